# Optimizing an MI355X kernel written in HIP

```python
import math
import jax
import jax.numpy as jnp
from jax import lax
import numpy as np

D_MODEL = 1024
BATCH = 4
SEQ = 8192
DEPTH = 1

GRID_W = 64
CTX_LEN = 256
EPS = 1e-6

SSD_WIDTH = 512
SSD_HEADDIM = 64
SSD_HEADS = 8
SSD_GROUPS = 2
SSD_STATE = 128
SSD_CONV = 5
SSD_CHUNK = 128
SSD_CONV_CH = SSD_WIDTH + 2 * SSD_GROUPS * SSD_STATE

HGRN_WIDTH = 512
HGRN_HEADS = 4
HGRN_HEADDIM = 128
HGRN_CHUNK = 64

N_EXPERTS = 16
EXPERT_FF = 1024
CAPACITY_FACTOR = 2

COL_SIZES = (SSD_WIDTH, SSD_CONV_CH, 2 * SSD_HEADS, HGRN_WIDTH, HGRN_WIDTH, HGRN_WIDTH, HGRN_WIDTH, HGRN_WIDTH)
IN_COLS = SSD_WIDTH + SSD_CONV_CH + 2 * SSD_HEADS + 5 * HGRN_WIDTH

kernel_name = 'hymba_ssd_hgrn2_ecmoe_prefix_dit_layer'


def rmsnorm(x, w):
    xf = x.astype(jnp.float32)
    y = xf * lax.rsqrt(jnp.mean(xf * xf, axis=-1, keepdims=True) + EPS)
    return (y * w.astype(jnp.float32)).astype(x.dtype)


def modulate(h, shift, scale):
    return h * (1 + scale) + shift


def flip_seq(t):
    return jnp.flip(t, axis=1)


def split_cols(u):
    points, acc = [], 0
    for s in COL_SIZES[:-1]:
        acc += s
        points.append(acc)
    return jnp.split(u, points, axis=-1)


def dwconv_centred(u, w, b):
    pad = w.shape[0] // 2
    y = lax.conv_general_dilated(u, w[:, None, :], (1,), [(pad, pad)],
                                 dimension_numbers=('NWC', 'WIO', 'NWC'),
                                 feature_group_count=u.shape[-1])
    return y + b


def latent_conv(u, w, b):
    bsz, n, ch = u.shape
    rows = n // GRID_W
    return dwconv_centred(u.reshape(bsz * rows, GRID_W, ch), w, b).reshape(bsz, n, ch)


def ssd_scan(xdt, log_a, bmat, cmat, s0, return_y=True):
    f32 = jnp.float32
    b, l, h, p = xdt.shape
    g, n = bmat.shape[2], bmat.shape[3]
    hg = h // g
    q = SSD_CHUNK
    c = l // q
    xc = xdt.reshape(b, c, q, g, hg, p).astype(f32)
    ac = log_a.reshape(b, c, q, g, hg).astype(f32)
    bc = bmat.reshape(b, c, q, g, n).astype(f32)
    cc = cmat.reshape(b, c, q, g, n).astype(f32)
    a_cs = jnp.cumsum(ac, axis=2)
    a_tot = a_cs[:, :, -1]
    decay_end = jnp.exp(a_tot[:, :, None] - a_cs)
    states = jnp.einsum('bcsgn,bcsgj,bcsgjp->bcgjpn', bc, decay_end, xc)

    def step(s, inp):
        st, at = inp
        return jnp.exp(at)[..., None, None] * s + st, s

    s_final, s_in = lax.scan(step, s0.reshape(b, g, hg, p, n).astype(f32),
                             (jnp.moveaxis(states, 1, 0), jnp.moveaxis(a_tot, 1, 0)))
    s_final = s_final.reshape(b, h, p, n)
    if not return_y:
        return None, s_final
    s_in = jnp.moveaxis(s_in, 0, 1)
    seg = a_cs[:, :, :, None] - a_cs[:, :, None, :]
    mask = jnp.tril(jnp.ones((q, q), bool))[:, :, None, None]
    lmat = jnp.exp(jnp.where(mask, seg, -jnp.inf))
    cb = jnp.einsum('bclgn,bcsgn->bclsg', cc, bc)
    y_diag = jnp.einsum('bclsg,bclsgj,bcsgjp->bclgjp', cb, lmat, xc)
    y_off = jnp.einsum('bclgn,bcgjpn,bclgj->bclgjp', cc, s_in, jnp.exp(a_cs))
    return (y_diag + y_off).reshape(b, l, h, p), s_final


def hgrn2_scan(q, f, v, s0, return_y=True):
    f32 = jnp.float32
    b, l, h, dk = q.shape
    dv = v.shape[-1]
    cq = HGRN_CHUNK
    c = l // cq
    qc = q.reshape(b, c, cq, h, dk).astype(f32)
    fc = f.reshape(b, c, cq, h, dk).astype(f32)
    vc = v.reshape(b, c, cq, h, dv).astype(f32)
    kc = 1 - fc
    bcs = jnp.cumsum(jnp.log(fc), axis=2)
    btot = bcs[:, :, -1]
    states = jnp.einsum('bcshk,bcshv->bchkv', kc * jnp.exp(btot[:, :, None] - bcs), vc)

    def step(s, inp):
        st, dt = inp
        return jnp.exp(dt)[..., None] * s + st, s

    s_final, s_in = lax.scan(step, s0.astype(f32),
                             (jnp.moveaxis(states, 1, 0), jnp.moveaxis(btot, 1, 0)))
    if not return_y:
        return None, s_final
    s_in = jnp.moveaxis(s_in, 0, 1)
    q_dec = qc * jnp.exp(bcs)
    k_inv = kc * jnp.exp(-bcs)
    att = jnp.einsum('bclhk,bcshk->bchls', q_dec, k_inv)
    att = jnp.where(jnp.tril(jnp.ones((cq, cq), bool)), att, 0.0)
    o = jnp.einsum('bchls,bcshv->bclhv', att, vc) + jnp.einsum('bclhk,bchkv->bclhv', q_dec, s_in)
    return o.reshape(b, l, h, dv), s_final


def token_mixer(u_lat, u_ctx, conv_w, conv_b, dt_bias, a_log, d_skip, ssd_nw, lb, hgrn_nw, ctx_out):
    f32 = jnp.float32
    z_l, xbc_l, dt_l, q_l, ff_l, fb_l, i_l, g_l = split_cols(u_lat)
    z_c, xbc_c, dt_c, q_c, ff_c, fb_c, i_c, g_c = split_cols(u_ctx)
    bsz = u_lat.shape[0]
    a_neg = -jnp.exp(a_log.astype(f32))
    d32 = d_skip.astype(f32)

    def ssd_inputs(xbc, dt_raw):
        b, l = xbc.shape[:2]
        xs, bm, cm = jnp.split(jax.nn.silu(xbc.astype(f32)),
                               [SSD_WIDTH, SSD_WIDTH + SSD_GROUPS * SSD_STATE], axis=-1)
        xs = xs.reshape(b, l, SSD_HEADS, SSD_HEADDIM)
        bm = bm.reshape(b, l, SSD_GROUPS, SSD_STATE)
        cm = cm.reshape(b, l, SSD_GROUPS, SSD_STATE)
        dt = jax.nn.softplus(dt_raw.astype(f32).reshape(b, l, 2, SSD_HEADS) + dt_bias.astype(f32))
        xdt = xs[:, :, None] * dt[..., None]
        return xs, bm, cm, xdt, dt * a_neg

    def ssd_output(y_f, y_b, xs, z):
        b, l = xs.shape[:2]
        y = y_f + flip_seq(y_b) + d32[:, None] * xs
        y = y.reshape(b, l, SSD_WIDTH) * jax.nn.silu(z.astype(f32))
        y = rmsnorm(y.reshape(b, l, SSD_GROUPS, -1), ssd_nw.reshape(SSD_GROUPS, -1))
        return y.reshape(b, l, SSD_WIDTH)

    def hgrn_inputs(q_raw, f_raw_f, f_raw_b, i_raw):
        b, l = q_raw.shape[:2]
        shp = (b, l, HGRN_HEADS, HGRN_HEADDIM)
        qq = jax.nn.silu(q_raw.astype(f32)).reshape(shp)
        f_f = (lb[0] + (1 - lb[0]) * jax.nn.sigmoid(f_raw_f.astype(f32))).reshape(shp)
        f_b = (lb[1] + (1 - lb[1]) * jax.nn.sigmoid(f_raw_b.astype(f32))).reshape(shp)
        return qq, f_f, f_b, i_raw.astype(f32).reshape(shp)

    def hgrn_output(o_f, o_b, g):
        b, l = g.shape[:2]
        o = rmsnorm(o_f + flip_seq(o_b), hgrn_nw.reshape(HGRN_HEADS, HGRN_HEADDIM))
        return o.reshape(b, l, HGRN_WIDTH) * jax.nn.silu(g.astype(f32))

    xs_c, b_c, c_c, xdt_c, la_c = ssd_inputs(dwconv_centred(xbc_c, conv_w, conv_b), dt_c)
    xs_l, b_l, c_l, xdt_l, la_l = ssd_inputs(latent_conv(xbc_l, conv_w, conv_b), dt_l)
    s0 = jnp.zeros((bsz, SSD_HEADS, SSD_HEADDIM, SSD_STATE), f32)
    yc_f, sc_f = ssd_scan(xdt_c[:, :, 0], la_c[:, :, 0], b_c, c_c, s0, ctx_out)
    yc_b, sc_b = ssd_scan(flip_seq(xdt_c[:, :, 1]), flip_seq(la_c[:, :, 1]),
                          flip_seq(b_c), flip_seq(c_c), s0, ctx_out)
    yl_f, _ = ssd_scan(xdt_l[:, :, 0], la_l[:, :, 0], b_l, c_l, sc_f)
    yl_b, _ = ssd_scan(flip_seq(xdt_l[:, :, 1]), flip_seq(la_l[:, :, 1]),
                       flip_seq(b_l), flip_seq(c_l), sc_b)
    ssd_lat = ssd_output(yl_f, yl_b, xs_l, z_l)

    qh_c, f_fc, f_bc, v_c = hgrn_inputs(q_c, ff_c, fb_c, i_c)
    qh_l, f_fl, f_bl, v_l = hgrn_inputs(q_l, ff_l, fb_l, i_l)
    r0 = jnp.zeros((bsz, HGRN_HEADS, HGRN_HEADDIM, HGRN_HEADDIM), f32)
    oc_f, rc_f = hgrn2_scan(qh_c, f_fc, v_c, r0, ctx_out)
    oc_b, rc_b = hgrn2_scan(flip_seq(qh_c), flip_seq(f_bc), flip_seq(v_c), r0, ctx_out)
    ol_f, _ = hgrn2_scan(qh_l, f_fl, v_l, rc_f)
    ol_b, _ = hgrn2_scan(flip_seq(qh_l), flip_seq(f_bl), flip_seq(v_l), rc_b)
    hgrn_lat = hgrn_output(ol_f, ol_b, g_l)

    y_lat = jnp.concatenate([ssd_lat, hgrn_lat], axis=-1).astype(u_lat.dtype)
    y_ctx = None
    if ctx_out:
        y_ctx = jnp.concatenate([ssd_output(yc_f, yc_b, xs_c, z_c),
                                 hgrn_output(oc_f, oc_b, g_c)], axis=-1).astype(u_ctx.dtype)
    return y_lat, y_ctx


def expert_choice_moe(h, w_router, w_gate, w_up, w_down):
    n, d = h.shape[1], h.shape[2]
    cap = CAPACITY_FACTOR * n // N_EXPERTS
    aff = jax.nn.softmax(jnp.einsum('bnd,de->ben', h, w_router).astype(jnp.float32), axis=1)
    gate, idx = lax.top_k(aff, cap)
    xin = jax.vmap(lambda hb, ib: hb[ib])(h, idx)
    hg = jnp.einsum('becd,edf->becf', xin, w_gate)
    hu = jnp.einsum('becd,edf->becf', xin, w_up)
    y = jnp.einsum('becf,efd->becd', jax.nn.silu(hg) * hu, w_down)
    y = y * gate[..., None].astype(y.dtype)
    return jax.vmap(lambda yb, ib: jnp.zeros((n, d), y.dtype).at[ib.reshape(-1)].add(yb.reshape(-1, d)))(y, idx)


def setup_inputs(seed: int = 0) -> dict:
    key = jax.random.key(seed)
    ks = jax.random.split(key, 24)
    f32 = jnp.float32

    def nrm(k, shape, scale):
        return jax.random.normal(k, shape, f32) * scale

    dt0 = jnp.exp(jax.random.uniform(ks[10], (DEPTH, 2, SSD_HEADS), f32, math.log(1e-3), math.log(1e-1)))
    return {
        'x': nrm(ks[0], (BATCH, SEQ, D_MODEL), 1.0),
        'c': nrm(ks[1], (BATCH, D_MODEL), 1.0),
        'ctx': nrm(ks[2], (BATCH, CTX_LEN, D_MODEL), 1.0),
        'c_ctx': nrm(ks[3], (D_MODEL,), 1.0),
        'ada_w': nrm(ks[4], (DEPTH, D_MODEL, 6 * D_MODEL), 0.5 * D_MODEL ** -0.5),
        'ada_b': nrm(ks[5], (DEPTH, 6 * D_MODEL), 0.02),
        'norm_w': 1.0 + nrm(ks[6], (DEPTH, 4, D_MODEL), 0.02),
        'w_in': nrm(ks[7], (DEPTH, D_MODEL, IN_COLS), D_MODEL ** -0.5),
        'ssd_conv_w': nrm(ks[8], (DEPTH, SSD_CONV, SSD_CONV_CH), SSD_CONV ** -0.5),
        'ssd_conv_b': nrm(ks[9], (DEPTH, SSD_CONV_CH), 0.02),
        'ssd_dt_bias': dt0 + jnp.log(-jnp.expm1(-dt0)),
        'ssd_a_log': jnp.log(jax.random.uniform(ks[11], (DEPTH, 2, SSD_HEADS), f32, 1.0, 16.0)),
        'ssd_d': 1.0 + nrm(ks[12], (DEPTH, SSD_HEADS), 0.02),
        'ssd_norm_w': 1.0 + nrm(ks[13], (DEPTH, SSD_WIDTH), 0.02),
        'hgrn_lb': nrm(ks[14], (DEPTH + 1, 2, HGRN_WIDTH), 0.1),
        'hgrn_norm_w': 1.0 + nrm(ks[15], (DEPTH, HGRN_WIDTH), 0.02),
        'w_out': nrm(ks[16], (DEPTH, D_MODEL, D_MODEL), D_MODEL ** -0.5),
        'w_router': nrm(ks[17], (DEPTH, D_MODEL, N_EXPERTS), D_MODEL ** -0.5),
        'w_gate': nrm(ks[18], (DEPTH, N_EXPERTS, D_MODEL, EXPERT_FF), D_MODEL ** -0.5),
        'w_up': nrm(ks[19], (DEPTH, N_EXPERTS, D_MODEL, EXPERT_FF), D_MODEL ** -0.5),
        'w_down': nrm(ks[20], (DEPTH, N_EXPERTS, EXPERT_FF, D_MODEL), EXPERT_FF ** -0.5),
    }


def reference(x, c, ctx, c_ctx, ada_w, ada_b, norm_w, w_in, ssd_conv_w, ssd_conv_b, ssd_dt_bias,
              ssd_a_log, ssd_d, ssd_norm_w, hgrn_lb, hgrn_norm_w, w_out, w_router, w_gate, w_up, w_down):
    lower_bounds = jnp.cumsum(jax.nn.softmax(hgrn_lb.astype(jnp.float32), axis=0), axis=0)
    x_lat, x_ctx = x, ctx
    for layer in range(DEPTH):
        ctx_out = layer < DEPTH - 1
        nw = norm_w[layer]
        mod_lat = jnp.split((jax.nn.silu(c) @ ada_w[layer] + ada_b[layer])[:, None, :], 6, axis=-1)
        mod_ctx = jnp.split(jax.nn.silu(c_ctx) @ ada_w[layer] + ada_b[layer], 6, axis=-1)

        h_lat = modulate(rmsnorm(x_lat, nw[0]), mod_lat[0], mod_lat[1])
        h_ctx = modulate(rmsnorm(x_ctx, nw[0]), mod_ctx[0], mod_ctx[1])
        y_lat, y_ctx = token_mixer(h_lat @ w_in[layer], h_ctx @ w_in[layer], ssd_conv_w[layer],
                                   ssd_conv_b[layer], ssd_dt_bias[layer], ssd_a_log[layer], ssd_d[layer],
                                   ssd_norm_w[layer], lower_bounds[layer], hgrn_norm_w[layer], ctx_out)
        x_lat = x_lat + mod_lat[2] * rmsnorm(y_lat @ w_out[layer], nw[1])

        h_lat = modulate(rmsnorm(x_lat, nw[2]), mod_lat[3], mod_lat[4])
        moe_lat = expert_choice_moe(h_lat, w_router[layer], w_gate[layer], w_up[layer], w_down[layer])
        x_lat = x_lat + mod_lat[5] * rmsnorm(moe_lat, nw[3])

        if ctx_out:
            x_ctx = x_ctx + mod_ctx[2] * rmsnorm(y_ctx @ w_out[layer], nw[1])
            h_ctx = modulate(rmsnorm(x_ctx, nw[2]), mod_ctx[3], mod_ctx[4])
            moe_ctx = expert_choice_moe(h_ctx, w_router[layer], w_gate[layer], w_up[layer], w_down[layer])
            x_ctx = x_ctx + mod_ctx[5] * rmsnorm(moe_ctx, nw[3])
    return x_lat
```

```cpp
#include <hip/hip_runtime.h>
#include <cstdio>
#include <cstdint>

#define DI __device__ __forceinline__
typedef _Float16 f16;
typedef _Float16 f16x8 __attribute__((ext_vector_type(8)));
typedef _Float16 f16x4 __attribute__((ext_vector_type(4)));
typedef float f32x4 __attribute__((ext_vector_type(4)));

constexpr int DM = 1024, NB = 4, SEQ = 8192, CTXL = 256;
constexpr int MLAT = NB * SEQ;
constexpr int MCTX = NB * CTXL;
constexpr int MTOT = MLAT + MCTX;
constexpr int INCOLS = 4112, NU = 4096;
constexpr int UZ = 0, UXBC = 512, UQ = 1536, UFF = 2048, UFB = 2560, UI = 3072, UG = 3584;
constexpr int NE = 16, FF = 1024, CAP = 1024;
constexpr float EPS = 1e-6f;

constexpr size_t MiB = 1u << 20;
constexpr size_t WS_MOD = 1 * MiB;
constexpr size_t WS_DT = 2 * MiB;
constexpr size_t WS_WDT = 5 * MiB;
constexpr size_t WS_AFF = 6 * MiB;
constexpr size_t WS_IDX = 8 * MiB;
constexpr size_t WS_GATEV = 8 * MiB + 256 * 1024;
constexpr size_t WS_SLOT = 9 * MiB;
constexpr size_t WS_WIN = 12 * MiB;
constexpr size_t WS_WOUT = 20 * MiB;
constexpr size_t WS_WGU = 22 * MiB;
constexpr size_t WS_WD = 86 * MiB;
constexpr size_t WS_H = 118 * MiB;
constexpr size_t WS_U = 184 * MiB;
constexpr size_t WS_Y = 448 * MiB;
constexpr size_t WS_END = 512 * MiB;
constexpr size_t WS_ACT = WS_U;
constexpr size_t WS_YM = WS_U + 128 * MiB;
constexpr size_t WS_R = WS_U;

DI float silu_f(float x) { return x / (1.f + __expf(-x)); }
DI float sigmoid_f(float x) { return 1.f / (1.f + __expf(-x)); }
DI float softplus_f(float x) { return x > 20.f ? x : log1pf(__expf(x)); }
DI float wave_sum(float v) {
#pragma unroll
    for (int o = 1; o < 64; o <<= 1) v += __shfl_xor(v, o);
    return v;
}

__global__ void __launch_bounds__(256) k_mods(const float* c, const float* c_ctx, const float* ada_w, const float* ada_b, float* MOD) {
    __shared__ float sv[5][DM];
    for (int i = threadIdx.x; i < 5 * DM; i += 256) { const int r = i / DM, k = i % DM; const float v = r < 4 ? c[r * DM + k] : c_ctx[k]; sv[r][k] = silu_f(v); }
    __syncthreads();
    const int j = blockIdx.x * 256 + threadIdx.x;
    float a0 = 0, a1 = 0, a2 = 0, a3 = 0, a4 = 0;
    for (int k = 0; k < DM; ++k) { const float w = ada_w[(size_t)k * 6144 + j]; a0 += sv[0][k] * w; a1 += sv[1][k] * w; a2 += sv[2][k] * w; a3 += sv[3][k] * w; a4 += sv[4][k] * w; }
    const float bb = ada_b[j];
    MOD[0 * 6144 + j] = a0 + bb; MOD[1 * 6144 + j] = a1 + bb; MOD[2 * 6144 + j] = a2 + bb; MOD[3 * 6144 + j] = a3 + bb; MOD[4 * 6144 + j] = a4 + bb;
}

DI void tr_tile(const float* src, size_t ld, int col0, int k0, f16* dst, int dstrow0, int Kdim) {
    __shared__ float t[32][33];
    const int tx = threadIdx.x & 31, ty = threadIdx.x >> 5;
#pragma unroll
    for (int i = 0; i < 4; ++i) t[ty + 8 * i][tx] = src[(size_t)(k0 + ty + 8 * i) * ld + col0 + tx];
    __syncthreads();
#pragma unroll
    for (int i = 0; i < 4; ++i) dst[(size_t)(dstrow0 + ty + 8 * i) * Kdim + k0 + tx] = (f16)t[tx][ty + 8 * i];
}
__global__ void __launch_bounds__(256) k_tr_win(const float* w_in, f16* WIN) {
    const int n0 = blockIdx.x * 32, k0 = blockIdx.y * 32;
    const int col0 = n0 < 1536 ? n0 : n0 + 16;
    tr_tile(w_in, INCOLS, col0, k0, WIN, n0, DM);
}
__global__ void __launch_bounds__(256) k_tr_wdt(const float* w_in, float* WDT) {
    const int i = blockIdx.x * 256 + threadIdx.x; if (i >= 16 * DM) return;
    const int j = i / DM, k = i % DM; WDT[i] = w_in[(size_t)k * INCOLS + 1536 + j];
}
__global__ void __launch_bounds__(256) k_tr_wout(const float* w_out, f16* WOUT) {
    tr_tile(w_out, DM, blockIdx.x * 32, blockIdx.y * 32, WOUT, blockIdx.x * 32, DM);
}
__global__ void __launch_bounds__(256) k_tr_gu(const float* w_gate, const float* w_up, f16* WGU) {
    const int r0 = blockIdx.x * 32, k0 = blockIdx.y * 32, e = blockIdx.z;
    const int blk = r0 / 128, within = r0 % 128, isu = blk & 1, f0 = (blk >> 1) * 128 + within;
    const float* src = (isu ? w_up : w_gate) + (size_t)e * DM * FF;
    tr_tile(src, FF, f0, k0, WGU + (size_t)e * 2048 * DM, r0, DM);
}
__global__ void __launch_bounds__(256) k_tr_wd(const float* w_down, f16* WD) {
    const int e = blockIdx.z;
    tr_tile(w_down + (size_t)e * FF * DM, DM, blockIdx.x * 32, blockIdx.y * 32, WD + (size_t)e * DM * FF, blockIdx.x * 32, FF);
}

__global__ void __launch_bounds__(256) k_hrows(const float* x, const float* ctx, const float* norm_w, const float* MOD, const float* WDT, f16* H, float* DT) {
    const int row = blockIdx.x * 4 + (threadIdx.x >> 6), lane = threadIdx.x & 63;
    if (row >= MTOT) return;
    const float* xr = row < MLAT ? x + (size_t)row * DM : ctx + (size_t)(row - MLAT) * DM;
    const int r = row < MLAT ? row / SEQ : 4;
    const float* shift = MOD + r * 6144, *scale = MOD + r * 6144 + 1024;
    f32x4 v[4]; float ss = 0.f;
#pragma unroll
    for (int j = 0; j < 4; ++j) { v[j] = *(const f32x4*)(xr + 4 * lane + 256 * j); ss += v[j].x * v[j].x + v[j].y * v[j].y + v[j].z * v[j].z + v[j].w * v[j].w; }
    const float rstd = rsqrtf(wave_sum(ss) * (1.f / DM) + EPS);
#pragma unroll
    for (int j = 0; j < 4; ++j) {
        const int k = 4 * lane + 256 * j;
        const f32x4 nw = *(const f32x4*)(norm_w + k), sc = *(const f32x4*)(scale + k), sh = *(const f32x4*)(shift + k);
        v[j] = v[j] * rstd * nw * (1.f + sc) + sh;
        f16x4 o; o.x = (f16)v[j].x; o.y = (f16)v[j].y; o.z = (f16)v[j].z; o.w = (f16)v[j].w;
        *(f16x4*)(H + (size_t)row * DM + k) = o;
    }
    for (int d = 0; d < 16; ++d) {
        float p = 0.f;
#pragma unroll
        for (int j = 0; j < 4; ++j) { const f32x4 w = *(const f32x4*)(WDT + d * DM + 4 * lane + 256 * j); p += v[j].x * w.x + v[j].y * w.y + v[j].z * w.z + v[j].w * w.w; }
        p = wave_sum(p);
        if (lane == 0) DT[(size_t)row * 16 + d] = p;
    }
}

template <bool DUAL, class Epi>
DI void gemm_block(const f16* A, int lda, const int* ridx, const f16* BT, int K, int m0, int n0, const Epi& epi) {
    const int lane = threadIdx.x & 63, wid = threadIdx.x >> 6, wr = wid >> 1, wc = wid & 1;
    const int fr = lane & 15, fq = lane >> 4;
    const int mw = m0 + wr * 64, nw = n0 + wc * 64;
    const f16* ap[4]; const f16* bp[4]; const f16* bp2[4];
#pragma unroll
    for (int i = 0; i < 4; ++i) {
        const int m = mw + 16 * i + fr; const int rr = ridx ? ridx[m] : m;
        ap[i] = A + (size_t)rr * lda + 8 * fq;
        bp[i] = BT + (size_t)(nw + 16 * i + fr) * K + 8 * fq;
        bp2[i] = bp[i] + (size_t)128 * K;
    }
    f32x4 acc[4][4], acc2[4][4];
#pragma unroll
    for (int i = 0; i < 4; ++i)
#pragma unroll
        for (int j = 0; j < 4; ++j) { acc[i][j] = (f32x4){0, 0, 0, 0}; acc2[i][j] = (f32x4){0, 0, 0, 0}; }
    for (int k0 = 0; k0 < K; k0 += 32) {
        f16x8 a[4], b[4], b2[4];
#pragma unroll
        for (int i = 0; i < 4; ++i) { a[i] = *(const f16x8*)(ap[i] + k0); b[i] = *(const f16x8*)(bp[i] + k0); if (DUAL) b2[i] = *(const f16x8*)(bp2[i] + k0); }
#pragma unroll
        for (int i = 0; i < 4; ++i)
#pragma unroll
            for (int j = 0; j < 4; ++j) {
                acc[i][j] = __builtin_amdgcn_mfma_f32_16x16x32_f16(b[j], a[i], acc[i][j], 0, 0, 0);
                if (DUAL) acc2[i][j] = __builtin_amdgcn_mfma_f32_16x16x32_f16(b2[j], a[i], acc2[i][j], 0, 0, 0);
            }
    }
#pragma unroll
    for (int i = 0; i < 4; ++i)
#pragma unroll
        for (int j = 0; j < 4; ++j) epi(mw + 16 * i + fr, nw + 16 * j + 4 * fq, acc[i][j], acc2[i][j]);
}
struct EpiF16 { f16* C; int ldc;
    DI void operator()(int m, int n, f32x4 v, f32x4) const { f16x4 o; o.x = (f16)v.x; o.y = (f16)v.y; o.z = (f16)v.z; o.w = (f16)v.w; *(f16x4*)(C + (size_t)m * ldc + n) = o; } };
struct EpiF32 { float* C; int ldc;
    DI void operator()(int m, int n, f32x4 v, f32x4) const { *(f32x4*)(C + (size_t)m * ldc + n) = v; } };
struct EpiSwiglu { f16* ACT; int rowbase, n0blk, f0;
    DI void operator()(int m, int n, f32x4 g, f32x4 u) const { f16x4 o; o.x = (f16)(silu_f(g.x) * u.x); o.y = (f16)(silu_f(g.y) * u.y); o.z = (f16)(silu_f(g.z) * u.z); o.w = (f16)(silu_f(g.w) * u.w);
        *(f16x4*)(ACT + (size_t)(rowbase + m) * FF + f0 + (n - n0blk)) = o; } };
struct EpiDown { f16* YM; const float* gv; int rowbase;
    DI void operator()(int m, int n, f32x4 v, f32x4) const { const float g = gv[m]; f16x4 o; o.x = (f16)(v.x * g); o.y = (f16)(v.y * g); o.z = (f16)(v.z * g); o.w = (f16)(v.w * g);
        *(f16x4*)(YM + (size_t)(rowbase + m) * DM + n) = o; } };

__global__ void __launch_bounds__(256) k_gemm_in(const f16* H, const f16* WIN, f16* U) {
    gemm_block<false>(H, DM, nullptr, WIN, DM, blockIdx.y * 128, blockIdx.x * 128, EpiF16{U, NU});
}
__global__ void __launch_bounds__(256) k_gemm_out(const f16* Y, const f16* WOUT, float* R) {
    gemm_block<false>(Y, DM, nullptr, WOUT, DM, blockIdx.y * 128, blockIdx.x * 128, EpiF32{R, DM});
}
__global__ void __launch_bounds__(256) k_gemm_gu(const f16* H2, const int* IDX, const f16* WGU, f16* ACT) {
    const int b = blockIdx.z >> 4, e = blockIdx.z & 15;
    const int n0 = blockIdx.x * 256;
    gemm_block<true>(H2 + (size_t)b * SEQ * DM, DM, IDX + (b * 16 + e) * CAP, WGU + (size_t)e * 2048 * DM, DM, blockIdx.y * 128, n0,
                     EpiSwiglu{ACT, (e * 4 + b) * CAP, n0, (int)blockIdx.x * 128});
}
__global__ void __launch_bounds__(256) k_gemm_down(const f16* ACT, const f16* WD, const float* GATEV, f16* YM) {
    const int b = blockIdx.z >> 4, e = blockIdx.z & 15;
    const int rowbase = (e * 4 + b) * CAP;
    gemm_block<false>(ACT + (size_t)rowbase * FF, FF, nullptr, WD + (size_t)e * DM * FF, FF, blockIdx.y * 128, blockIdx.x * 128,
                      EpiDown{YM, GATEV + (b * 16 + e) * CAP, rowbase});
}

__global__ void __launch_bounds__(256) k_conv(const f16* U, const float* cw, const float* cb, f16* XBC) {
    const size_t i = (size_t)blockIdx.x * 256 + threadIdx.x; if (i >= (size_t)MTOT * 1024) return;
    const int row = (int)(i >> 10), c = (int)(i & 1023);
    int s0, s1;
    if (row < MLAT) { s0 = row & ~63; s1 = s0 + 64; } else { s0 = MLAT + ((row - MLAT) & ~255); s1 = s0 + 256; }
    float a = cb[c];
#pragma unroll
    for (int j = 0; j < 5; ++j) { const int r = row + j - 2; if (r >= s0 && r < s1) a += cw[j * 1024 + c] * (float)U[(size_t)r * NU + UXBC + c]; }
    XBC[i] = (f16)silu_f(a);
}
__global__ void __launch_bounds__(256) k_ssd_seq(const f16* XBC, const float* DT, const float* dt_bias, const float* a_log, float* YS, int dir, int accum) {
    __shared__ float xs[64][64], Bm[64][128], Cm[64][128], av[64], dtv[64], yt[64][64];
    const int b = blockIdx.x >> 3, h = blockIdx.x & 7, g = h >> 2;
    const int tid = threadIdx.x, p = tid >> 2, nq = tid & 3;
    const float aneg = -__expf(a_log[dir * 8 + h]), dtb = dt_bias[dir * 8 + h];
    float st[32];
#pragma unroll
    for (int i = 0; i < 32; ++i) st[i] = 0.f;
    const int ntile = (CTXL + SEQ) / 64;
    for (int tl = 0; tl < ntile; ++tl) {
        const bool isctx = tl < 4;
        int base;
        if (isctx) base = MLAT + b * CTXL + (dir == 0 ? tl * 64 : CTXL - 1 - tl * 64);
        else base = b * SEQ + (dir == 0 ? (tl - 4) * 64 : SEQ - 1 - (tl - 4) * 64);
        const int step = dir == 0 ? 1 : -1;
        __syncthreads();
        for (int i = tid; i < 64 * 64; i += 256) { const int t = i >> 6, c = i & 63; xs[t][c] = (float)XBC[(size_t)(base + step * t) * 1024 + h * 64 + c]; }
        for (int i = tid; i < 64 * 128; i += 256) { const int t = i >> 7, c = i & 127; const size_t ro = (size_t)(base + step * t) * 1024; Bm[t][c] = (float)XBC[ro + 512 + g * 128 + c]; Cm[t][c] = (float)XBC[ro + 768 + g * 128 + c]; }
        if (tid < 64) { const float d = softplus_f(DT[(size_t)(base + step * tid) * 16 + dir * 8 + h] + dtb); dtv[tid] = d; av[tid] = __expf(d * aneg); }
        __syncthreads();
        for (int t = 0; t < 64; ++t) {
            const float a = av[t], xd = xs[t][p] * dtv[t];
            float y = 0.f;
#pragma unroll
            for (int i = 0; i < 32; ++i) { st[i] = a * st[i] + xd * Bm[t][nq * 32 + i]; y += st[i] * Cm[t][nq * 32 + i]; }
            y += __shfl_xor(y, 1); y += __shfl_xor(y, 2);
            if (nq == 0) yt[t][p] = y;
        }
        __syncthreads();
        if (!isctx) for (int i = tid; i < 64 * 64; i += 256) { const int t = i >> 6, c = i & 63; float* o = YS + (size_t)(base + step * t) * 512 + h * 64 + c; *o = accum ? *o + yt[t][c] : yt[t][c]; }
    }
}
__global__ void __launch_bounds__(512) k_hgrn_seq(const f16* U, const float* hgrn_lb, float* OH, int dir, int accum) {
    __shared__ float qs[32][128], fs[32][128], is[32][128], ot[32][128];
    const int b = blockIdx.x >> 2, h = blockIdx.x & 3;
    const int tid = threadIdx.x, v = tid >> 2, kq = tid & 3;
    float st[32];
#pragma unroll
    for (int i = 0; i < 32; ++i) st[i] = 0.f;
    const int fcol = dir == 0 ? UFF : UFB;
    const int ntile = (CTXL + SEQ) / 32;
    for (int tl = 0; tl < ntile; ++tl) {
        const bool isctx = tl < 8;
        int base;
        if (isctx) base = MLAT + b * CTXL + (dir == 0 ? tl * 32 : CTXL - 1 - tl * 32);
        else base = b * SEQ + (dir == 0 ? (tl - 8) * 32 : SEQ - 1 - (tl - 8) * 32);
        const int step = dir == 0 ? 1 : -1;
        __syncthreads();
        for (int i = tid; i < 32 * 128; i += 512) {
            const int t = i >> 7, c = i & 127; const size_t ro = (size_t)(base + step * t) * NU; const int ch = h * 128 + c;
            qs[t][c] = silu_f((float)U[ro + UQ + ch]);
            const float l0 = hgrn_lb[dir * 512 + ch], l1 = hgrn_lb[1024 + dir * 512 + ch];
            const float lb = 1.f / (1.f + __expf(l1 - l0));
            fs[t][c] = lb + (1.f - lb) * sigmoid_f((float)U[ro + fcol + ch]);
            is[t][c] = (float)U[ro + UI + ch];
        }
        __syncthreads();
        for (int t = 0; t < 32; ++t) {
            const float iv = is[t][v]; float o = 0.f;
#pragma unroll
            for (int i = 0; i < 32; ++i) { const float f = fs[t][kq * 32 + i]; st[i] = f * st[i] + (1.f - f) * iv; o += qs[t][kq * 32 + i] * st[i]; }
            o += __shfl_xor(o, 1); o += __shfl_xor(o, 2);
            if (kq == 0) ot[t][v] = o;
        }
        __syncthreads();
        if (!isctx) for (int i = tid; i < 32 * 128; i += 512) { const int t = i >> 7, c = i & 127; float* o = OH + (size_t)(base + step * t) * 512 + h * 128 + c; *o = accum ? *o + ot[t][c] : ot[t][c]; }
    }
}
__global__ void __launch_bounds__(256) k_mix_out(const f16* U, const f16* XBC, const float* YS, const float* OH, const float* ssd_d, const float* ssd_nw, const float* hgrn_nw, f16* Y) {
    const int row = blockIdx.x * 4 + (threadIdx.x >> 6), lane = threadIdx.x & 63;
    const int c0 = lane * 8;
    float y[8], o[8]; float ss = 0.f, so = 0.f;
    const float dsk = ssd_d[c0 >> 6];
#pragma unroll
    for (int j = 0; j < 8; ++j) {
        const int c = c0 + j;
        float v = YS[(size_t)row * 512 + c] + dsk * (float)XBC[(size_t)row * 1024 + c];
        v *= silu_f((float)U[(size_t)row * NU + UZ + c]);
        y[j] = v; ss += v * v;
        const float w = OH[(size_t)row * 512 + c]; o[j] = w; so += w * w;
    }
    for (int m = 1; m < 32; m <<= 1) ss += __shfl_xor(ss, m);
    for (int m = 1; m < 16; m <<= 1) so += __shfl_xor(so, m);
    const float rs = rsqrtf(ss * (1.f / 256.f) + EPS), ro = rsqrtf(so * (1.f / 128.f) + EPS);
#pragma unroll
    for (int j = 0; j < 8; ++j) {
        const int c = c0 + j;
        Y[(size_t)row * DM + c] = (f16)(y[j] * rs * ssd_nw[c]);
        Y[(size_t)row * DM + 512 + c] = (f16)(o[j] * ro * hgrn_nw[c] * silu_f((float)U[(size_t)row * NU + UG + c]));
    }
}

__global__ void __launch_bounds__(256) k_post(const float* x, const float* R, const float* norm_w, const float* MOD, const float* w_router, float* XLAT, f16* H2, float* AFF) {
    __shared__ float wr[DM * 16];
    for (int i = threadIdx.x; i < DM * 16; i += 256) wr[i] = w_router[i];
    __syncthreads();
    const int lane = threadIdx.x & 63;
    for (int row = blockIdx.x * 4 + (threadIdx.x >> 6); row < MLAT; row += gridDim.x * 4) {
        const int b = row / SEQ, t = row % SEQ;
        const float* mod = MOD + b * 6144;
        f32x4 r[4], xl[4]; float ss = 0.f;
#pragma unroll
        for (int j = 0; j < 4; ++j) { r[j] = *(const f32x4*)(R + (size_t)row * DM + 4 * lane + 256 * j); ss += r[j].x * r[j].x + r[j].y * r[j].y + r[j].z * r[j].z + r[j].w * r[j].w; }
        const float rstd = rsqrtf(wave_sum(ss) * (1.f / DM) + EPS);
        float s2 = 0.f;
#pragma unroll
        for (int j = 0; j < 4; ++j) {
            const int k = 4 * lane + 256 * j;
            const f32x4 xv = *(const f32x4*)(x + (size_t)row * DM + k), nw = *(const f32x4*)(norm_w + 1024 + k), gt = *(const f32x4*)(mod + 2048 + k);
            xl[j] = xv + gt * (r[j] * rstd * nw);
            *(f32x4*)(XLAT + (size_t)row * DM + k) = xl[j];
            s2 += xl[j].x * xl[j].x + xl[j].y * xl[j].y + xl[j].z * xl[j].z + xl[j].w * xl[j].w;
        }
        const float rstd2 = rsqrtf(wave_sum(s2) * (1.f / DM) + EPS);
        float lg[16];
#pragma unroll
        for (int e = 0; e < 16; ++e) lg[e] = 0.f;
#pragma unroll
        for (int j = 0; j < 4; ++j) {
            const int k = 4 * lane + 256 * j;
            const f32x4 nw = *(const f32x4*)(norm_w + 2048 + k), sh = *(const f32x4*)(mod + 3072 + k), sc = *(const f32x4*)(mod + 4096 + k);
            const f32x4 hv = xl[j] * rstd2 * nw * (1.f + sc) + sh;
            f16x4 o; o.x = (f16)hv.x; o.y = (f16)hv.y; o.z = (f16)hv.z; o.w = (f16)hv.w;
            *(f16x4*)(H2 + (size_t)row * DM + k) = o;
#pragma unroll
            for (int e = 0; e < 16; ++e) lg[e] += hv.x * wr[(k + 0) * 16 + e] + hv.y * wr[(k + 1) * 16 + e] + hv.z * wr[(k + 2) * 16 + e] + hv.w * wr[(k + 3) * 16 + e];
        }
        float mx = -1e30f;
#pragma unroll
        for (int e = 0; e < 16; ++e) { lg[e] = wave_sum(lg[e]); mx = fmaxf(mx, lg[e]); }
        float den = 0.f;
#pragma unroll
        for (int e = 0; e < 16; ++e) { lg[e] = __expf(lg[e] - mx); den += lg[e]; }
        const float inv = 1.f / den;
        if (lane < 16) { float v = 0.f;
#pragma unroll
            for (int e = 0; e < 16; ++e) v = lane == e ? lg[e] : v;
            AFF[((size_t)b * 16 + lane) * SEQ + t] = v * inv; }
    }
}

__global__ void __launch_bounds__(512) k_topk(const float* AFF, int* IDX, float* GATEV, int* SLOT) {
    __shared__ unsigned vals[SEQ];
    __shared__ unsigned hist[256];
    __shared__ unsigned s_prefix, s_k;
    __shared__ unsigned wsum_gt[8], wsum_eq[8];
    const int be = blockIdx.x, tid = threadIdx.x;
    const float* a = AFF + (size_t)be * SEQ;
    for (int i = tid; i < SEQ; i += 512) vals[i] = __float_as_uint(a[i]);
    if (tid == 0) { s_prefix = 0u; s_k = CAP; }
    __syncthreads();
    unsigned mask = 0u;
    for (int pass = 0; pass < 4; ++pass) {
        const int shift = 24 - 8 * pass;
        if (tid < 256) hist[tid] = 0u;
        __syncthreads();
        const unsigned prefix = s_prefix;
        for (int i = tid; i < SEQ; i += 512) { const unsigned v = vals[i]; if ((v & mask) == prefix) atomicAdd(&hist[(v >> shift) & 255u], 1u); }
        __syncthreads();
        if (tid == 0) {
            unsigned k = s_k, cum = 0u; int bin = 255;
            for (; bin > 0; --bin) { if (cum + hist[bin] >= k) break; cum += hist[bin]; }
            s_k = k - cum; s_prefix = prefix | ((unsigned)bin << shift);
        }
        mask |= 255u << shift;
        __syncthreads();
    }
    const unsigned T = s_prefix, keq = s_k;
    unsigned cg = 0, ce = 0;
    for (int j = 0; j < 16; ++j) { const unsigned v = vals[tid * 16 + j]; cg += v > T; ce += v == T; }
    const int lane = tid & 63, w = tid >> 6;
    unsigned ig = cg, ie = ce;
    for (int o = 1; o < 64; o <<= 1) { const unsigned tg = __shfl_up(ig, o), te = __shfl_up(ie, o); if (lane >= o) { ig += tg; ie += te; } }
    if (lane == 63) { wsum_gt[w] = ig; wsum_eq[w] = ie; }
    __syncthreads();
    unsigned og = 0, oe = 0;
    for (int i = 0; i < w; ++i) { og += wsum_gt[i]; oe += wsum_eq[i]; }
    unsigned pg = og + ig - cg, pe = oe + ie - ce;
    for (int j = 0; j < 16; ++j) {
        const int t = tid * 16 + j; const unsigned v = vals[t];
        int slot = -1;
        if (v > T) { slot = (int)(pg + (pe < keq ? pe : keq)); pg++; }
        else if (v == T) { if (pe < keq) slot = (int)(pg + pe); pe++; }
        SLOT[(size_t)be * SEQ + t] = slot;
        if (slot >= 0) { IDX[be * CAP + slot] = t; GATEV[be * CAP + slot] = __uint_as_float(v); }
    }
}

__global__ void __launch_bounds__(256) k_combine(const float* XLAT, const f16* YM, const int* SLOT, const float* norm_w, const float* MOD, float* out) {
    const int row = blockIdx.x * 4 + (threadIdx.x >> 6), lane = threadIdx.x & 63;
    const int b = row / SEQ, t = row % SEQ;
    f32x4 acc[4];
#pragma unroll
    for (int j = 0; j < 4; ++j) acc[j] = (f32x4){0, 0, 0, 0};
    for (int e = 0; e < NE; ++e) {
        const int s = SLOT[((size_t)b * 16 + e) * SEQ + t];
        if (s >= 0) {
            const f16* yr = YM + (size_t)((e * 4 + b) * CAP + s) * DM;
#pragma unroll
            for (int j = 0; j < 4; ++j) { const f16x4 v = *(const f16x4*)(yr + 4 * lane + 256 * j); acc[j].x += (float)v.x; acc[j].y += (float)v.y; acc[j].z += (float)v.z; acc[j].w += (float)v.w; }
        }
    }
    float ss = 0.f;
#pragma unroll
    for (int j = 0; j < 4; ++j) ss += acc[j].x * acc[j].x + acc[j].y * acc[j].y + acc[j].z * acc[j].z + acc[j].w * acc[j].w;
    const float rstd = rsqrtf(wave_sum(ss) * (1.f / DM) + EPS);
#pragma unroll
    for (int j = 0; j < 4; ++j) {
        const int k = 4 * lane + 256 * j;
        const f32x4 xl = *(const f32x4*)(XLAT + (size_t)row * DM + k), nw = *(const f32x4*)(norm_w + 3072 + k), gt = *(const f32x4*)(MOD + b * 6144 + 5120 + k);
        *(f32x4*)(out + (size_t)row * DM + k) = xl + gt * (acc[j] * rstd * nw);
    }
}

extern "C" void kernel_launch(void* const* d_in, const int* in_sizes, int n_in, void* d_out, int out_size, void* d_ws, size_t ws_size, hipStream_t stream) {
    if (ws_size < WS_END) { fprintf(stderr, "kernel_launch: workspace too small: %zu < %zu\n", ws_size, (size_t)WS_END); return; }
    const float* x = (const float*)d_in[0]; const float* c = (const float*)d_in[1]; const float* ctx = (const float*)d_in[2]; const float* c_ctx = (const float*)d_in[3];
    const float* ada_w = (const float*)d_in[4]; const float* ada_b = (const float*)d_in[5]; const float* norm_w = (const float*)d_in[6]; const float* w_in = (const float*)d_in[7];
    const float* conv_w = (const float*)d_in[8]; const float* conv_b = (const float*)d_in[9]; const float* dt_bias = (const float*)d_in[10]; const float* a_log = (const float*)d_in[11];
    const float* ssd_d = (const float*)d_in[12]; const float* ssd_nw = (const float*)d_in[13]; const float* hgrn_lb = (const float*)d_in[14]; const float* hgrn_nw = (const float*)d_in[15];
    const float* w_out = (const float*)d_in[16]; const float* w_router = (const float*)d_in[17]; const float* w_gate = (const float*)d_in[18]; const float* w_up = (const float*)d_in[19];
    const float* w_down = (const float*)d_in[20];
    char* ws = (char*)d_ws; float* out = (float*)d_out;
    float* MOD = (float*)(ws + WS_MOD); float* DT = (float*)(ws + WS_DT); float* WDT = (float*)(ws + WS_WDT); float* AFF = (float*)(ws + WS_AFF);
    int* IDX = (int*)(ws + WS_IDX); float* GATEV = (float*)(ws + WS_GATEV); int* SLOT = (int*)(ws + WS_SLOT);
    f16* WIN = (f16*)(ws + WS_WIN); f16* WOUT = (f16*)(ws + WS_WOUT); f16* WGU = (f16*)(ws + WS_WGU); f16* WD = (f16*)(ws + WS_WD);
    f16* H = (f16*)(ws + WS_H); f16* U = (f16*)(ws + WS_U); f16* Y = (f16*)(ws + WS_Y);
    f16* XBC = H; f16* H2 = H; float* R = (float*)(ws + WS_R); f16* ACT = (f16*)(ws + WS_ACT); f16* YM = (f16*)(ws + WS_YM);
    float* YS = out; float* OH = out + (size_t)MLAT * 512; float* XLAT = out;

    k_mods<<<24, 256, 0, stream>>>(c, c_ctx, ada_w, ada_b, MOD);
    k_tr_win<<<dim3(128, 32), 256, 0, stream>>>(w_in, WIN);
    k_tr_wdt<<<64, 256, 0, stream>>>(w_in, WDT);
    k_tr_wout<<<dim3(32, 32), 256, 0, stream>>>(w_out, WOUT);
    k_tr_gu<<<dim3(64, 32, 16), 256, 0, stream>>>(w_gate, w_up, WGU);
    k_tr_wd<<<dim3(32, 32, 16), 256, 0, stream>>>(w_down, WD);
    k_hrows<<<MTOT / 4, 256, 0, stream>>>(x, ctx, norm_w, MOD, WDT, H, DT);
    k_gemm_in<<<dim3(NU / 128, MTOT / 128), 256, 0, stream>>>(H, WIN, U);
    k_conv<<<(MTOT * 1024) / 256, 256, 0, stream>>>(U, conv_w, conv_b, XBC);
    k_ssd_seq<<<32, 256, 0, stream>>>(XBC, DT, dt_bias, a_log, YS, 0, 0);
    k_ssd_seq<<<32, 256, 0, stream>>>(XBC, DT, dt_bias, a_log, YS, 1, 1);
    k_hgrn_seq<<<16, 512, 0, stream>>>(U, hgrn_lb, OH, 0, 0);
    k_hgrn_seq<<<16, 512, 0, stream>>>(U, hgrn_lb, OH, 1, 1);
    k_mix_out<<<MLAT / 4, 256, 0, stream>>>(U, XBC, YS, OH, ssd_d, ssd_nw, hgrn_nw, Y);
    k_gemm_out<<<dim3(DM / 128, MLAT / 128), 256, 0, stream>>>(Y, WOUT, R);
    k_post<<<1024, 256, 0, stream>>>(x, R, norm_w, MOD, w_router, XLAT, H2, AFF);
    k_topk<<<64, 512, 0, stream>>>(AFF, IDX, GATEV, SLOT);
    k_gemm_gu<<<dim3(8, 8, 64), 256, 0, stream>>>(H2, IDX, WGU, ACT);
    k_gemm_down<<<dim3(8, 8, 64), 256, 0, stream>>>(ACT, WD, GATEV, YM);
    k_combine<<<MLAT / 4, 256, 0, stream>>>(XLAT, YM, SLOT, norm_w, MOD, out);
}
```

```cpp
#include <hip/hip_runtime.h>
#include <cstdio>
#include <cstdint>

#define DI __device__ __forceinline__
typedef _Float16 f16;
typedef _Float16 f16x8 __attribute__((ext_vector_type(8)));
typedef _Float16 f16x4 __attribute__((ext_vector_type(4)));
typedef float f32x4 __attribute__((ext_vector_type(4)));

constexpr int DM = 1024, NB = 4, SEQ = 8192, CTXL = 256;
constexpr int MLAT = NB * SEQ;
constexpr int MCTX = NB * CTXL;
constexpr int MTOT = MLAT + MCTX;
constexpr int INCOLS = 4112, NU = 4096;
constexpr int UZ = 0, UXBC = 512, UQ = 1536, UFF = 2048, UFB = 2560, UI = 3072, UG = 3584;
constexpr int NE = 16, FF = 1024, CAP = 1024;
constexpr float EPS = 1e-6f;

constexpr size_t MiB = 1u << 20;
constexpr size_t WS_MOD = 1 * MiB;
constexpr size_t WS_DT = 2 * MiB;
constexpr size_t WS_WDT = 5 * MiB;
constexpr size_t WS_AFF = 6 * MiB;
constexpr size_t WS_IDX = 8 * MiB;
constexpr size_t WS_GATEV = 8 * MiB + 256 * 1024;
constexpr size_t WS_SLOT = 9 * MiB;
constexpr size_t WS_WIN = 12 * MiB;
constexpr size_t WS_WOUT = 20 * MiB;
constexpr size_t WS_WGU = 22 * MiB;
constexpr size_t WS_WD = 86 * MiB;
constexpr size_t WS_H = 118 * MiB;
constexpr size_t WS_U = 184 * MiB;
constexpr size_t WS_Y = 448 * MiB;
constexpr size_t WS_END = 512 * MiB;
constexpr size_t WS_ACT = WS_U;
constexpr size_t WS_YM = WS_U + 128 * MiB;
constexpr size_t WS_R = WS_U;

DI float silu_f(float x) { return x / (1.f + __expf(-x)); }
DI float sigmoid_f(float x) { return 1.f / (1.f + __expf(-x)); }
DI float softplus_f(float x) { return x > 20.f ? x : log1pf(__expf(x)); }
DI float wave_sum(float v) {
#pragma unroll
    for (int o = 1; o < 64; o <<= 1) v += __shfl_xor(v, o);
    return v;
}

#define LAS __attribute__((address_space(3)))
typedef unsigned u32x4 __attribute__((ext_vector_type(4)));
namespace gm {
constexpr int BM = 256, BK = 64, HALF = 128, HTB = HALF * BK * 2, STAGE_BYTES = 8 * HTB, NXCD = 8, WGM = 8, KD = 1024, NT = KD / BK;
DI int lds_byte(int r, int c) { const int st = (r >> 4) * 2 + (c >> 5), rr = r & 15, cc = c & 31, ob = rr * 64 + cc * 2; return st * 1024 + (ob ^ (((ob >> 9) & 1) << 5)); }
DI void stage_rc(int b, int& R, int& C) { const int st = b / 1024, sb = b % 1024, swz = sb ^ (((sb >> 9) & 1) << 5); R = (st >> 1) * 16 + swz / 64; C = (st & 1) * 32 + (swz % 64) / 2; }
DI int perm32(int rho) { const int n = rho >> 4, i = rho & 15; return 8 * (i >> 2) + 4 * n + (i & 3); }
struct Unit { int pm, pn; };
DI bool unit_at(int i, int G, int c, int nM, int nN, Unit& u) {
    const int nwg = nM * nN; const long L = (long)i * G + c; if (L >= nwg) return false;
    int wgid = (int)L; { const int q = nwg / NXCD, r = nwg % NXCD, xcd = wgid % NXCD, off = wgid / NXCD; wgid = (xcd < r ? xcd * (q + 1) : r * (q + 1) + (xcd - r) * q) + off; }
    const int nig = WGM * nN, gid = wgid / nig, fm = gid * WGM, gsz = (nM - fm) < WGM ? (nM - fm) : WGM;
    u.pm = fm + ((wgid % nig) % gsz); u.pn = (wgid % nig) / gsz; return true;
}
typedef f32x4 Acc[2][2][4][2];
DI unsigned pack2(float a, float b) { typedef _Float16 h2 __attribute__((ext_vector_type(2))); h2 v; v.x = (f16)a; v.y = (f16)b; return __builtin_bit_cast(unsigned, v); }

template <class P>
DI void gemm_phase(LAS unsigned char* lds, const P& p, int G, int c) {
    const int tid = threadIdx.x, wid = __builtin_amdgcn_readfirstlane(tid >> 6), lane = tid & 63, wr = wid >> 2, wc = wid & 3, fr = lane & 15, fq = lane >> 4;
    constexpr int K = KD, nt = NT;
    int Rr[2], Cc[2]; unsigned voffB[2];
#pragma unroll
    for (int i = 0; i < 2; ++i) { stage_rc(tid * 16 + i * 8192, Rr[i], Cc[i]); const int Rb = P::PERM ? ((Rr[i] & ~31) + perm32(Rr[i] & 31)) : Rr[i]; voffB[i] = (unsigned)(Rb * K + Cc[i]) * 2u; }
    const size_t kstep = (size_t)(BK * 2);
    const size_t hstep = (size_t)HALF * K * 2;
    const unsigned ldsw = (unsigned)wid * 1024u;
    const int aoff = lds_byte(wr * 64 + fr, fq * 8), boff = lds_byte(wc * 32 + fr, fq * 8);
#define G_SA(b, h) (((b) * 2 + (h)) * HTB)
#define G_SB(b, h) ((4 + (b) * 2 + (h)) * HTB)
#define G_STAGEB(bufoff, gbase) do { _Pragma("unroll") for (int _i = 0; _i < 2; ++_i) \
        __builtin_amdgcn_global_load_lds((const unsigned*)((const char*)(gbase) + voffB[_i]), (LAS unsigned*)(lds + (bufoff) + ldsw + _i * 8192), 16, 0, 0); } while (0)
#define G_STAGEA(bufoff, offs, h, koff) do { _Pragma("unroll") for (int _i = 0; _i < 2; ++_i) \
        __builtin_amdgcn_global_load_lds((const unsigned*)(gA + (offs)[h][_i] + (koff)), (LAS unsigned*)(lds + (bufoff) + ldsw + _i * 8192), 16, 0, 0); } while (0)
#define G_LDA(dst, b, h) do { _Pragma("unroll") for (int m = 0; m < 4; ++m) _Pragma("unroll") for (int k = 0; k < 2; ++k) dst[m][k] = *(const LAS f16x8*)(lds + G_SA(b, h) + aoff + m * 2048 + k * 1024); } while (0)
#define G_LDB(dst, b, h) do { _Pragma("unroll") for (int n = 0; n < 2; ++n) _Pragma("unroll") for (int k = 0; k < 2; ++k) dst[n][k] = *(const LAS f16x8*)(lds + G_SB(b, h) + boff + n * 2048 + k * 1024); } while (0)
#define G_MMA(ai, bj, At, Bt) do { __builtin_amdgcn_s_setprio(1); _Pragma("unroll") for (int m = 0; m < 4; ++m) _Pragma("unroll") for (int n = 0; n < 2; ++n) _Pragma("unroll") for (int k = 0; k < 2; ++k) \
        acc[ai][bj][m][n] = __builtin_amdgcn_mfma_f32_16x16x32_f16(Bt[n][k], At[m][k], acc[ai][bj][m][n], 0, 0, 0); __builtin_amdgcn_s_setprio(0); } while (0)
#define G_WAIT_V(n) asm volatile("s_waitcnt vmcnt(" #n ")" ::: "memory")
#define G_WAIT_L(n) asm volatile("s_waitcnt lgkmcnt(" #n ")" ::: "memory")
#define G_BAR __builtin_amdgcn_s_barrier()
#define G_SCHED __builtin_amdgcn_sched_barrier(0)
    Unit cur, nxt; int ui = 0;
    if (!unit_at(0, G, c, P::nM, P::nN, cur)) return;
    Acc acc;
#pragma unroll
    for (int a = 0; a < 2; ++a)
#pragma unroll
        for (int b = 0; b < 2; ++b)
#pragma unroll
            for (int m = 0; m < 4; ++m)
#pragma unroll
                for (int n = 0; n < 2; ++n) acc[a][b][m][n] = (f32x4){0.f, 0.f, 0.f, 0.f};
    f16x8 At[4][2], B0[2][2], B1[2][2];
    const char* gA = (const char*)p.A;
    unsigned offC[2][2], offN[2][2];
#pragma unroll
    for (int h = 0; h < 2; ++h)
#pragma unroll
        for (int i = 0; i < 2; ++i) offC[h][i] = p.arow(0, cur, 128 * h + Rr[i]) * (unsigned)(K * 2) + (unsigned)Cc[i] * 2u;
    const char* cB = p.bptr(cur);
    G_STAGEB(G_SB(0, 0), cB); G_STAGEA(G_SA(0, 0), offC, 0, 0); G_STAGEB(G_SB(0, 1), cB + hstep); G_STAGEA(G_SA(0, 1), offC, 1, 0);
    if (wr == 1) G_BAR;
    G_WAIT_V(4); G_BAR;
    G_STAGEB(G_SB(1, 0), cB + kstep); G_STAGEA(G_SA(1, 0), offC, 0, kstep); G_STAGEB(G_SB(1, 1), cB + hstep + kstep);
    G_WAIT_V(6); G_BAR;
    for (;;) {
        const bool has_next = unit_at(ui + 1, G, c, P::nM, P::nN, nxt);
        const char* nB = has_next ? p.bptr(nxt) : cB;
#pragma unroll
        for (int h = 0; h < 2; ++h)
#pragma unroll
            for (int i = 0; i < 2; ++i) offN[h][i] = has_next ? p.arow(ui + 1, nxt, 128 * h + Rr[i]) * (unsigned)(K * 2) + (unsigned)Cc[i] * 2u : offC[h][i];
        for (int t = 0; t < nt; t += 2) {
            const bool last = (t == nt - 2);
            const size_t k1 = (size_t)(t + 1) * kstep;
            const size_t k2 = last ? 0 : (size_t)(t + 2) * kstep, k3 = k2 + kstep;
            const char* b2 = last ? nB : cB + (size_t)(t + 2) * kstep; const char* b3 = b2 + kstep;
            unsigned o2[2][2];
#pragma unroll
            for (int h = 0; h < 2; ++h)
#pragma unroll
                for (int i = 0; i < 2; ++i) o2[h][i] = last ? offN[h][i] : offC[h][i];
            G_LDB(B0, 0, 0); G_SCHED; G_LDA(At, 0, 0); G_STAGEA(G_SA(1, 1), offC, 1, k1);
            G_WAIT_L(8); G_BAR; G_WAIT_L(0); G_MMA(0, 0, At, B0); G_BAR; G_SCHED;
            G_LDB(B1, 0, 1); G_STAGEB(G_SB(0, 0), b2);
            G_BAR; G_WAIT_L(0); G_MMA(0, 1, At, B1); G_BAR;
            G_LDA(At, 0, 1); G_STAGEA(G_SA(0, 0), o2, 0, k2);
            G_BAR; G_WAIT_L(0); G_MMA(1, 0, At, B0); G_BAR; G_SCHED;
            G_STAGEB(G_SB(0, 1), b2 + hstep);
            G_WAIT_V(6); G_BAR; G_MMA(1, 1, At, B1); G_BAR;
            G_LDB(B0, 1, 0); G_SCHED; G_LDA(At, 1, 0); G_STAGEA(G_SA(0, 1), o2, 1, k2);
            G_WAIT_L(8); G_BAR; G_WAIT_L(0); G_MMA(0, 0, At, B0); G_BAR; G_SCHED;
            G_LDB(B1, 1, 1); G_STAGEB(G_SB(1, 0), b3);
            G_BAR; G_WAIT_L(0); G_MMA(0, 1, At, B1); G_BAR;
            G_LDA(At, 1, 1); G_STAGEA(G_SA(1, 0), o2, 0, k3);
            G_BAR; G_WAIT_L(0); G_MMA(1, 0, At, B0); G_BAR; G_SCHED;
            G_STAGEB(G_SB(1, 1), b3 + hstep);
            G_WAIT_V(6); G_BAR; G_MMA(1, 1, At, B1); G_BAR;
        }
        p.epi(acc, cur, wr, wc, fr, fq);
        if (!has_next) break;
#pragma unroll
        for (int a = 0; a < 2; ++a)
#pragma unroll
            for (int b = 0; b < 2; ++b)
#pragma unroll
                for (int m = 0; m < 4; ++m)
#pragma unroll
                    for (int n = 0; n < 2; ++n) acc[a][b][m][n] = (f32x4){0.f, 0.f, 0.f, 0.f};
        cur = nxt; cB = nB; ++ui;
#pragma unroll
        for (int h = 0; h < 2; ++h)
#pragma unroll
            for (int i = 0; i < 2; ++i) offC[h][i] = offN[h][i];
    }
    G_WAIT_V(0);
    if (wr == 0) G_BAR;
    G_BAR;
#undef G_SA
#undef G_SB
#undef G_STAGEA
#undef G_STAGEB
#undef G_LDA
#undef G_LDB
#undef G_MMA
#undef G_WAIT_V
#undef G_WAIT_L
#undef G_BAR
#undef G_SCHED
}

struct ProbIn {
    static constexpr int nM = MTOT / 256, nN = NU / 256; static constexpr bool PERM = true;
    const f16* A; const f16* BT; f16* U;
    DI unsigned arow(int, const Unit& u, int r) const { return (unsigned)(u.pm * 256 + r); }
    DI const char* bptr(const Unit& u) const { return (const char*)(BT + (size_t)u.pn * 256 * KD); }
    DI void epi(const Acc& acc, const Unit& u, int wr, int wc, int fr, int fq) const {
        const int row0 = u.pm * BM + wr * 64 + fr, col0 = u.pn * BM + wc * 32 + 8 * fq;
#pragma unroll
        for (int ai = 0; ai < 2; ++ai)
#pragma unroll
            for (int m = 0; m < 4; ++m) { f16* rowp = U + (size_t)(row0 + ai * HALF + m * 16) * NU + col0;
#pragma unroll
                for (int bj = 0; bj < 2; ++bj) { const f32x4 v0 = acc[ai][bj][m][0], v1 = acc[ai][bj][m][1];
                    u32x4 w; w.x = pack2(v0[0], v0[1]); w.y = pack2(v0[2], v0[3]); w.z = pack2(v1[0], v1[1]); w.w = pack2(v1[2], v1[3]);
                    *(u32x4*)(rowp + bj * HALF) = w; } }
    }
};
struct ProbOut {
    static constexpr int nM = MLAT / 256, nN = DM / 256; static constexpr bool PERM = false;
    const f16* A; const f16* BT; float* R;
    DI unsigned arow(int, const Unit& u, int r) const { return (unsigned)(u.pm * 256 + r); }
    DI const char* bptr(const Unit& u) const { return (const char*)(BT + (size_t)u.pn * 256 * KD); }
    DI void epi(const Acc& acc, const Unit& u, int wr, int wc, int fr, int fq) const {
        const int row0 = u.pm * BM + wr * 64 + fr, col0 = u.pn * BM + wc * 32 + 4 * fq;
#pragma unroll
        for (int ai = 0; ai < 2; ++ai)
#pragma unroll
            for (int m = 0; m < 4; ++m) { float* rowp = R + (size_t)(row0 + ai * HALF + m * 16) * DM + col0;
#pragma unroll
                for (int bj = 0; bj < 2; ++bj)
#pragma unroll
                    for (int n = 0; n < 2; ++n) *(f32x4*)(rowp + bj * HALF + n * 16) = acc[ai][bj][m][n]; }
    }
};
struct ProbGU {
    static constexpr int nM = (NE * NB * CAP) / 256, nN = 2048 / 256; static constexpr bool PERM = true;
    const f16* A; const f16* BT; f16* ACT; const int* IDX; const LAS int* tab;
    DI unsigned arow(int ui, const Unit& u, int r) const { return (unsigned)tab[ui * 256 + r]; }
    DI const char* bptr(const Unit& u) const { return (const char*)(BT + ((size_t)(u.pm >> 4) * 2048 + (size_t)u.pn * 256) * KD); }
    DI void epi(const Acc& acc, const Unit& u, int wr, int wc, int fr, int fq) const {
        const int row0 = u.pm * BM + wr * 64 + fr, col0 = u.pn * 128 + wc * 32 + 8 * fq;
#pragma unroll
        for (int ai = 0; ai < 2; ++ai)
#pragma unroll
            for (int m = 0; m < 4; ++m) { f16* rowp = ACT + (size_t)(row0 + ai * HALF + m * 16) * FF + col0;
                const f32x4 g0 = acc[ai][0][m][0], g1 = acc[ai][0][m][1], u0 = acc[ai][1][m][0], u1 = acc[ai][1][m][1];
                u32x4 w; w.x = pack2(silu_f(g0[0]) * u0[0], silu_f(g0[1]) * u0[1]); w.y = pack2(silu_f(g0[2]) * u0[2], silu_f(g0[3]) * u0[3]);
                w.z = pack2(silu_f(g1[0]) * u1[0], silu_f(g1[1]) * u1[1]); w.w = pack2(silu_f(g1[2]) * u1[2], silu_f(g1[3]) * u1[3]);
                *(u32x4*)rowp = w; }
    }
};
struct ProbDown {
    static constexpr int nM = (NE * NB * CAP) / 256, nN = DM / 256; static constexpr bool PERM = true;
    const f16* A; const f16* BT; f16* YM; const float* GV;
    DI unsigned arow(int, const Unit& u, int r) const { return (unsigned)(u.pm * 256 + r); }
    DI const char* bptr(const Unit& u) const { return (const char*)(BT + ((size_t)(u.pm >> 4) * 1024 + (size_t)u.pn * 256) * KD); }
    DI void epi(const Acc& acc, const Unit& u, int wr, int wc, int fr, int fq) const {
        const int row0 = u.pm * BM + wr * 64 + fr, col0 = u.pn * BM + wc * 32 + 8 * fq;
#pragma unroll
        for (int ai = 0; ai < 2; ++ai)
#pragma unroll
            for (int m = 0; m < 4; ++m) { const int row = row0 + ai * HALF + m * 16; const float g = GV[row]; f16* rowp = YM + (size_t)row * DM + col0;
#pragma unroll
                for (int bj = 0; bj < 2; ++bj) { const f32x4 v0 = acc[ai][bj][m][0] * g, v1 = acc[ai][bj][m][1] * g;
                    u32x4 w; w.x = pack2(v0[0], v0[1]); w.y = pack2(v0[2], v0[3]); w.z = pack2(v1[0], v1[1]); w.w = pack2(v1[2], v1[3]);
                    *(u32x4*)(rowp + bj * HALF) = w; } }
    }
};
}

#define XB_TMO      128
#define XB_XCNT(j)  (256  + 64 * (j))
#define XB_XSUB(j)  (1280 + 64 * (j))
#define XB_XGEN(j)  (2304 + 64 * (j))
#define XB_TOP      3328
#define XB_TOPGEN   3392
#define XCD_BAR_WORDS 3456
#define XB_SPIN_CAP (1u << 22)
DI unsigned xb_ld(unsigned* p)              { return __hip_atomic_load(p, __ATOMIC_RELAXED, __HIP_MEMORY_SCOPE_AGENT); }
DI unsigned xb_add(unsigned* p, unsigned v) { return __hip_atomic_fetch_add(p, v, __ATOMIC_RELAXED, __HIP_MEMORY_SCOPE_AGENT); }
DI unsigned xb_xcc_id() { return (unsigned)__builtin_amdgcn_s_getreg((3 << 11) | 20) & 0xFu; }
#define XB_SPIN(cond, bar) do { unsigned _sp = 0; while (cond) { __builtin_amdgcn_s_sleep(1); \
    if ((++_sp & 255u) == 0u) { if (xb_ld(&(bar)[XB_TMO])) break; if (_sp > XB_SPIN_CAP) { atomicAdd(&(bar)[XB_TMO], 1u); break; } } } } while (0)
struct XcdBarrier { unsigned* bar; unsigned x; volatile LAS unsigned* st; };
DI XcdBarrier xcd_barrier_post(unsigned* bar, volatile LAS unsigned* st) {
    XcdBarrier b; b.bar = bar; b.x = xb_xcc_id(); b.st = st;
    if (threadIdx.x == 0) (void)xb_add(&bar[XB_XCNT(b.x)], 1u);
    return b;
}
DI void xcd_barrier_complete(unsigned* bar, unsigned x, unsigned& nloc, unsigned& nx) {
    const unsigned G = gridDim.x * gridDim.y * gridDim.z;
    unsigned sum, cnt, mine, sp = 0u;
    for (;;) {
        sum = 0u; cnt = 0u; mine = 0u;
#pragma unroll
        for (unsigned j = 0; j < 16; ++j) { const unsigned c = xb_ld(&bar[XB_XCNT(j)]); sum += c; cnt += (c > 0u) ? 1u : 0u; mine = (j == x) ? c : mine; }
        if (sum == G) break;
        __builtin_amdgcn_s_sleep(1);
        if ((++sp & 255u) == 0u) { if (xb_ld(&bar[XB_TMO])) break; if (sp > XB_SPIN_CAP) { atomicAdd(&bar[XB_TMO], 1u); break; } }
    }
    nloc = mine > 0u ? mine : 1u; nx = cnt > 0u ? cnt : 1u;
}
DI void xcd_barrier(const XcdBarrier& b) {
    asm volatile("s_waitcnt vmcnt(0)" ::: "memory");
    __syncthreads();
    if (threadIdx.x == 0) {
        unsigned* bar = b.bar;
        __builtin_amdgcn_s_waitcnt(0);
        unsigned nloc = b.st[0], nx = b.st[1];
        if (nloc == 0u) { xcd_barrier_complete(bar, b.x, nloc, nx); b.st[0] = nloc; b.st[1] = nx; }
        const unsigned old = xb_add(&bar[XB_XSUB(b.x)], 1u);
        const unsigned gen = old / nloc;
        if (old + 1u == (gen + 1u) * nloc) {
            __builtin_amdgcn_fence(__ATOMIC_RELEASE, "agent");
            asm volatile("s_waitcnt vmcnt(0)" ::: "memory");
            const unsigned og = xb_add(&bar[XB_TOP], 1u);
            const unsigned tg = og / nx;
            if (og + 1u == (tg + 1u) * nx) xb_add(&bar[XB_TOPGEN], 1u);
            else XB_SPIN(xb_ld(&bar[XB_TOPGEN]) == tg, bar);
            __builtin_amdgcn_fence(__ATOMIC_ACQUIRE, "agent");
            xb_add(&bar[XB_XGEN(b.x)], 1u);
            asm volatile("s_waitcnt vmcnt(0)" ::: "memory");
        } else {
            XB_SPIN(xb_ld(&bar[XB_XGEN(b.x)]) == gen, bar);
            __builtin_amdgcn_fence(__ATOMIC_ACQUIRE, "agent");
            asm volatile("s_waitcnt vmcnt(0)" ::: "memory");
        }
    }
    __syncthreads();
}

constexpr int LDS_TAB_OFF = 131072;
constexpr int LDS_MISC_OFF = 131072 + 8192;
constexpr int LDS_BYTES = 147456;
constexpr size_t WS_BAR = 0;
constexpr size_t WS_CTL_BYTES = 65536;
struct Args { const float* in[21]; float* out; unsigned char* ws; int ph_lo, ph_hi; };
enum { PH_PREP = 0, PH_HROWS, PH_GEMM_IN, PH_CONV, PH_SEQ_F, PH_SEQ_B, PH_MIXOUT, PH_GEMM_OUT, PH_POST, PH_TOPK, PH_GEMM_GU, PH_GEMM_DOWN, PH_COMBINE, PH_COUNT };

struct Ctx {
    LAS unsigned char* lds; int tid, lane, wave, G, c;
    const float *x, *cvec, *ctx, *c_ctx, *ada_w, *ada_b, *norm_w, *w_in, *conv_w, *conv_b, *dt_bias, *a_log, *ssd_d, *ssd_nw, *hgrn_lb, *hgrn_nw, *w_out, *w_router, *w_gate, *w_up, *w_down;
    float* out;
    float *MOD, *DT, *WDT, *AFF, *GATEV, *R, *YS, *OH, *XLAT; int *IDX, *SLOT;
    f16 *WIN, *WOUT, *WGU, *WD, *H, *U, *Y, *XBC, *H2, *ACT, *YM;
};

DI void tr_item(const float* src, int ld, int col0, int k0, f16* dst_row0, int ldd, LAS float* scr, int lane) {
#pragma unroll 8
    for (int i = 0; i < 32; ++i) { const int kk = 2 * i + (lane >> 5); scr[kk * 33 + (lane & 31)] = src[(size_t)(k0 + kk) * ld + col0 + (lane & 31)]; }
    asm volatile("s_waitcnt lgkmcnt(0)" ::: "memory");
    const int cc = lane & 7;
#pragma unroll
    for (int j = 0; j < 4; ++j) { const int n = (lane >> 3) + 8 * j; const LAS float* s = scr + (8 * cc) * 33 + n;
        u32x4 o; o.x = gm::pack2(s[0 * 33], s[1 * 33]); o.y = gm::pack2(s[2 * 33], s[3 * 33]); o.z = gm::pack2(s[4 * 33], s[5 * 33]); o.w = gm::pack2(s[6 * 33], s[7 * 33]);
        *(u32x4*)(dst_row0 + (size_t)n * ldd + k0 + 8 * cc) = o; }
    asm volatile("s_waitcnt lgkmcnt(0)" ::: "memory");
}
DI void phase_prep(const Ctx& F) {
    {
        LAS float* sv = (LAS float*)F.lds;
        LAS float* red = sv + 5 * DM;
        for (int i = F.tid; i < 5 * DM; i += 512) { const int r = i >> 10, k = i & 1023; sv[i] = silu_f(r < 4 ? F.cvec[r * DM + k] : F.c_ctx[k]); }
        __syncthreads();
        const int col = F.tid % 24, kg = F.tid / 24, j = F.c * 24 + col;
        if (kg < 21) {
            float a[5] = {0, 0, 0, 0, 0};
            for (int k = kg; k < DM; k += 21) { const float w = F.ada_w[(size_t)k * 6144 + j];
#pragma unroll
                for (int r = 0; r < 5; ++r) a[r] += sv[r * DM + k] * w; }
#pragma unroll
            for (int r = 0; r < 5; ++r) red[(kg * 24 + col) * 5 + r] = a[r];
        }
        __syncthreads();
        if (F.tid < 120) { const int cl = F.tid % 24, r = F.tid / 24; float s = 0.f; for (int g = 0; g < 21; ++g) s += red[(g * 24 + cl) * 5 + r]; const int jj = F.c * 24 + cl; F.MOD[r * 6144 + jj] = s + F.ada_b[jj]; }
        __syncthreads();
    }
    for (int i = F.c * 512 + F.tid; i < 16 * DM; i += F.G * 512) { const int j = i >> 10, k = i & 1023; F.WDT[i] = F.w_in[(size_t)k * INCOLS + 1536 + j]; }
    LAS float* scr = (LAS float*)(F.lds + F.wave * 8704);
    const int gw = F.c * 8 + F.wave, NGW = F.G * 8;
    constexpr int I_IN = 16 * 128, I_OUT = 16 * 32, I_GU = 16 * 16 * 64, I_D = 16 * 16 * 32;
    for (int it = gw; it < I_IN + I_OUT + I_GU + I_D; it += NGW) {
        int r = it;
        if (r < I_IN) { const int kb = r / 128, nb = r % 128, n0 = nb * 32; tr_item(F.w_in, INCOLS, n0 < 1536 ? n0 : n0 + 16, kb * 64, F.WIN + (size_t)n0 * DM, DM, scr, F.lane); continue; } r -= I_IN;
        if (r < I_OUT) { const int kb = r / 32, nb = r % 32; tr_item(F.w_out, DM, nb * 32, kb * 64, F.WOUT + (size_t)nb * 32 * DM, DM, scr, F.lane); continue; } r -= I_OUT;
        if (r < I_GU) { const int e = r / 1024, q = r % 1024, kb = q / 64, nb = q % 64, r0 = nb * 32, blk = r0 >> 7, within = r0 & 127, isu = blk & 1, f0 = (blk >> 1) * 128 + within;
            tr_item((isu ? F.w_up : F.w_gate) + (size_t)e * DM * FF, FF, f0, kb * 64, F.WGU + ((size_t)e * 2048 + r0) * DM, DM, scr, F.lane); continue; } r -= I_GU;
        { const int e = r / 512, q = r % 512, kb = q / 32, nb = q % 32; tr_item(F.w_down + (size_t)e * FF * DM, DM, nb * 32, kb * 64, F.WD + ((size_t)e * DM + nb * 32) * FF, FF, scr, F.lane); }
    }
}

DI void phase_hrows(const Ctx& F) {
    const int gw = F.c * 8 + F.wave, NGW = F.G * 8, lane = F.lane;
    for (int row = gw; row < MTOT; row += NGW) {
        const float* xr = row < MLAT ? F.x + (size_t)row * DM : F.ctx + (size_t)(row - MLAT) * DM;
        const int r = row < MLAT ? row / SEQ : 4;
        const float* shift = F.MOD + r * 6144, *scale = F.MOD + r * 6144 + 1024;
        f32x4 v[4]; float ss = 0.f;
#pragma unroll
        for (int j = 0; j < 4; ++j) { v[j] = *(const f32x4*)(xr + 4 * lane + 256 * j); ss += v[j].x * v[j].x + v[j].y * v[j].y + v[j].z * v[j].z + v[j].w * v[j].w; }
        const float rstd = rsqrtf(wave_sum(ss) * (1.f / DM) + EPS);
#pragma unroll
        for (int j = 0; j < 4; ++j) {
            const int k = 4 * lane + 256 * j;
            const f32x4 nw = *(const f32x4*)(F.norm_w + k), sc = *(const f32x4*)(scale + k), sh = *(const f32x4*)(shift + k);
            v[j] = v[j] * rstd * nw * (1.f + sc) + sh;
            f16x4 o; o.x = (f16)v[j].x; o.y = (f16)v[j].y; o.z = (f16)v[j].z; o.w = (f16)v[j].w;
            *(f16x4*)(F.H + (size_t)row * DM + k) = o;
        }
        float mine = 0.f;
        for (int d = 0; d < 16; ++d) {
            float p = 0.f;
#pragma unroll
            for (int j = 0; j < 4; ++j) { const f32x4 w = *(const f32x4*)(F.WDT + d * DM + 4 * lane + 256 * j); p += v[j].x * w.x + v[j].y * w.y + v[j].z * w.z + v[j].w * w.w; }
            p = wave_sum(p);
            mine = lane == d ? p : mine;
        }
        if (lane < 16) F.DT[(size_t)row * 16 + lane] = mine;
    }
}

DI void phase_conv(const Ctx& F) {
    for (size_t i = (size_t)F.c * 512 + F.tid; i < (size_t)MTOT * 1024; i += (size_t)F.G * 512) {
        const int row = (int)(i >> 10), c = (int)(i & 1023);
        int s0, s1;
        if (row < MLAT) { s0 = row & ~63; s1 = s0 + 64; } else { s0 = MLAT + ((row - MLAT) & ~255); s1 = s0 + 256; }
        float a = F.conv_b[c];
#pragma unroll
        for (int j = 0; j < 5; ++j) { const int r = row + j - 2; if (r >= s0 && r < s1) a += F.conv_w[j * 1024 + c] * (float)F.U[(size_t)r * NU + UXBC + c]; }
        F.XBC[i] = (f16)silu_f(a);
    }
}
DI void ssd_seq_unit(const Ctx& F, int b, int h, int dir, int accum) {
    LAS float* xs = (LAS float*)F.lds;
    LAS float* Bm = xs + 64 * 64;
    LAS float* Cm = Bm + 64 * 128;
    LAS float* yt = Cm + 64 * 128;
    LAS float* av = yt + 64 * 64;
    LAS float* dtv = av + 64;
    const int g = h >> 2, tid = F.tid, p = tid >> 3, nq = tid & 7;
    const float aneg = -__expf(F.a_log[dir * 8 + h]), dtb = F.dt_bias[dir * 8 + h];
    float st[16];
#pragma unroll
    for (int i = 0; i < 16; ++i) st[i] = 0.f;
    const int ntile = (CTXL + SEQ) / 64;
    for (int tl = 0; tl < ntile; ++tl) {
        const bool isctx = tl < 4;
        int base;
        if (isctx) base = MLAT + b * CTXL + (dir == 0 ? tl * 64 : CTXL - 1 - tl * 64);
        else base = b * SEQ + (dir == 0 ? (tl - 4) * 64 : SEQ - 1 - (tl - 4) * 64);
        const int step = dir == 0 ? 1 : -1;
        __syncthreads();
        for (int i = tid; i < 64 * 64; i += 512) { const int t = i >> 6, c = i & 63; xs[i] = (float)F.XBC[(size_t)(base + step * t) * 1024 + h * 64 + c]; }
        for (int i = tid; i < 64 * 128; i += 512) { const int t = i >> 7, c = i & 127; const size_t ro = (size_t)(base + step * t) * 1024; Bm[i] = (float)F.XBC[ro + 512 + g * 128 + c]; Cm[i] = (float)F.XBC[ro + 768 + g * 128 + c]; }
        if (tid < 64) { const float d = softplus_f(F.DT[(size_t)(base + step * tid) * 16 + dir * 8 + h] + dtb); dtv[tid] = d; av[tid] = __expf(d * aneg); }
        __syncthreads();
        for (int t = 0; t < 64; ++t) {
            const float a = av[t], xd = xs[t * 64 + p] * dtv[t];
            float y = 0.f;
#pragma unroll
            for (int i = 0; i < 16; ++i) { st[i] = a * st[i] + xd * Bm[t * 128 + nq * 16 + i]; y += st[i] * Cm[t * 128 + nq * 16 + i]; }
            y += __shfl_xor(y, 1); y += __shfl_xor(y, 2); y += __shfl_xor(y, 4);
            if (nq == 0) yt[t * 64 + p] = y;
        }
        __syncthreads();
        if (!isctx) for (int i = tid; i < 64 * 64; i += 512) { const int t = i >> 6, c = i & 63; float* o = F.YS + (size_t)(base + step * t) * 512 + h * 64 + c; *o = accum ? *o + yt[i] : yt[i]; }
    }
}
DI void hgrn_seq_unit(const Ctx& F, int b, int h, int dir, int accum) {
    LAS float* qs = (LAS float*)F.lds;
    LAS float* fs = qs + 32 * 128;
    LAS float* is = fs + 32 * 128;
    LAS float* ot = is + 32 * 128;
    const int tid = F.tid, v = tid >> 2, kq = tid & 3;
    float st[32];
#pragma unroll
    for (int i = 0; i < 32; ++i) st[i] = 0.f;
    const int fcol = dir == 0 ? UFF : UFB;
    const int ntile = (CTXL + SEQ) / 32;
    for (int tl = 0; tl < ntile; ++tl) {
        const bool isctx = tl < 8;
        int base;
        if (isctx) base = MLAT + b * CTXL + (dir == 0 ? tl * 32 : CTXL - 1 - tl * 32);
        else base = b * SEQ + (dir == 0 ? (tl - 8) * 32 : SEQ - 1 - (tl - 8) * 32);
        const int step = dir == 0 ? 1 : -1;
        __syncthreads();
        for (int i = tid; i < 32 * 128; i += 512) {
            const int t = i >> 7, c = i & 127; const size_t ro = (size_t)(base + step * t) * NU; const int ch = h * 128 + c;
            qs[i] = silu_f((float)F.U[ro + UQ + ch]);
            const float l0 = F.hgrn_lb[dir * 512 + ch], l1 = F.hgrn_lb[1024 + dir * 512 + ch];
            const float lb = 1.f / (1.f + __expf(l1 - l0));
            fs[i] = lb + (1.f - lb) * sigmoid_f((float)F.U[ro + fcol + ch]);
            is[i] = (float)F.U[ro + UI + ch];
        }
        __syncthreads();
        for (int t = 0; t < 32; ++t) {
            const float iv = is[t * 128 + v]; float o = 0.f;
#pragma unroll
            for (int i = 0; i < 32; ++i) { const float f = fs[t * 128 + kq * 32 + i]; st[i] = f * st[i] + (1.f - f) * iv; o += qs[t * 128 + kq * 32 + i] * st[i]; }
            o += __shfl_xor(o, 1); o += __shfl_xor(o, 2);
            if (kq == 0) ot[t * 128 + v] = o;
        }
        __syncthreads();
        if (!isctx) for (int i = tid; i < 32 * 128; i += 512) { const int t = i >> 7, c = i & 127; float* o = F.OH + (size_t)(base + step * t) * 512 + h * 128 + c; *o = accum ? *o + ot[i] : ot[i]; }
    }
}
DI void phase_seq(const Ctx& F, int dir) {
    if (F.c < 32) ssd_seq_unit(F, F.c >> 3, F.c & 7, dir, dir);
    else if (F.c < 48) hgrn_seq_unit(F, (F.c - 32) >> 2, (F.c - 32) & 3, dir, dir);
}
DI void phase_mixout(const Ctx& F) {
    const int gw = F.c * 8 + F.wave, NGW = F.G * 8, lane = F.lane, c0 = lane * 8;
    for (int row = gw; row < MLAT; row += NGW) {
        float y[8], o[8]; float ss = 0.f, so = 0.f;
        const float dsk = F.ssd_d[c0 >> 6];
#pragma unroll
        for (int j = 0; j < 8; ++j) {
            const int c = c0 + j;
            float v = F.YS[(size_t)row * 512 + c] + dsk * (float)F.XBC[(size_t)row * 1024 + c];
            v *= silu_f((float)F.U[(size_t)row * NU + UZ + c]);
            y[j] = v; ss += v * v;
            const float w = F.OH[(size_t)row * 512 + c]; o[j] = w; so += w * w;
        }
        for (int m = 1; m < 32; m <<= 1) ss += __shfl_xor(ss, m);
        for (int m = 1; m < 16; m <<= 1) so += __shfl_xor(so, m);
        const float rs = rsqrtf(ss * (1.f / 256.f) + EPS), ro = rsqrtf(so * (1.f / 128.f) + EPS);
#pragma unroll
        for (int j = 0; j < 8; ++j) {
            const int c = c0 + j;
            F.Y[(size_t)row * DM + c] = (f16)(y[j] * rs * F.ssd_nw[c]);
            F.Y[(size_t)row * DM + 512 + c] = (f16)(o[j] * ro * F.hgrn_nw[c] * silu_f((float)F.U[(size_t)row * NU + UG + c]));
        }
    }
}

DI void phase_post(const Ctx& F) {
    LAS float* wr = (LAS float*)F.lds;
    for (int i = F.tid; i < DM * 16; i += 512) wr[i] = F.w_router[i];
    __syncthreads();
    const int lane = F.lane, gw = F.c * 8 + F.wave, NGW = F.G * 8;
    for (int row = gw; row < MLAT; row += NGW) {
        const int b = row / SEQ, t = row % SEQ;
        const float* mod = F.MOD + b * 6144;
        f32x4 r[4], xl[4]; float ss = 0.f;
#pragma unroll
        for (int j = 0; j < 4; ++j) { r[j] = *(const f32x4*)(F.R + (size_t)row * DM + 4 * lane + 256 * j); ss += r[j].x * r[j].x + r[j].y * r[j].y + r[j].z * r[j].z + r[j].w * r[j].w; }
        const float rstd = rsqrtf(wave_sum(ss) * (1.f / DM) + EPS);
        float s2 = 0.f;
#pragma unroll
        for (int j = 0; j < 4; ++j) {
            const int k = 4 * lane + 256 * j;
            const f32x4 xv = *(const f32x4*)(F.x + (size_t)row * DM + k), nw = *(const f32x4*)(F.norm_w + 1024 + k), gt = *(const f32x4*)(mod + 2048 + k);
            xl[j] = xv + gt * (r[j] * rstd * nw);
            *(f32x4*)(F.XLAT + (size_t)row * DM + k) = xl[j];
            s2 += xl[j].x * xl[j].x + xl[j].y * xl[j].y + xl[j].z * xl[j].z + xl[j].w * xl[j].w;
        }
        const float rstd2 = rsqrtf(wave_sum(s2) * (1.f / DM) + EPS);
        float lg[16];
#pragma unroll
        for (int e = 0; e < 16; ++e) lg[e] = 0.f;
#pragma unroll
        for (int j = 0; j < 4; ++j) {
            const int k = 4 * lane + 256 * j;
            const f32x4 nw = *(const f32x4*)(F.norm_w + 2048 + k), sh = *(const f32x4*)(mod + 3072 + k), sc = *(const f32x4*)(mod + 4096 + k);
            const f32x4 hv = xl[j] * rstd2 * nw * (1.f + sc) + sh;
            f16x4 o; o.x = (f16)hv.x; o.y = (f16)hv.y; o.z = (f16)hv.z; o.w = (f16)hv.w;
            *(f16x4*)(F.H2 + (size_t)row * DM + k) = o;
#pragma unroll
            for (int kk = 0; kk < 4; ++kk) {
                const LAS f32x4* wp = (const LAS f32x4*)(wr + (k + kk) * 16); const float hk = hv[kk];
#pragma unroll
                for (int q = 0; q < 4; ++q) { const f32x4 w = wp[q]; lg[4 * q + 0] += hk * w.x; lg[4 * q + 1] += hk * w.y; lg[4 * q + 2] += hk * w.z; lg[4 * q + 3] += hk * w.w; }
                __builtin_amdgcn_sched_barrier(0);
            }
        }
        float mx = -1e30f;
#pragma unroll
        for (int e = 0; e < 16; ++e) { lg[e] = wave_sum(lg[e]); mx = fmaxf(mx, lg[e]); }
        float den = 0.f;
#pragma unroll
        for (int e = 0; e < 16; ++e) { lg[e] = __expf(lg[e] - mx); den += lg[e]; }
        const float inv = 1.f / den;
        if (lane < 16) { float v = 0.f;
#pragma unroll
            for (int e = 0; e < 16; ++e) v = lane == e ? lg[e] : v;
            F.AFF[((size_t)b * 16 + lane) * SEQ + t] = v * inv; }
    }
    __syncthreads();
}

DI void phase_topk(const Ctx& F) {
    if (F.c >= 64) return;
    LAS unsigned* vals = (LAS unsigned*)F.lds;
    LAS unsigned* hist = vals + SEQ;
    LAS unsigned* sm = hist + 256;
    const int be = F.c, tid = F.tid;
    const float* a = F.AFF + (size_t)be * SEQ;
    for (int i = tid; i < SEQ; i += 512) vals[i] = __float_as_uint(a[i]);
    if (tid == 0) { sm[0] = 0u; sm[1] = CAP; }
    __syncthreads();
    unsigned mask = 0u;
    for (int pass = 0; pass < 4; ++pass) {
        const int shift = 24 - 8 * pass;
        if (tid < 256) hist[tid] = 0u;
        __syncthreads();
        const unsigned prefix = sm[0];
        for (int i = tid; i < SEQ; i += 512) { const unsigned v = vals[i]; if ((v & mask) == prefix) atomicAdd((unsigned*)&hist[(v >> shift) & 255u], 1u); }
        __syncthreads();
        if (tid == 0) {
            unsigned k = sm[1], cum = 0u; int bin = 255;
            for (; bin > 0; --bin) { if (cum + hist[bin] >= k) break; cum += hist[bin]; }
            sm[1] = k - cum; sm[0] = prefix | ((unsigned)bin << shift);
        }
        mask |= 255u << shift;
        __syncthreads();
    }
    const unsigned T = sm[0], keq = sm[1];
    unsigned cg = 0, ce = 0;
    for (int j = 0; j < 16; ++j) { const unsigned v = vals[tid * 16 + j]; cg += v > T; ce += v == T; }
    const int lane = tid & 63, w = tid >> 6;
    unsigned ig = cg, ie = ce;
    for (int o = 1; o < 64; o <<= 1) { const unsigned tg = __shfl_up(ig, o), te = __shfl_up(ie, o); if (lane >= o) { ig += tg; ie += te; } }
    if (lane == 63) { sm[2 + w] = ig; sm[10 + w] = ie; }
    __syncthreads();
    unsigned og = 0, oe = 0;
    for (int i = 0; i < w; ++i) { og += sm[2 + i]; oe += sm[10 + i]; }
    unsigned pg = og + ig - cg, pe = oe + ie - ce;
    const int rowbase = ((be & 15) * 4 + (be >> 4)) * CAP;
    for (int j = 0; j < 16; ++j) {
        const int t = tid * 16 + j; const unsigned v = vals[t];
        int slot = -1;
        if (v > T) { slot = (int)(pg + (pe < keq ? pe : keq)); pg++; }
        else if (v == T) { if (pe < keq) slot = (int)(pg + pe); pe++; }
        F.SLOT[(size_t)be * SEQ + t] = slot;
        if (slot >= 0) { F.IDX[rowbase + slot] = t; F.GATEV[rowbase + slot] = __uint_as_float(v); }
    }
    __syncthreads();
}

DI void phase_combine(const Ctx& F) {
    const int lane = F.lane, gw = F.c * 8 + F.wave, NGW = F.G * 8;
    for (int row = gw; row < MLAT; row += NGW) {
        const int b = row / SEQ, t = row % SEQ;
        f32x4 acc[4];
#pragma unroll
        for (int j = 0; j < 4; ++j) acc[j] = (f32x4){0, 0, 0, 0};
        for (int e = 0; e < NE; ++e) {
            const int s = F.SLOT[((size_t)b * 16 + e) * SEQ + t];
            if (s >= 0) {
                const f16* yr = F.YM + (size_t)((e * 4 + b) * CAP + s) * DM;
#pragma unroll
                for (int j = 0; j < 4; ++j) { const f16x4 v = *(const f16x4*)(yr + 4 * lane + 256 * j); acc[j].x += (float)v.x; acc[j].y += (float)v.y; acc[j].z += (float)v.z; acc[j].w += (float)v.w; }
            }
        }
        float ss = 0.f;
#pragma unroll
        for (int j = 0; j < 4; ++j) ss += acc[j].x * acc[j].x + acc[j].y * acc[j].y + acc[j].z * acc[j].z + acc[j].w * acc[j].w;
        const float rstd = rsqrtf(wave_sum(ss) * (1.f / DM) + EPS);
#pragma unroll
        for (int j = 0; j < 4; ++j) {
            const int k = 4 * lane + 256 * j;
            const f32x4 xl = *(const f32x4*)(F.XLAT + (size_t)row * DM + k), nw = *(const f32x4*)(F.norm_w + 3072 + k), gt = *(const f32x4*)(F.MOD + b * 6144 + 5120 + k);
            *(f32x4*)(F.out + (size_t)row * DM + k) = xl + gt * (acc[j] * rstd * nw);
        }
    }
}

__global__ void __launch_bounds__(512, 2) mk_fwd(Args args) {
    extern __shared__ __attribute__((aligned(16))) unsigned char lds_raw[];
    Ctx F;
    F.lds = (LAS unsigned char*)lds_raw;
    F.tid = threadIdx.x; F.lane = F.tid & 63; F.wave = __builtin_amdgcn_readfirstlane(F.tid >> 6); F.G = gridDim.x; F.c = blockIdx.x;
    unsigned char* ws = args.ws;
    F.x = args.in[0]; F.cvec = args.in[1]; F.ctx = args.in[2]; F.c_ctx = args.in[3]; F.ada_w = args.in[4]; F.ada_b = args.in[5]; F.norm_w = args.in[6]; F.w_in = args.in[7];
    F.conv_w = args.in[8]; F.conv_b = args.in[9]; F.dt_bias = args.in[10]; F.a_log = args.in[11]; F.ssd_d = args.in[12]; F.ssd_nw = args.in[13]; F.hgrn_lb = args.in[14]; F.hgrn_nw = args.in[15];
    F.w_out = args.in[16]; F.w_router = args.in[17]; F.w_gate = args.in[18]; F.w_up = args.in[19]; F.w_down = args.in[20];
    F.out = args.out;
    F.MOD = (float*)(ws + WS_MOD); F.DT = (float*)(ws + WS_DT); F.WDT = (float*)(ws + WS_WDT); F.AFF = (float*)(ws + WS_AFF);
    F.IDX = (int*)(ws + WS_IDX); F.GATEV = (float*)(ws + WS_GATEV); F.SLOT = (int*)(ws + WS_SLOT);
    F.WIN = (f16*)(ws + WS_WIN); F.WOUT = (f16*)(ws + WS_WOUT); F.WGU = (f16*)(ws + WS_WGU); F.WD = (f16*)(ws + WS_WD);
    F.H = (f16*)(ws + WS_H); F.U = (f16*)(ws + WS_U); F.Y = (f16*)(ws + WS_Y);
    F.XBC = F.H; F.H2 = F.H; F.R = (float*)(ws + WS_R); F.ACT = (f16*)(ws + WS_ACT); F.YM = (f16*)(ws + WS_YM);
    F.YS = F.out; F.OH = F.out + (size_t)MLAT * 512; F.XLAT = F.out;
    const int lo = args.ph_lo, hi = args.ph_hi;
    volatile LAS unsigned* misc = (volatile LAS unsigned*)(F.lds + LDS_MISC_OFF);
    if (F.tid < 16) misc[F.tid] = 0u;
    __syncthreads();
    XcdBarrier bar; bar.bar = (unsigned*)(ws + WS_BAR); bar.x = 0; bar.st = misc + 8;
    const bool multi = hi - lo > 1;
    if (multi) bar = xcd_barrier_post((unsigned*)(ws + WS_BAR), misc + 8);
#define IN(k) (lo <= (k) && (k) < hi)
#define SEAM(k) do { if (IN(k) && IN((k) + 1)) xcd_barrier(bar); } while (0)
    if (IN(PH_PREP)) { phase_prep(F); } SEAM(PH_PREP);
    if (IN(PH_HROWS)) { phase_hrows(F); } SEAM(PH_HROWS);
    if (IN(PH_GEMM_IN)) { gm::ProbIn p{F.H, F.WIN, F.U}; gm::gemm_phase(F.lds, p, F.G, F.c); } SEAM(PH_GEMM_IN);
    if (IN(PH_CONV)) { phase_conv(F); } SEAM(PH_CONV);
    if (IN(PH_SEQ_F)) { phase_seq(F, 0); } SEAM(PH_SEQ_F);
    if (IN(PH_SEQ_B)) { phase_seq(F, 1); } SEAM(PH_SEQ_B);
    if (IN(PH_MIXOUT)) { phase_mixout(F); } SEAM(PH_MIXOUT);
    if (IN(PH_GEMM_OUT)) { gm::ProbOut p{F.Y, F.WOUT, F.R}; gm::gemm_phase(F.lds, p, F.G, F.c); } SEAM(PH_GEMM_OUT);
    if (IN(PH_POST)) { phase_post(F); } SEAM(PH_POST);
    if (IN(PH_TOPK)) { phase_topk(F); } SEAM(PH_TOPK);
    if (IN(PH_GEMM_GU)) {
        LAS int* tab = (LAS int*)(F.lds + LDS_TAB_OFF);
        for (int i = 0; i < 8; ++i) { gm::Unit u; if (!gm::unit_at(i, F.G, F.c, gm::ProbGU::nM, gm::ProbGU::nN, u)) break;
            if (F.tid < 256) { const int b = (u.pm >> 2) & 3; tab[i * 256 + F.tid] = b * SEQ + F.IDX[u.pm * 256 + F.tid]; } }
        __syncthreads();
        gm::ProbGU p{F.H2, F.WGU, F.ACT, F.IDX, tab}; gm::gemm_phase(F.lds, p, F.G, F.c);
    } SEAM(PH_GEMM_GU);
    if (IN(PH_GEMM_DOWN)) { gm::ProbDown p{F.ACT, F.WD, F.YM, F.GATEV}; gm::gemm_phase(F.lds, p, F.G, F.c); } SEAM(PH_GEMM_DOWN);
    if (IN(PH_COMBINE)) { phase_combine(F); }
#undef IN
#undef SEAM
}

#ifndef MK_SPLIT
#define MK_SPLIT 0
#endif
extern "C" void kernel_launch(void* const* d_in, const int* in_sizes, int n_in, void* d_out, int out_size, void* d_ws, size_t ws_size, hipStream_t stream) {
    if (ws_size < WS_END || n_in < 21) { fprintf(stderr, "kernel_launch: bad workspace/inputs: ws %zu n_in %d\n", ws_size, n_in); return; }
    static bool attr_set = false;
    if (!attr_set) { (void)hipFuncSetAttribute((const void*)mk_fwd, hipFuncAttributeMaxDynamicSharedMemorySize, LDS_BYTES); attr_set = true; }
    Args a{}; for (int i = 0; i < 21; ++i) a.in[i] = (const float*)d_in[i]; a.out = (float*)d_out; a.ws = (unsigned char*)d_ws;
    (void)hipMemsetAsync((char*)d_ws + WS_BAR, 0, WS_CTL_BYTES, stream);
#if MK_SPLIT
    for (int ph = 0; ph < PH_COUNT; ++ph) { a.ph_lo = ph; a.ph_hi = ph + 1; hipLaunchKernelGGL(mk_fwd, dim3(256), dim3(512), LDS_BYTES, stream, a); }
#else
    a.ph_lo = 0; a.ph_hi = PH_COUNT; hipLaunchKernelGGL(mk_fwd, dim3(256), dim3(512), LDS_BYTES, stream, a);
#endif
}
```

```cpp
#include <hip/hip_runtime.h>
#include <cstdio>
#include <cstdint>

#define DI __device__ __forceinline__
typedef _Float16 f16;
typedef _Float16 f16x8 __attribute__((ext_vector_type(8)));
typedef _Float16 f16x4 __attribute__((ext_vector_type(4)));
typedef float f32x4 __attribute__((ext_vector_type(4)));

constexpr int DM = 1024, NB = 4, SEQ = 8192, CTXL = 256;
constexpr int MLAT = NB * SEQ;
constexpr int MCTX = NB * CTXL;
constexpr int MTOT = MLAT + MCTX;
constexpr int INCOLS = 4112, NU = 4096;
constexpr int UZ = 0, UXBC = 512, UQ = 1536, UFF = 2048, UFB = 2560, UI = 3072, UG = 3584;
constexpr int NE = 16, FF = 1024, CAP = 1024;
constexpr float EPS = 1e-6f;

constexpr size_t MiB = 1u << 20;
constexpr size_t WS_MOD = 1 * MiB;
constexpr size_t WS_DT = 2 * MiB;
constexpr size_t WS_WDT = 5 * MiB;
constexpr size_t WS_AFF = 6 * MiB;
constexpr size_t WS_IDX = 8 * MiB;
constexpr size_t WS_GATEV = 8 * MiB + 256 * 1024;
constexpr size_t WS_SLOT = 9 * MiB;
constexpr size_t WS_WIN = 12 * MiB;
constexpr size_t WS_WOUT = 20 * MiB;
constexpr size_t WS_WGU = 22 * MiB;
constexpr size_t WS_WD = 86 * MiB;
constexpr size_t WS_H = 118 * MiB;
constexpr size_t WS_U = 184 * MiB;
constexpr size_t WS_Y = 448 * MiB;
constexpr size_t WS_END = 512 * MiB;
constexpr size_t WS_ACT = WS_U;
constexpr size_t WS_YM = WS_U + 128 * MiB;
constexpr size_t WS_R = WS_U;

DI float silu_f(float x) { return x / (1.f + __expf(-x)); }
DI float sigmoid_f(float x) { return 1.f / (1.f + __expf(-x)); }
DI float softplus_f(float x) { return x > 20.f ? x : log1pf(__expf(x)); }
DI float wave_sum(float v) {
#pragma unroll
    for (int o = 1; o < 64; o <<= 1) v += __shfl_xor(v, o);
    return v;
}

#define LAS __attribute__((address_space(3)))
typedef unsigned u32x4 __attribute__((ext_vector_type(4)));
namespace gm {
constexpr int BM = 256, BK = 64, HALF = 128, HTB = HALF * BK * 2, STAGE_BYTES = 8 * HTB, NXCD = 8, WGM = 8, KD = 1024, NT = KD / BK;
DI int lds_byte(int r, int c) { const int st = (r >> 4) * 2 + (c >> 5), rr = r & 15, cc = c & 31, ob = rr * 64 + cc * 2; return st * 1024 + (ob ^ (((ob >> 9) & 1) << 5)); }
DI void stage_rc(int b, int& R, int& C) { const int st = b / 1024, sb = b % 1024, swz = sb ^ (((sb >> 9) & 1) << 5); R = (st >> 1) * 16 + swz / 64; C = (st & 1) * 32 + (swz % 64) / 2; }
DI int perm32(int rho) { const int n = rho >> 4, i = rho & 15; return 8 * (i >> 2) + 4 * n + (i & 3); }
struct Unit { int pm, pn; };
DI bool unit_at(int i, int G, int c, int nM, int nN, Unit& u) {
    const int nwg = nM * nN; const long L = (long)i * G + c; if (L >= nwg) return false;
    int wgid = (int)L; { const int q = nwg / NXCD, r = nwg % NXCD, xcd = wgid % NXCD, off = wgid / NXCD; wgid = (xcd < r ? xcd * (q + 1) : r * (q + 1) + (xcd - r) * q) + off; }
    const int nig = WGM * nN, gid = wgid / nig, fm = gid * WGM, gsz = (nM - fm) < WGM ? (nM - fm) : WGM;
    u.pm = fm + ((wgid % nig) % gsz); u.pn = (wgid % nig) / gsz; return true;
}
typedef f32x4 Acc[2][2][4][2];
DI unsigned pack2(float a, float b) { typedef _Float16 h2 __attribute__((ext_vector_type(2))); h2 v; v.x = (f16)a; v.y = (f16)b; return __builtin_bit_cast(unsigned, v); }

template <class P>
DI void gemm_phase(LAS unsigned char* lds, const P& p, int G, int c) {
    const int tid = threadIdx.x, wid = __builtin_amdgcn_readfirstlane(tid >> 6), lane = tid & 63, wr = wid >> 2, wc = wid & 3, fr = lane & 15, fq = lane >> 4;
    constexpr int K = KD, nt = NT;
    int Rr[2], Cc[2]; unsigned voffB[2];
#pragma unroll
    for (int i = 0; i < 2; ++i) { stage_rc(tid * 16 + i * 8192, Rr[i], Cc[i]); const int Rb = P::PERM ? ((Rr[i] & ~31) + perm32(Rr[i] & 31)) : Rr[i]; voffB[i] = (unsigned)(Rb * K + Cc[i]) * 2u; }
    const size_t kstep = (size_t)(BK * 2);
    const size_t hstep = (size_t)HALF * K * 2;
    const unsigned ldsw = (unsigned)wid * 1024u;
    const int aoff = lds_byte(wr * 64 + fr, fq * 8), boff = lds_byte(wc * 32 + fr, fq * 8);
#define G_SA(b, h) (((b) * 2 + (h)) * HTB)
#define G_SB(b, h) ((4 + (b) * 2 + (h)) * HTB)
#define G_STAGEB(bufoff, gbase) do { _Pragma("unroll") for (int _i = 0; _i < 2; ++_i) \
        __builtin_amdgcn_global_load_lds((const unsigned*)((const char*)(gbase) + voffB[_i]), (LAS unsigned*)(lds + (bufoff) + ldsw + _i * 8192), 16, 0, 0); } while (0)
#define G_STAGEA(bufoff, offs, h, koff) do { _Pragma("unroll") for (int _i = 0; _i < 2; ++_i) \
        __builtin_amdgcn_global_load_lds((const unsigned*)(gA + (offs)[h][_i] + (koff)), (LAS unsigned*)(lds + (bufoff) + ldsw + _i * 8192), 16, 0, 0); } while (0)
#define G_LDA(dst, b, h) do { _Pragma("unroll") for (int m = 0; m < 4; ++m) _Pragma("unroll") for (int k = 0; k < 2; ++k) dst[m][k] = *(const LAS f16x8*)(lds + G_SA(b, h) + aoff + m * 2048 + k * 1024); } while (0)
#define G_LDB(dst, b, h) do { _Pragma("unroll") for (int n = 0; n < 2; ++n) _Pragma("unroll") for (int k = 0; k < 2; ++k) dst[n][k] = *(const LAS f16x8*)(lds + G_SB(b, h) + boff + n * 2048 + k * 1024); } while (0)
#define G_MMA(ai, bj, At, Bt) do { __builtin_amdgcn_s_setprio(1); _Pragma("unroll") for (int m = 0; m < 4; ++m) _Pragma("unroll") for (int n = 0; n < 2; ++n) _Pragma("unroll") for (int k = 0; k < 2; ++k) \
        acc[ai][bj][m][n] = __builtin_amdgcn_mfma_f32_16x16x32_f16(Bt[n][k], At[m][k], acc[ai][bj][m][n], 0, 0, 0); __builtin_amdgcn_s_setprio(0); } while (0)
#define G_WAIT_V(n) asm volatile("s_waitcnt vmcnt(" #n ")" ::: "memory")
#define G_WAIT_L(n) asm volatile("s_waitcnt lgkmcnt(" #n ")" ::: "memory")
#define G_BAR __builtin_amdgcn_s_barrier()
#define G_SCHED __builtin_amdgcn_sched_barrier(0)
    Unit cur, nxt; int ui = 0;
    if (!unit_at(0, G, c, P::nM, P::nN, cur)) return;
    Acc acc;
#pragma unroll
    for (int a = 0; a < 2; ++a)
#pragma unroll
        for (int b = 0; b < 2; ++b)
#pragma unroll
            for (int m = 0; m < 4; ++m)
#pragma unroll
                for (int n = 0; n < 2; ++n) acc[a][b][m][n] = (f32x4){0.f, 0.f, 0.f, 0.f};
    f16x8 At[4][2], B0[2][2], B1[2][2];
    const char* gA = (const char*)p.A;
    unsigned offC[2][2], offN[2][2];
#pragma unroll
    for (int h = 0; h < 2; ++h)
#pragma unroll
        for (int i = 0; i < 2; ++i) offC[h][i] = p.arow(0, cur, 128 * h + Rr[i]) * (unsigned)(K * 2) + (unsigned)Cc[i] * 2u;
    const char* cB = p.bptr(cur);
    G_STAGEB(G_SB(0, 0), cB); G_STAGEA(G_SA(0, 0), offC, 0, 0); G_STAGEB(G_SB(0, 1), cB + hstep); G_STAGEA(G_SA(0, 1), offC, 1, 0);
    if (wr == 1) G_BAR;
    G_WAIT_V(4); G_BAR;
    G_STAGEB(G_SB(1, 0), cB + kstep); G_STAGEA(G_SA(1, 0), offC, 0, kstep); G_STAGEB(G_SB(1, 1), cB + hstep + kstep);
    G_WAIT_V(6); G_BAR;
    for (;;) {
        const bool has_next = unit_at(ui + 1, G, c, P::nM, P::nN, nxt);
        const char* nB = has_next ? p.bptr(nxt) : cB;
#pragma unroll
        for (int h = 0; h < 2; ++h)
#pragma unroll
            for (int i = 0; i < 2; ++i) offN[h][i] = has_next ? p.arow(ui + 1, nxt, 128 * h + Rr[i]) * (unsigned)(K * 2) + (unsigned)Cc[i] * 2u : offC[h][i];
        for (int t = 0; t < nt; t += 2) {
            const bool last = (t == nt - 2);
            const size_t k1 = (size_t)(t + 1) * kstep;
            const size_t k2 = last ? 0 : (size_t)(t + 2) * kstep, k3 = k2 + kstep;
            const char* b2 = last ? nB : cB + (size_t)(t + 2) * kstep; const char* b3 = b2 + kstep;
            unsigned o2[2][2];
#pragma unroll
            for (int h = 0; h < 2; ++h)
#pragma unroll
                for (int i = 0; i < 2; ++i) o2[h][i] = last ? offN[h][i] : offC[h][i];
            G_LDB(B0, 0, 0); G_SCHED; G_LDA(At, 0, 0); G_STAGEA(G_SA(1, 1), offC, 1, k1);
            G_WAIT_L(8); G_BAR; G_WAIT_L(0); G_MMA(0, 0, At, B0); G_BAR; G_SCHED;
            G_LDB(B1, 0, 1); G_STAGEB(G_SB(0, 0), b2);
            G_BAR; G_WAIT_L(0); G_MMA(0, 1, At, B1); G_BAR;
            G_LDA(At, 0, 1); G_STAGEA(G_SA(0, 0), o2, 0, k2);
            G_BAR; G_WAIT_L(0); G_MMA(1, 0, At, B0); G_BAR; G_SCHED;
            G_STAGEB(G_SB(0, 1), b2 + hstep);
            G_WAIT_V(6); G_BAR; G_MMA(1, 1, At, B1); G_BAR;
            G_LDB(B0, 1, 0); G_SCHED; G_LDA(At, 1, 0); G_STAGEA(G_SA(0, 1), o2, 1, k2);
            G_WAIT_L(8); G_BAR; G_WAIT_L(0); G_MMA(0, 0, At, B0); G_BAR; G_SCHED;
            G_LDB(B1, 1, 1); G_STAGEB(G_SB(1, 0), b3);
            G_BAR; G_WAIT_L(0); G_MMA(0, 1, At, B1); G_BAR;
            G_LDA(At, 1, 1); G_STAGEA(G_SA(1, 0), o2, 0, k3);
            G_BAR; G_WAIT_L(0); G_MMA(1, 0, At, B0); G_BAR; G_SCHED;
            G_STAGEB(G_SB(1, 1), b3 + hstep);
            G_WAIT_V(6); G_BAR; G_MMA(1, 1, At, B1); G_BAR;
        }
        p.epi(acc, cur, wr, wc, fr, fq);
        if (!has_next) break;
#pragma unroll
        for (int a = 0; a < 2; ++a)
#pragma unroll
            for (int b = 0; b < 2; ++b)
#pragma unroll
                for (int m = 0; m < 4; ++m)
#pragma unroll
                    for (int n = 0; n < 2; ++n) acc[a][b][m][n] = (f32x4){0.f, 0.f, 0.f, 0.f};
        cur = nxt; cB = nB; ++ui;
#pragma unroll
        for (int h = 0; h < 2; ++h)
#pragma unroll
            for (int i = 0; i < 2; ++i) offC[h][i] = offN[h][i];
    }
    G_WAIT_V(0);
    if (wr == 0) G_BAR;
    G_BAR;
#undef G_SA
#undef G_SB
#undef G_STAGEA
#undef G_STAGEB
#undef G_LDA
#undef G_LDB
#undef G_MMA
#undef G_WAIT_V
#undef G_WAIT_L
#undef G_BAR
#undef G_SCHED
}

struct ProbIn {
    static constexpr int nM = MTOT / 256, nN = NU / 256; static constexpr bool PERM = true;
    const f16* A; const f16* BT; f16* U;
    DI unsigned arow(int, const Unit& u, int r) const { return (unsigned)(u.pm * 256 + r); }
    DI const char* bptr(const Unit& u) const { return (const char*)(BT + (size_t)u.pn * 256 * KD); }
    DI void epi(const Acc& acc, const Unit& u, int wr, int wc, int fr, int fq) const {
        const int row0 = u.pm * BM + wr * 64 + fr, col0 = u.pn * BM + wc * 32 + 8 * fq;
#pragma unroll
        for (int ai = 0; ai < 2; ++ai)
#pragma unroll
            for (int m = 0; m < 4; ++m) { f16* rowp = U + (size_t)(row0 + ai * HALF + m * 16) * NU + col0;
#pragma unroll
                for (int bj = 0; bj < 2; ++bj) { const f32x4 v0 = acc[ai][bj][m][0], v1 = acc[ai][bj][m][1];
                    u32x4 w; w.x = pack2(v0[0], v0[1]); w.y = pack2(v0[2], v0[3]); w.z = pack2(v1[0], v1[1]); w.w = pack2(v1[2], v1[3]);
                    *(u32x4*)(rowp + bj * HALF) = w; } }
    }
};
struct ProbOut {
    static constexpr int nM = MLAT / 256, nN = DM / 256; static constexpr bool PERM = false;
    const f16* A; const f16* BT; float* R;
    DI unsigned arow(int, const Unit& u, int r) const { return (unsigned)(u.pm * 256 + r); }
    DI const char* bptr(const Unit& u) const { return (const char*)(BT + (size_t)u.pn * 256 * KD); }
    DI void epi(const Acc& acc, const Unit& u, int wr, int wc, int fr, int fq) const {
        const int row0 = u.pm * BM + wr * 64 + fr, col0 = u.pn * BM + wc * 32 + 4 * fq;
#pragma unroll
        for (int ai = 0; ai < 2; ++ai)
#pragma unroll
            for (int m = 0; m < 4; ++m) { float* rowp = R + (size_t)(row0 + ai * HALF + m * 16) * DM + col0;
#pragma unroll
                for (int bj = 0; bj < 2; ++bj)
#pragma unroll
                    for (int n = 0; n < 2; ++n) *(f32x4*)(rowp + bj * HALF + n * 16) = acc[ai][bj][m][n]; }
    }
};
struct ProbGU {
    static constexpr int nM = (NE * NB * CAP) / 256, nN = 2048 / 256; static constexpr bool PERM = true;
    const f16* A; const f16* BT; f16* ACT; const int* IDX; const LAS int* tab;
    DI unsigned arow(int ui, const Unit& u, int r) const { return (unsigned)tab[ui * 256 + r]; }
    DI const char* bptr(const Unit& u) const { return (const char*)(BT + ((size_t)(u.pm >> 4) * 2048 + (size_t)u.pn * 256) * KD); }
    DI void epi(const Acc& acc, const Unit& u, int wr, int wc, int fr, int fq) const {
        const int row0 = u.pm * BM + wr * 64 + fr, col0 = u.pn * 128 + wc * 32 + 8 * fq;
#pragma unroll
        for (int ai = 0; ai < 2; ++ai)
#pragma unroll
            for (int m = 0; m < 4; ++m) { f16* rowp = ACT + (size_t)(row0 + ai * HALF + m * 16) * FF + col0;
                const f32x4 g0 = acc[ai][0][m][0], g1 = acc[ai][0][m][1], u0 = acc[ai][1][m][0], u1 = acc[ai][1][m][1];
                u32x4 w; w.x = pack2(silu_f(g0[0]) * u0[0], silu_f(g0[1]) * u0[1]); w.y = pack2(silu_f(g0[2]) * u0[2], silu_f(g0[3]) * u0[3]);
                w.z = pack2(silu_f(g1[0]) * u1[0], silu_f(g1[1]) * u1[1]); w.w = pack2(silu_f(g1[2]) * u1[2], silu_f(g1[3]) * u1[3]);
                *(u32x4*)rowp = w; }
    }
};
struct ProbDown {
    static constexpr int nM = (NE * NB * CAP) / 256, nN = DM / 256; static constexpr bool PERM = true;
    const f16* A; const f16* BT; f16* YM; const float* GV;
    DI unsigned arow(int, const Unit& u, int r) const { return (unsigned)(u.pm * 256 + r); }
    DI const char* bptr(const Unit& u) const { return (const char*)(BT + ((size_t)(u.pm >> 4) * 1024 + (size_t)u.pn * 256) * KD); }
    DI void epi(const Acc& acc, const Unit& u, int wr, int wc, int fr, int fq) const {
        const int row0 = u.pm * BM + wr * 64 + fr, col0 = u.pn * BM + wc * 32 + 8 * fq;
#pragma unroll
        for (int ai = 0; ai < 2; ++ai)
#pragma unroll
            for (int m = 0; m < 4; ++m) { const int row = row0 + ai * HALF + m * 16; const float g = GV[row]; f16* rowp = YM + (size_t)row * DM + col0;
#pragma unroll
                for (int bj = 0; bj < 2; ++bj) { const f32x4 v0 = acc[ai][bj][m][0] * g, v1 = acc[ai][bj][m][1] * g;
                    u32x4 w; w.x = pack2(v0[0], v0[1]); w.y = pack2(v0[2], v0[3]); w.z = pack2(v1[0], v1[1]); w.w = pack2(v1[2], v1[3]);
                    *(u32x4*)(rowp + bj * HALF) = w; } }
    }
};
}

#define XB_TMO      128
#define XB_XCNT(j)  (256  + 64 * (j))
#define XB_XSUB(j)  (1280 + 64 * (j))
#define XB_XGEN(j)  (2304 + 64 * (j))
#define XB_TOP      3328
#define XB_TOPGEN   3392
#define XCD_BAR_WORDS 3456
#define XB_SPIN_CAP (1u << 22)
DI unsigned xb_ld(unsigned* p)              { return __hip_atomic_load(p, __ATOMIC_RELAXED, __HIP_MEMORY_SCOPE_AGENT); }
DI unsigned xb_add(unsigned* p, unsigned v) { return __hip_atomic_fetch_add(p, v, __ATOMIC_RELAXED, __HIP_MEMORY_SCOPE_AGENT); }
DI unsigned xb_xcc_id() { return (unsigned)__builtin_amdgcn_s_getreg((3 << 11) | 20) & 0xFu; }
#define XB_SPIN(cond, bar) do { unsigned _sp = 0; while (cond) { __builtin_amdgcn_s_sleep(1); \
    if ((++_sp & 255u) == 0u) { if (xb_ld(&(bar)[XB_TMO])) break; if (_sp > XB_SPIN_CAP) { atomicAdd(&(bar)[XB_TMO], 1u); break; } } } } while (0)
struct XcdBarrier { unsigned* bar; unsigned x; volatile LAS unsigned* st; };
DI XcdBarrier xcd_barrier_post(unsigned* bar, volatile LAS unsigned* st) {
    XcdBarrier b; b.bar = bar; b.x = xb_xcc_id(); b.st = st;
    if (threadIdx.x == 0) (void)xb_add(&bar[XB_XCNT(b.x)], 1u);
    return b;
}
DI void xcd_barrier_complete(unsigned* bar, unsigned x, unsigned& nloc, unsigned& nx) {
    const unsigned G = gridDim.x * gridDim.y * gridDim.z;
    unsigned sum, cnt, mine, sp = 0u;
    for (;;) {
        sum = 0u; cnt = 0u; mine = 0u;
#pragma unroll
        for (unsigned j = 0; j < 16; ++j) { const unsigned c = xb_ld(&bar[XB_XCNT(j)]); sum += c; cnt += (c > 0u) ? 1u : 0u; mine = (j == x) ? c : mine; }
        if (sum == G) break;
        __builtin_amdgcn_s_sleep(1);
        if ((++sp & 255u) == 0u) { if (xb_ld(&bar[XB_TMO])) break; if (sp > XB_SPIN_CAP) { atomicAdd(&bar[XB_TMO], 1u); break; } }
    }
    nloc = mine > 0u ? mine : 1u; nx = cnt > 0u ? cnt : 1u;
}
DI void xcd_barrier(const XcdBarrier& b) {
    asm volatile("s_waitcnt vmcnt(0)" ::: "memory");
    __syncthreads();
    if (threadIdx.x == 0) {
        unsigned* bar = b.bar;
        __builtin_amdgcn_s_waitcnt(0);
        unsigned nloc = b.st[0], nx = b.st[1];
        if (nloc == 0u) { xcd_barrier_complete(bar, b.x, nloc, nx); b.st[0] = nloc; b.st[1] = nx; }
        const unsigned old = xb_add(&bar[XB_XSUB(b.x)], 1u);
        const unsigned gen = old / nloc;
        if (old + 1u == (gen + 1u) * nloc) {
            __builtin_amdgcn_fence(__ATOMIC_RELEASE, "agent");
            asm volatile("s_waitcnt vmcnt(0)" ::: "memory");
            const unsigned og = xb_add(&bar[XB_TOP], 1u);
            const unsigned tg = og / nx;
            if (og + 1u == (tg + 1u) * nx) xb_add(&bar[XB_TOPGEN], 1u);
            else XB_SPIN(xb_ld(&bar[XB_TOPGEN]) == tg, bar);
            __builtin_amdgcn_fence(__ATOMIC_ACQUIRE, "agent");
            xb_add(&bar[XB_XGEN(b.x)], 1u);
            asm volatile("s_waitcnt vmcnt(0)" ::: "memory");
        } else {
            XB_SPIN(xb_ld(&bar[XB_XGEN(b.x)]) == gen, bar);
            __builtin_amdgcn_fence(__ATOMIC_ACQUIRE, "agent");
            asm volatile("s_waitcnt vmcnt(0)" ::: "memory");
        }
    }
    __syncthreads();
}

constexpr int LDS_TAB_OFF = 131072;
constexpr int LDS_MISC_OFF = 131072 + 8192;
constexpr int LDS_BYTES = 147456;
constexpr size_t WS_BAR = 0;
constexpr size_t WS_CTL_BYTES = 65536;
struct Args { const float* in[21]; float* out; unsigned char* ws; int ph_lo, ph_hi; };
enum { PH_PREP = 0, PH_HROWS, PH_GEMM_IN, PH_MA, PH_MB, PH_MC, PH_GEMM_OUT, PH_POST, PH_TOPK, PH_GEMM_GU, PH_GEMM_DOWN, PH_COMBINE, PH_COUNT };

struct Ctx {
    LAS unsigned char* lds; int tid, lane, wave, G, c;
    const float *x, *cvec, *ctx, *c_ctx, *ada_w, *ada_b, *norm_w, *w_in, *conv_w, *conv_b, *dt_bias, *a_log, *ssd_d, *ssd_nw, *hgrn_lb, *hgrn_nw, *w_out, *w_router, *w_gate, *w_up, *w_down;
    float* out;
    float *MOD, *DT, *WDT, *AFF, *GATEV, *R, *YS, *OH, *XLAT; int *IDX, *SLOT;
    f16 *WIN, *WOUT, *WGU, *WD, *H, *U, *Y, *XBC, *H2, *ACT, *YM;
};

DI void tr_item(const float* src, int ld, int col0, int k0, f16* dst_row0, int ldd, LAS float* scr, int lane) {
#pragma unroll 8
    for (int i = 0; i < 32; ++i) { const int kk = 2 * i + (lane >> 5); scr[kk * 33 + (lane & 31)] = src[(size_t)(k0 + kk) * ld + col0 + (lane & 31)]; }
    asm volatile("s_waitcnt lgkmcnt(0)" ::: "memory");
    const int cc = lane & 7;
#pragma unroll
    for (int j = 0; j < 4; ++j) { const int n = (lane >> 3) + 8 * j; const LAS float* s = scr + (8 * cc) * 33 + n;
        u32x4 o; o.x = gm::pack2(s[0 * 33], s[1 * 33]); o.y = gm::pack2(s[2 * 33], s[3 * 33]); o.z = gm::pack2(s[4 * 33], s[5 * 33]); o.w = gm::pack2(s[6 * 33], s[7 * 33]);
        *(u32x4*)(dst_row0 + (size_t)n * ldd + k0 + 8 * cc) = o; }
    asm volatile("s_waitcnt lgkmcnt(0)" ::: "memory");
}
DI void phase_prep(const Ctx& F) {
    {
        LAS float* sv = (LAS float*)F.lds;
        LAS float* red = sv + 5 * DM;
        for (int i = F.tid; i < 5 * DM; i += 512) { const int r = i >> 10, k = i & 1023; sv[i] = silu_f(r < 4 ? F.cvec[r * DM + k] : F.c_ctx[k]); }
        __syncthreads();
        const int col = F.tid % 24, kg = F.tid / 24, j = F.c * 24 + col;
        if (kg < 21) {
            float a[5] = {0, 0, 0, 0, 0};
            for (int k = kg; k < DM; k += 21) { const float w = F.ada_w[(size_t)k * 6144 + j];
#pragma unroll
                for (int r = 0; r < 5; ++r) a[r] += sv[r * DM + k] * w; }
#pragma unroll
            for (int r = 0; r < 5; ++r) red[(kg * 24 + col) * 5 + r] = a[r];
        }
        __syncthreads();
        if (F.tid < 120) { const int cl = F.tid % 24, r = F.tid / 24; float s = 0.f; for (int g = 0; g < 21; ++g) s += red[(g * 24 + cl) * 5 + r]; const int jj = F.c * 24 + cl; F.MOD[r * 6144 + jj] = s + F.ada_b[jj]; }
        __syncthreads();
    }
    for (int i = F.c * 512 + F.tid; i < 16 * DM; i += F.G * 512) { const int j = i >> 10, k = i & 1023; F.WDT[i] = F.w_in[(size_t)k * INCOLS + 1536 + j]; }
    LAS float* scr = (LAS float*)(F.lds + F.wave * 8704);
    const int gw = F.c * 8 + F.wave, NGW = F.G * 8;
    constexpr int I_IN = 16 * 128, I_OUT = 16 * 32, I_GU = 16 * 16 * 64, I_D = 16 * 16 * 32;
    for (int it = gw; it < I_IN + I_OUT + I_GU + I_D; it += NGW) {
        int r = it;
        if (r < I_IN) { const int kb = r / 128, nb = r % 128, n0 = nb * 32; tr_item(F.w_in, INCOLS, n0 < 1536 ? n0 : n0 + 16, kb * 64, F.WIN + (size_t)n0 * DM, DM, scr, F.lane); continue; } r -= I_IN;
        if (r < I_OUT) { const int kb = r / 32, nb = r % 32; tr_item(F.w_out, DM, nb * 32, kb * 64, F.WOUT + (size_t)nb * 32 * DM, DM, scr, F.lane); continue; } r -= I_OUT;
        if (r < I_GU) { const int e = r / 1024, q = r % 1024, kb = q / 64, nb = q % 64, r0 = nb * 32, blk = r0 >> 7, within = r0 & 127, isu = blk & 1, f0 = (blk >> 1) * 128 + within;
            tr_item((isu ? F.w_up : F.w_gate) + (size_t)e * DM * FF, FF, f0, kb * 64, F.WGU + ((size_t)e * 2048 + r0) * DM, DM, scr, F.lane); continue; } r -= I_GU;
        { const int e = r / 512, q = r % 512, kb = q / 32, nb = q % 32; tr_item(F.w_down + (size_t)e * FF * DM, DM, nb * 32, kb * 64, F.WD + ((size_t)e * DM + nb * 32) * FF, FF, scr, F.lane); }
    }
}

DI void phase_hrows(const Ctx& F) {
    const int gw = F.c * 8 + F.wave, NGW = F.G * 8, lane = F.lane;
    for (int row = gw; row < MTOT; row += NGW) {
        const float* xr = row < MLAT ? F.x + (size_t)row * DM : F.ctx + (size_t)(row - MLAT) * DM;
        const int r = row < MLAT ? row / SEQ : 4;
        const float* shift = F.MOD + r * 6144, *scale = F.MOD + r * 6144 + 1024;
        f32x4 v[4]; float ss = 0.f;
#pragma unroll
        for (int j = 0; j < 4; ++j) { v[j] = *(const f32x4*)(xr + 4 * lane + 256 * j); ss += v[j].x * v[j].x + v[j].y * v[j].y + v[j].z * v[j].z + v[j].w * v[j].w; }
        const float rstd = rsqrtf(wave_sum(ss) * (1.f / DM) + EPS);
#pragma unroll
        for (int j = 0; j < 4; ++j) {
            const int k = 4 * lane + 256 * j;
            const f32x4 nw = *(const f32x4*)(F.norm_w + k), sc = *(const f32x4*)(scale + k), sh = *(const f32x4*)(shift + k);
            v[j] = v[j] * rstd * nw * (1.f + sc) + sh;
            f16x4 o; o.x = (f16)v[j].x; o.y = (f16)v[j].y; o.z = (f16)v[j].z; o.w = (f16)v[j].w;
            *(f16x4*)(F.H + (size_t)row * DM + k) = o;
        }
        float mine = 0.f;
        for (int d = 0; d < 16; ++d) {
            float p = 0.f;
#pragma unroll
            for (int j = 0; j < 4; ++j) { const f32x4 w = *(const f32x4*)(F.WDT + d * DM + 4 * lane + 256 * j); p += v[j].x * w.x + v[j].y * w.y + v[j].z * w.z + v[j].w * w.w; }
            p = wave_sum(p);
            mine = lane == d ? p : mine;
        }
        if (lane < 16) F.DT[(size_t)row * 16 + lane] = mine;
    }
}

DI void phase_post(const Ctx& F) {
    LAS float* wr = (LAS float*)F.lds;
    for (int i = F.tid; i < DM * 16; i += 512) wr[i] = F.w_router[i];
    __syncthreads();
    const int lane = F.lane, gw = F.c * 8 + F.wave, NGW = F.G * 8;
    for (int row = gw; row < MLAT; row += NGW) {
        const int b = row / SEQ, t = row % SEQ;
        const float* mod = F.MOD + b * 6144;
        f32x4 r[4], xl[4]; float ss = 0.f;
#pragma unroll
        for (int j = 0; j < 4; ++j) { r[j] = *(const f32x4*)(F.R + (size_t)row * DM + 4 * lane + 256 * j); ss += r[j].x * r[j].x + r[j].y * r[j].y + r[j].z * r[j].z + r[j].w * r[j].w; }
        const float rstd = rsqrtf(wave_sum(ss) * (1.f / DM) + EPS);
        float s2 = 0.f;
#pragma unroll
        for (int j = 0; j < 4; ++j) {
            const int k = 4 * lane + 256 * j;
            const f32x4 xv = *(const f32x4*)(F.x + (size_t)row * DM + k), nw = *(const f32x4*)(F.norm_w + 1024 + k), gt = *(const f32x4*)(mod + 2048 + k);
            xl[j] = xv + gt * (r[j] * rstd * nw);
            *(f32x4*)(F.XLAT + (size_t)row * DM + k) = xl[j];
            s2 += xl[j].x * xl[j].x + xl[j].y * xl[j].y + xl[j].z * xl[j].z + xl[j].w * xl[j].w;
        }
        const float rstd2 = rsqrtf(wave_sum(s2) * (1.f / DM) + EPS);
        float lg[16];
#pragma unroll
        for (int e = 0; e < 16; ++e) lg[e] = 0.f;
#pragma unroll
        for (int j = 0; j < 4; ++j) {
            const int k = 4 * lane + 256 * j;
            const f32x4 nw = *(const f32x4*)(F.norm_w + 2048 + k), sh = *(const f32x4*)(mod + 3072 + k), sc = *(const f32x4*)(mod + 4096 + k);
            const f32x4 hv = xl[j] * rstd2 * nw * (1.f + sc) + sh;
            f16x4 o; o.x = (f16)hv.x; o.y = (f16)hv.y; o.z = (f16)hv.z; o.w = (f16)hv.w;
            *(f16x4*)(F.H2 + (size_t)row * DM + k) = o;
#pragma unroll
            for (int kk = 0; kk < 4; ++kk) {
                const LAS f32x4* wp = (const LAS f32x4*)(wr + (k + kk) * 16); const float hk = hv[kk];
#pragma unroll
                for (int q = 0; q < 4; ++q) { const f32x4 w = wp[q]; lg[4 * q + 0] += hk * w.x; lg[4 * q + 1] += hk * w.y; lg[4 * q + 2] += hk * w.z; lg[4 * q + 3] += hk * w.w; }
                __builtin_amdgcn_sched_barrier(0);
            }
        }
        float mx = -1e30f;
#pragma unroll
        for (int e = 0; e < 16; ++e) { lg[e] = wave_sum(lg[e]); mx = fmaxf(mx, lg[e]); }
        float den = 0.f;
#pragma unroll
        for (int e = 0; e < 16; ++e) { lg[e] = __expf(lg[e] - mx); den += lg[e]; }
        const float inv = 1.f / den;
        if (lane < 16) { float v = 0.f;
#pragma unroll
            for (int e = 0; e < 16; ++e) v = lane == e ? lg[e] : v;
            F.AFF[((size_t)b * 16 + lane) * SEQ + t] = v * inv; }
    }
    __syncthreads();
}

DI void phase_topk(const Ctx& F) {
    if (F.c >= 64) return;
    LAS unsigned* vals = (LAS unsigned*)F.lds;
    LAS unsigned* hist = vals + SEQ;
    LAS unsigned* sm = hist + 256;
    const int be = F.c, tid = F.tid;
    const float* a = F.AFF + (size_t)be * SEQ;
    for (int i = tid; i < SEQ; i += 512) vals[i] = __float_as_uint(a[i]);
    if (tid == 0) { sm[0] = 0u; sm[1] = CAP; }
    __syncthreads();
    unsigned mask = 0u;
    for (int pass = 0; pass < 4; ++pass) {
        const int shift = 24 - 8 * pass;
        if (tid < 256) hist[tid] = 0u;
        __syncthreads();
        const unsigned prefix = sm[0];
        for (int i = tid; i < SEQ; i += 512) { const unsigned v = vals[i]; if ((v & mask) == prefix) atomicAdd((unsigned*)&hist[(v >> shift) & 255u], 1u); }
        __syncthreads();
        if (tid == 0) {
            unsigned k = sm[1], cum = 0u; int bin = 255;
            for (; bin > 0; --bin) { if (cum + hist[bin] >= k) break; cum += hist[bin]; }
            sm[1] = k - cum; sm[0] = prefix | ((unsigned)bin << shift);
        }
        mask |= 255u << shift;
        __syncthreads();
    }
    const unsigned T = sm[0], keq = sm[1];
    unsigned cg = 0, ce = 0;
    for (int j = 0; j < 16; ++j) { const unsigned v = vals[tid * 16 + j]; cg += v > T; ce += v == T; }
    const int lane = tid & 63, w = tid >> 6;
    unsigned ig = cg, ie = ce;
    for (int o = 1; o < 64; o <<= 1) { const unsigned tg = __shfl_up(ig, o), te = __shfl_up(ie, o); if (lane >= o) { ig += tg; ie += te; } }
    if (lane == 63) { sm[2 + w] = ig; sm[10 + w] = ie; }
    __syncthreads();
    unsigned og = 0, oe = 0;
    for (int i = 0; i < w; ++i) { og += sm[2 + i]; oe += sm[10 + i]; }
    unsigned pg = og + ig - cg, pe = oe + ie - ce;
    const int rowbase = ((be & 15) * 4 + (be >> 4)) * CAP;
    for (int j = 0; j < 16; ++j) {
        const int t = tid * 16 + j; const unsigned v = vals[t];
        int slot = -1;
        if (v > T) { slot = (int)(pg + (pe < keq ? pe : keq)); pg++; }
        else if (v == T) { if (pe < keq) slot = (int)(pg + pe); pe++; }
        F.SLOT[(size_t)be * SEQ + t] = slot;
        if (slot >= 0) { F.IDX[rowbase + slot] = t; F.GATEV[rowbase + slot] = __uint_as_float(v); }
    }
    __syncthreads();
}

DI void phase_combine(const Ctx& F) {
    const int lane = F.lane, gw = F.c * 8 + F.wave, NGW = F.G * 8;
    for (int row = gw; row < MLAT; row += NGW) {
        const int b = row / SEQ, t = row % SEQ;
        f32x4 acc[4];
#pragma unroll
        for (int j = 0; j < 4; ++j) acc[j] = (f32x4){0, 0, 0, 0};
        for (int e = 0; e < NE; ++e) {
            const int s = F.SLOT[((size_t)b * 16 + e) * SEQ + t];
            if (s >= 0) {
                const f16* yr = F.YM + (size_t)((e * 4 + b) * CAP + s) * DM;
#pragma unroll
                for (int j = 0; j < 4; ++j) { const f16x4 v = *(const f16x4*)(yr + 4 * lane + 256 * j); acc[j].x += (float)v.x; acc[j].y += (float)v.y; acc[j].z += (float)v.z; acc[j].w += (float)v.w; }
            }
        }
        float ss = 0.f;
#pragma unroll
        for (int j = 0; j < 4; ++j) ss += acc[j].x * acc[j].x + acc[j].y * acc[j].y + acc[j].z * acc[j].z + acc[j].w * acc[j].w;
        const float rstd = rsqrtf(wave_sum(ss) * (1.f / DM) + EPS);
#pragma unroll
        for (int j = 0; j < 4; ++j) {
            const int k = 4 * lane + 256 * j;
            const f32x4 xl = *(const f32x4*)(F.XLAT + (size_t)row * DM + k), nw = *(const f32x4*)(F.norm_w + 3072 + k), gt = *(const f32x4*)(F.MOD + b * 6144 + 5120 + k);
            *(f32x4*)(F.out + (size_t)row * DM + k) = xl + gt * (acc[j] * rstd * nw);
        }
    }
}


namespace mx {
DI int swz(int row, int chunk) { return row * 256 + ((chunk ^ (row & 15)) << 4); }
template <bool TR>
DI void conv_tile(const f16* U, int row0, int s0, int seglo, int seghi, int ucol, const float* cw, const float* cb, LAS unsigned char* T, int rbase, int chunk) {
    f16x8 raw[12];
#pragma unroll
    for (int i = 0; i < 12; ++i) { const int s = s0 - 2 + i; const bool ok = s >= seglo && s < seghi;
        if (ok) raw[i] = *(const f16x8*)(U + (size_t)(row0 + s) * NU + ucol); else raw[i] = (f16x8){0, 0, 0, 0, 0, 0, 0, 0}; }
    const int cc = ucol - UXBC;
    float w[5][8], bb[8];
#pragma unroll
    for (int j = 0; j < 8; ++j) bb[j] = cb[cc + j];
#pragma unroll
    for (int tp = 0; tp < 5; ++tp)
#pragma unroll
        for (int j = 0; j < 8; ++j) w[tp][j] = cw[tp * 1024 + cc + j];
    f16x8 vt[8];
#pragma unroll
    for (int t = 0; t < 8; ++t) { f16x8 v;
#pragma unroll
        for (int j = 0; j < 8; ++j) { float a = bb[j];
#pragma unroll
            for (int tp = 0; tp < 5; ++tp) a += w[tp][j] * (float)raw[t + tp][j];
            const f16 r = (f16)silu_f(a);
            if (TR) vt[j][t] = r; else v[j] = r; }
        if (!TR) *(LAS f16x8*)(T + swz(rbase + t, chunk)) = v; }
    if (TR) {
#pragma unroll
        for (int j = 0; j < 8; ++j) *(LAS f16x8*)(T + swz(rbase + j, chunk)) = vt[j]; }
}
DI void scan128(float a0, float a1, float& c0, float& c1, float& tot) {
    float p = a0 + a1;
#pragma unroll
    for (int o = 1; o < 64; o <<= 1) { const float t = __shfl_up(p, o); if ((int)(threadIdx.x & 63) >= o) p += t; }
    c1 = p; c0 = p - a1; tot = __shfl(p, 63);
}
constexpr size_t SSD_SLOT = 8192;
DI size_t ssd_sid(int b, int ck, int h, int dir) { return (size_t)(((b * 66 + ck) * 8 + h) * 2 + dir); }

DI void ssd_a_unit(const Ctx& F, f16* ST, float* TOTS, int b, int ck, int h) {
    const int g = h >> 2, tid = F.tid, lane = F.lane, fr = lane & 15, fq = lane >> 4;
    const int row0 = ck < 2 ? MLAT + b * CTXL + 128 * ck : b * SEQ + 128 * (ck - 2);
    LAS unsigned char* XT = F.lds;
    LAS unsigned char* BT = F.lds + 64 * 256;
    LAS float* dtA = (LAS float*)(F.lds + 192 * 256);
    LAS float* laA = dtA + 256;
    LAS f16* w16 = (LAS f16*)(laA + 256);
    if (tid < 384) {
        const int tr = tid & 15, g8 = tid >> 4;
        const int s0 = 8 * tr;
        int seglo, seghi;
        if (ck < 2) { seglo = -128 * ck; seghi = seglo + 256; } else { seglo = s0 & ~63; seghi = seglo + 64; }
        const int ucol = g8 < 8 ? UXBC + h * 64 + 8 * g8 : UXBC + 512 + g * 128 + 8 * (g8 - 8);
        conv_tile<true>(F.U, row0, s0, seglo, seghi, ucol, F.conv_w, F.conv_b, g8 < 8 ? XT : BT, g8 < 8 ? 8 * g8 : 8 * (g8 - 8), tr);
    } else {
        const int s = tid - 384;
#pragma unroll
        for (int dir = 0; dir < 2; ++dir) { const float d = softplus_f(F.DT[(size_t)(row0 + s) * 16 + dir * 8 + h] + F.dt_bias[dir * 8 + h]);
            dtA[dir * 128 + s] = d; laA[dir * 128 + s] = -d * __expf(F.a_log[dir * 8 + h]); }
    }
    __syncthreads();
    if (F.wave < 2) {
        const int dir = F.wave; const float a0 = laA[dir * 128 + 2 * lane], a1 = laA[dir * 128 + 2 * lane + 1];
        float c0, c1, tot; scan128(a0, a1, c0, c1, tot);
        const float e0 = dir == 0 ? tot - c0 : c0 - a0, e1 = dir == 0 ? tot - c1 : c1 - a1;
        w16[dir * 128 + 2 * lane] = (f16)(dtA[dir * 128 + 2 * lane] * __expf(e0));
        w16[dir * 128 + 2 * lane + 1] = (f16)(dtA[dir * 128 + 2 * lane + 1] * __expf(e1));
        if (lane == 0) TOTS[ssd_sid(b, ck, h, dir)] = __expf(tot);
    }
    __syncthreads();
    {
        const int dir = F.wave & 1, ntp = F.wave >> 1;
        f32x4 acc[2][4];
#pragma unroll
        for (int i = 0; i < 2; ++i)
#pragma unroll
            for (int j = 0; j < 4; ++j) acc[i][j] = (f32x4){0, 0, 0, 0};
#pragma unroll
        for (int kk = 0; kk < 4; ++kk) {
            const f16x8 wv = *(const LAS f16x8*)(w16 + dir * 128 + 32 * kk + 8 * fq);
            f16x8 a[2], bf[4];
#pragma unroll
            for (int nt = 0; nt < 2; ++nt) a[nt] = *(const LAS f16x8*)(BT + swz(16 * (2 * ntp + nt) + fr, 4 * kk + fq)) * wv;
#pragma unroll
            for (int pt = 0; pt < 4; ++pt) bf[pt] = *(const LAS f16x8*)(XT + swz(16 * pt + fr, 4 * kk + fq));
#pragma unroll
            for (int nt = 0; nt < 2; ++nt)
#pragma unroll
                for (int pt = 0; pt < 4; ++pt) acc[nt][pt] = __builtin_amdgcn_mfma_f32_16x16x32_f16(a[nt], bf[pt], acc[nt][pt], 0, 0, 0);
        }
        f16* S = ST + ssd_sid(b, ck, h, dir) * SSD_SLOT;
#pragma unroll
        for (int nt = 0; nt < 2; ++nt)
#pragma unroll
            for (int pt = 0; pt < 4; ++pt) { f16x4 o; o.x = (f16)acc[nt][pt].x; o.y = (f16)acc[nt][pt].y; o.z = (f16)acc[nt][pt].z; o.w = (f16)acc[nt][pt].w;
                *(f16x4*)(S + (size_t)(16 * pt + fr) * 128 + 16 * (2 * ntp + nt) + 4 * fq) = o; }
    }
    __syncthreads();
}

DI void ssd_b(const Ctx& F, f16* ST, const float* TOTS) {
    const int idx = F.c * 512 + F.tid; if (idx >= 64 * 2048) return;
    const int e = idx & 2047, chain = idx >> 11, dir = chain & 1, h = (chain >> 1) & 7, b = chain >> 4;
    float run[4] = {0.f, 0.f, 0.f, 0.f};
    for (int s0 = 0; s0 < 66; s0 += 6) {
        f16x4 loc[6]; float d[6]; f16* p[6];
#pragma unroll
        for (int i = 0; i < 6; ++i) { const int st = s0 + i; const int ck = dir == 0 ? st : (st < 2 ? 1 - st : 67 - st);
            const size_t sid = ssd_sid(b, ck, h, dir); p[i] = ST + sid * SSD_SLOT + (size_t)e * 4; loc[i] = *(const f16x4*)p[i]; d[i] = TOTS[sid]; }
#pragma unroll
        for (int i = 0; i < 6; ++i) { f16x4 o; o.x = (f16)run[0]; o.y = (f16)run[1]; o.z = (f16)run[2]; o.w = (f16)run[3]; *(f16x4*)p[i] = o;
            run[0] = d[i] * run[0] + (float)loc[i].x; run[1] = d[i] * run[1] + (float)loc[i].y; run[2] = d[i] * run[2] + (float)loc[i].z; run[3] = d[i] * run[3] + (float)loc[i].w; }
    }
}

DI void ssd_c_unit(const Ctx& F, const f16* ST, int b, int c, int g) {
    const int tid = F.tid, lane = F.lane, fr = lane & 15, fq = lane >> 4, w = F.wave;
    const int row0 = b * SEQ + 128 * c;
    LAS unsigned char* CT = F.lds;
    LAS unsigned char* BM = F.lds + 128 * 256;
    LAS unsigned char* XT = F.lds + 256 * 256;
    LAS float* dtA = (LAS float*)(F.lds + 131072);
    LAS float* csA = dtA + 1024;
    {
        const int tr = tid & 15, g8 = tid >> 4, s0 = 8 * tr, seglo = s0 & ~63;
        conv_tile<true>(F.U, row0, s0, seglo, seglo + 64, UXBC + g * 256 + 8 * g8, F.conv_w, F.conv_b, XT, 8 * g8, tr);
    }
    __builtin_amdgcn_sched_barrier(0);
    {
        const int g8 = tid & 31, tr = tid >> 5, s0 = 8 * tr, seglo = s0 & ~63;
        conv_tile<false>(F.U, row0, s0, seglo, seglo + 64, UXBC + 512 + (g8 >> 4) * 256 + g * 128 + 8 * (g8 & 15), F.conv_w, F.conv_b, g8 < 16 ? BM : CT, s0, g8 & 15);
    }
    __builtin_amdgcn_sched_barrier(0);
#pragma unroll
    for (int q = 0; q < 2; ++q) { const int idx = tid + 512 * q, s = idx & 127, hd = idx >> 7, hh = hd >> 1, dir = hd & 1, h = g * 4 + hh;
        const float d = softplus_f(F.DT[(size_t)(row0 + s) * 16 + dir * 8 + h] + F.dt_bias[dir * 8 + h]);
        dtA[hd * 128 + s] = d; csA[hd * 128 + s] = -d * __expf(F.a_log[dir * 8 + h]); }
    __syncthreads();
    {
        const float a0 = csA[w * 128 + 2 * lane], a1 = csA[w * 128 + 2 * lane + 1];
        float c0, c1, tot; scan128(a0, a1, c0, c1, tot);
        if (w & 1) { c0 = tot - c0 + a0; c1 = tot - c1 + a1; }
        csA[w * 128 + 2 * lane] = c0; csA[w * 128 + 2 * lane + 1] = c1;
    }
    __syncthreads();
    const int l = 16 * w + fr;
    f16x8 cfr[4];
#pragma unroll
    for (int kk = 0; kk < 4; ++kk) cfr[kk] = *(const LAS f16x8*)(CT + swz(l, 4 * kk + fq));
    f32x4 gacc[8];
#pragma unroll
    for (int st = 0; st < 8; ++st) { gacc[st] = (f32x4){0, 0, 0, 0};
#pragma unroll
        for (int kk = 0; kk < 4; ++kk) gacc[st] = __builtin_amdgcn_mfma_f32_16x16x32_f16(*(const LAS f16x8*)(BM + swz(16 * st + fr, 4 * kk + fq)), cfr[kk], gacc[st], 0, 0, 0); }
    __syncthreads();
    const size_t urow = (size_t)(row0 + l) * NU + UZ + g * 256;
    float ss = 0.f;
#pragma unroll 1
    for (int hh = 0; hh < 4; ++hh) {
        const int h = g * 4 + hh;
        const LAS float* dtf = dtA + (2 * hh) * 128, *dtb = dtA + (2 * hh + 1) * 128, *csf = csA + (2 * hh) * 128, *rcb = csA + (2 * hh + 1) * 128;
        const float csf_l = csf[l], rcb_l = rcb[l], dsum_l = dtf[l] + dtb[l], dskip = F.ssd_d[h];
        f32x4 yacc[4];
#pragma unroll
        for (int pt = 0; pt < 4; ++pt) yacc[pt] = (f32x4){0, 0, 0, 0};
#pragma unroll
        for (int kk = 0; kk < 4; ++kk) {
            f16x8 m;
#pragma unroll
            for (int hf = 0; hf < 2; ++hf) { const int st = 2 * kk + hf, sb = 16 * st + 4 * fq;
                const f32x4 cf = *(const LAS f32x4*)(csf + sb), rb = *(const LAS f32x4*)(rcb + sb), df = *(const LAS f32x4*)(dtf + sb), db = *(const LAS f32x4*)(dtb + sb);
#pragma unroll
                for (int r = 0; r < 4; ++r) { const int s = sb + r;
                    const float arg = s < l ? csf_l - cf[r] : (s > l ? rcb_l - rb[r] : 0.f);
                    const float dsel = s < l ? df[r] : (s > l ? db[r] : dsum_l);
                    float val = gacc[st][r] * __expf(arg) * dsel; if (s == l) val += dskip;
                    m[hf * 4 + r] = (f16)val; } }
#pragma unroll
            for (int pt = 0; pt < 4; ++pt) { const int p = 64 * hh + 16 * pt + fr;
                const f16x4 x0 = *(const LAS f16x4*)(XT + swz(p, 4 * kk + (fq >> 1)) + 8 * (fq & 1));
                const f16x4 x1 = *(const LAS f16x4*)(XT + swz(p, 4 * kk + 2 + (fq >> 1)) + 8 * (fq & 1));
                f16x8 xf; xf[0] = x0[0]; xf[1] = x0[1]; xf[2] = x0[2]; xf[3] = x0[3]; xf[4] = x1[0]; xf[5] = x1[1]; xf[6] = x1[2]; xf[7] = x1[3];
                yacc[pt] = __builtin_amdgcn_mfma_f32_16x16x32_f16(xf, m, yacc[pt], 0, 0, 0); }
        }
#pragma unroll
        for (int dir = 0; dir < 2; ++dir) {
            const f16* S = ST + ssd_sid(b, c + 2, h, dir) * SSD_SLOT;
            f32x4 off[4];
#pragma unroll
            for (int pt = 0; pt < 4; ++pt) off[pt] = (f32x4){0, 0, 0, 0};
#pragma unroll
            for (int kk = 0; kk < 4; ++kk)
#pragma unroll
                for (int pt = 0; pt < 4; ++pt) off[pt] = __builtin_amdgcn_mfma_f32_16x16x32_f16(*(const f16x8*)(S + (size_t)(16 * pt + fr) * 128 + 32 * kk + 8 * fq), cfr[kk], off[pt], 0, 0, 0);
            const float e = __expf(dir == 0 ? csf_l : rcb_l);
#pragma unroll
            for (int pt = 0; pt < 4; ++pt) yacc[pt] += off[pt] * e;
        }
        LAS unsigned char* stg = (hh < 2 ? CT : BM) + w * 4096 + (hh & 1) * 2048;
#pragma unroll
        for (int pt = 0; pt < 4; ++pt) { const f16x4 z = *(const f16x4*)(F.U + urow + 64 * hh + 16 * pt + 4 * fq); f16x4 o;
#pragma unroll
            for (int r = 0; r < 4; ++r) { const float v = yacc[pt][r] * silu_f((float)z[r]); ss += v * v; o[r] = (f16)v; }
            *(LAS f16x4*)(stg + fr * 128 + (16 * pt + 4 * fq) * 2) = o; }
    }
    ss += __shfl_xor(ss, 16); ss += __shfl_xor(ss, 32);
    const float rstd = rsqrtf(ss * (1.f / 256.f) + EPS);
    f16* yrow = F.Y + (size_t)(row0 + l) * DM + g * 256;
#pragma unroll
    for (int hh = 0; hh < 4; ++hh) {
        const LAS unsigned char* stg = (hh < 2 ? CT : BM) + w * 4096 + (hh & 1) * 2048;
#pragma unroll
        for (int pt = 0; pt < 4; ++pt) { const int ch = 64 * hh + 16 * pt + 4 * fq; const f32x4 nw = *(const f32x4*)(F.ssd_nw + g * 256 + ch);
            const f16x4 v = *(const LAS f16x4*)(stg + fr * 128 + (16 * pt + 4 * fq) * 2);
            f16x4 o; o.x = (f16)((float)v.x * rstd * nw.x); o.y = (f16)((float)v.y * rstd * nw.y); o.z = (f16)((float)v.z * rstd * nw.z); o.w = (f16)((float)v.w * rstd * nw.w);
            *(f16x4*)(yrow + ch) = o; }
    }
    __syncthreads();
}
}

namespace mx {
typedef short s16x8 __attribute__((ext_vector_type(8)));
DI int swz64(int row, int chunk) { return row * 128 + ((chunk ^ ((row >> 1) & 7)) << 4); }
DI unsigned short f2bf(float f) { unsigned u = __builtin_bit_cast(unsigned, f); return (unsigned short)((u + 0x7fffu + ((u >> 16) & 1u)) >> 16); }
constexpr size_t HG_SLOT = 16384;
DI size_t hg_sid(int b, int ck, int h, int dir) { return (size_t)(((b * 132 + ck) * 4 + h) * 2 + dir); }
DI f16* hg_slot(f16* HCT, f16* HLAT, int b, int ck, int h, int dir) {
    return ck < 4 ? HCT + (size_t)(((b * 4 + ck) * 4 + h) * 2 + dir) * HG_SLOT : HLAT + (size_t)(((b * 128 + (ck - 4)) * 4 + h) * 2 + dir) * HG_SLOT;
}
template <int NCH>
DI void load_raw(const Ctx& F, int row0, int ucol, LAS unsigned char* RAW) {
    constexpr int CPR = NCH / 8;
    for (int i = F.tid; i < 64 * CPR; i += 512) { const int t = i / CPR, cch = i % CPR;
        *(LAS f16x8*)(RAW + (t * NCH + cch * 8) * 2) = *(const f16x8*)(F.U + (size_t)(row0 + t) * NU + ucol + cch * 8); }
}
DI void load_vt(const Ctx& F, int row0, int h, LAS unsigned char* VT) {
    const int t2 = F.tid - 256, i = t2 & 31, g0 = t2 >> 5;
#pragma unroll
    for (int q = 0; q < 2; ++q) { const int g8 = g0 + 8 * q;
        const f16x8 a = *(const f16x8*)(F.U + (size_t)(row0 + 2 * i) * NU + UI + h * 128 + 8 * g8);
        const f16x8 b = *(const f16x8*)(F.U + (size_t)(row0 + 2 * i + 1) * NU + UI + h * 128 + 8 * g8);
#pragma unroll
        for (int j = 0; j < 8; ++j) { typedef _Float16 h2 __attribute__((ext_vector_type(2))); h2 p; p.x = a[j]; p.y = b[j];
            *(LAS h2*)(VT + swz64(8 * g8 + j, i >> 2) + (i & 3) * 4) = p; } }
}


template <int DIR>
DI void hg_a_elem(const LAS f16* rw, float lb, LAS unsigned char* T, int k, float* dec_out) {
    float lf[64]; float tot = 0.f;
#pragma unroll
    for (int i = 0; i < 64; ++i) { const int t = DIR == 0 ? i : 63 - i; const float f = lb + (1.f - lb) * sigmoid_f((float)rw[t * 128]); lf[i] = __logf(f); tot += lf[i]; if ((i & 7) == 7) __builtin_amdgcn_sched_barrier(0); }
    *dec_out = __expf(tot);
    float cum = 0.f;
#pragma unroll
    for (int jj = 0; jj < 8; ++jj) { const int j = DIR == 0 ? jj : 7 - jj; f16x8 v;
#pragma unroll
        for (int qq = 0; qq < 8; ++qq) { const int q = DIR == 0 ? qq : 7 - qq; const int i = DIR == 0 ? 8 * j + q : 63 - (8 * j + q); cum += lf[i]; v[q] = (f16)((1.f - __expf(lf[i])) * __expf(tot - cum)); }
        *(LAS f16x8*)(T + k * 128 + ((j ^ ((k >> 1) & 7)) << 4)) = v; __builtin_amdgcn_sched_barrier(0); }
}
template <int DIR>
DI void hg_c_elem(const LAS f16* rf, const LAS f16* rq, float lb, LAS unsigned char* TQ, LAS unsigned char* TK, int k) {
    float lf[64];
#pragma unroll
    for (int i = 0; i < 64; ++i) { const int t = DIR == 0 ? i : 63 - i; const float f = lb + (1.f - lb) * sigmoid_f((float)rf[t * 128]); lf[i] = __logf(f); if ((i & 7) == 7) __builtin_amdgcn_sched_barrier(0); }
    float cum = 0.f;
    const int cb = (k & 7) * 2, cx = (k >> 3) << 4;
#pragma unroll
    for (int i = 0; i < 64; ++i) { const int t = DIR == 0 ? i : 63 - i; cum += lf[i];
        const float qv = silu_f((float)rq[t * 128]);
        const int off = t * 256 + (cx ^ ((t & 15) << 4)) + cb;
        *(LAS unsigned short*)(TQ + off) = f2bf(qv * __expf(cum));
        *(LAS unsigned short*)(TK + off) = f2bf((1.f - __expf(lf[i])) * __expf(-cum)); if ((i & 3) == 3) __builtin_amdgcn_sched_barrier(0); }
}

DI void hg_a_unit(const Ctx& F, f16* HCT, f16* HLAT, float* DEC, int b, int ck, int h) {
    const int tid = F.tid, lane = F.lane, fr = lane & 15, fq = lane >> 4, w = F.wave;
    const int row0 = ck < 4 ? MLAT + b * CTXL + 64 * ck : b * SEQ + 64 * (ck - 4);
    LAS unsigned char* RAW = F.lds;
    LAS unsigned char* KD = F.lds + 32768;
    LAS unsigned char* VT = F.lds + 65536;
    load_raw<128>(F, row0, UFF + h * 128, RAW);
    load_raw<128>(F, row0, UFB + h * 128, RAW + 64 * 256);
    if (tid >= 256) load_vt(F, row0, h, VT);
    __syncthreads();
    if (tid < 256) {
        const int k = tid & 127, dir = tid >> 7, ch = h * 128 + k;
        const float l0 = F.hgrn_lb[dir * 512 + ch], l1 = F.hgrn_lb[1024 + dir * 512 + ch];
        const float lb = 1.f / (1.f + __expf(l1 - l0));
        const LAS f16* rw = (const LAS f16*)(RAW + dir * 64 * 256) + k;
        float dec;
        if (dir == 0) hg_a_elem<0>(rw, lb, KD, k, &dec); else hg_a_elem<1>(rw, lb, KD + 16384, k, &dec);
        DEC[hg_sid(b, ck, h, dir) * 128 + k] = dec;
    }
    __syncthreads();
    {
        const int dir = w & 1, q = w >> 1;
        const LAS unsigned char* T = KD + dir * 16384;
        f32x4 acc[2][8];
#pragma unroll
        for (int i = 0; i < 2; ++i)
#pragma unroll
            for (int j = 0; j < 8; ++j) acc[i][j] = (f32x4){0, 0, 0, 0};
#pragma unroll
        for (int kk = 0; kk < 2; ++kk) {
            f16x8 a[2];
#pragma unroll
            for (int i = 0; i < 2; ++i) a[i] = *(const LAS f16x8*)(T + swz64(16 * (2 * q + i) + fr, 4 * kk + fq));
#pragma unroll
            for (int vt = 0; vt < 8; ++vt) { const f16x8 bv = *(const LAS f16x8*)(VT + swz64(16 * vt + fr, 4 * kk + fq));
#pragma unroll
                for (int i = 0; i < 2; ++i) acc[i][vt] = __builtin_amdgcn_mfma_f32_16x16x32_f16(a[i], bv, acc[i][vt], 0, 0, 0); }
        }
        f16* S = hg_slot(HCT, HLAT, b, ck, h, dir);
#pragma unroll
        for (int i = 0; i < 2; ++i)
#pragma unroll
            for (int vt = 0; vt < 8; ++vt) { f16x4 o; o.x = (f16)acc[i][vt].x; o.y = (f16)acc[i][vt].y; o.z = (f16)acc[i][vt].z; o.w = (f16)acc[i][vt].w;
                *(f16x4*)(S + (size_t)(16 * vt + fr) * 128 + 16 * (2 * q + i) + 4 * fq) = o; }
    }
    __syncthreads();
}

DI void hg_b(const Ctx& F, f16* HCT, f16* HLAT, const float* DEC) {
    const int idx = F.c * 512 + F.tid; if (idx >= 32 * 4096) return;
    const int e = idx & 4095, chain = idx >> 12, dir = chain & 1, h = (chain >> 1) & 3, b = chain >> 3;
    const int k0 = (e & 31) * 4;
    float run[4] = {0.f, 0.f, 0.f, 0.f};
    for (int s0 = 0; s0 < 132; s0 += 6) {
        f16x4 loc[6]; f32x4 d[6]; f16* p[6];
#pragma unroll
        for (int i = 0; i < 6; ++i) { const int st = s0 + i; const int ck = dir == 0 ? st : (st < 4 ? 3 - st : 135 - st);
            p[i] = hg_slot(HCT, HLAT, b, ck, h, dir) + (size_t)e * 4; loc[i] = *(const f16x4*)p[i]; d[i] = *(const f32x4*)(DEC + hg_sid(b, ck, h, dir) * 128 + k0); }
#pragma unroll
        for (int i = 0; i < 6; ++i) { f16x4 o; o.x = (f16)run[0]; o.y = (f16)run[1]; o.z = (f16)run[2]; o.w = (f16)run[3]; *(f16x4*)p[i] = o;
            run[0] = d[i].x * run[0] + (float)loc[i].x; run[1] = d[i].y * run[1] + (float)loc[i].y; run[2] = d[i].z * run[2] + (float)loc[i].z; run[3] = d[i].w * run[3] + (float)loc[i].w; }
    }
}

DI void hg_c_unit(const Ctx& F, f16* HCT, f16* HLAT, int b, int c, int h) {
    const int tid = F.tid, lane = F.lane, fr = lane & 15, fq = lane >> 4, w = F.wave;
    const int row0 = b * SEQ + 64 * c;
    LAS unsigned char* RAW = F.lds;
    LAS unsigned char* QD = F.lds + 49152;
    LAS unsigned char* KI = F.lds + 81920;
    LAS unsigned char* VT = F.lds + 114688;
    LAS float* red = (LAS float*)(F.lds + 131072);
    load_raw<128>(F, row0, UQ + h * 128, RAW);
    load_raw<128>(F, row0, UFF + h * 128, RAW + 16384);
    load_raw<128>(F, row0, UFB + h * 128, RAW + 32768);
    if (tid >= 256) load_vt(F, row0, h, VT);
    __syncthreads();
    if (tid < 256) {
        const int k = tid & 127, dir = tid >> 7, ch = h * 128 + k;
        const float l0 = F.hgrn_lb[dir * 512 + ch], l1 = F.hgrn_lb[1024 + dir * 512 + ch];
        const float lb = 1.f / (1.f + __expf(l1 - l0));
        const LAS f16* rf = (const LAS f16*)(RAW + 16384 + dir * 16384) + k;
        const LAS f16* rq = (const LAS f16*)RAW + k;
        if (dir == 0) hg_c_elem<0>(rf, rq, lb, QD, KI, k); else hg_c_elem<1>(rf, rq, lb, QD + 16384, KI + 16384, k);
    }
    __syncthreads();
    const int lt = w & 3, vh = w >> 2, l = 16 * lt + fr;
    f32x4 oacc[4];
#pragma unroll
    for (int vt = 0; vt < 4; ++vt) oacc[vt] = (f32x4){0, 0, 0, 0};
#pragma unroll
    for (int dir = 0; dir < 2; ++dir) {
        const LAS unsigned char* TQ = QD + dir * 16384; const LAS unsigned char* TK = KI + dir * 16384;
        s16x8 qfr[4];
#pragma unroll
        for (int kk = 0; kk < 4; ++kk) qfr[kk] = *(const LAS s16x8*)(TQ + swz(l, 4 * kk + fq));
        f32x4 att[4];
#pragma unroll
        for (int st = 0; st < 4; ++st) { att[st] = (f32x4){0, 0, 0, 0};
#pragma unroll
            for (int kk = 0; kk < 4; ++kk) att[st] = __builtin_amdgcn_mfma_f32_16x16x32_bf16(*(const LAS s16x8*)(TK + swz(16 * st + fr, 4 * kk + fq)), qfr[kk], att[st], 0, 0, 0); }
#pragma unroll
        for (int k2 = 0; k2 < 2; ++k2) {
            f16x8 m;
#pragma unroll
            for (int hf = 0; hf < 2; ++hf)
#pragma unroll
                for (int r = 0; r < 4; ++r) { const int s = 16 * (2 * k2 + hf) + 4 * fq + r; const bool keep = dir == 0 ? s <= l : s >= l; m[hf * 4 + r] = keep ? (f16)att[2 * k2 + hf][r] : (f16)0.f; }
#pragma unroll
            for (int vt = 0; vt < 4; ++vt) { const int v = 64 * vh + 16 * vt + fr;
                const f16x4 x0 = *(const LAS f16x4*)(VT + swz64(v, 4 * k2 + (fq >> 1)) + 8 * (fq & 1));
                const f16x4 x1 = *(const LAS f16x4*)(VT + swz64(v, 4 * k2 + 2 + (fq >> 1)) + 8 * (fq & 1));
                f16x8 xf; xf[0] = x0[0]; xf[1] = x0[1]; xf[2] = x0[2]; xf[3] = x0[3]; xf[4] = x1[0]; xf[5] = x1[1]; xf[6] = x1[2]; xf[7] = x1[3];
                oacc[vt] = __builtin_amdgcn_mfma_f32_16x16x32_f16(xf, m, oacc[vt], 0, 0, 0); }
        }
        const f16* S = hg_slot(HCT, HLAT, b, c + 4, h, dir);
#pragma unroll
        for (int kk = 0; kk < 4; ++kk) { f16x8 q16;
#pragma unroll
            for (int j = 0; j < 8; ++j) q16[j] = (f16)__builtin_bit_cast(float, ((unsigned)(unsigned short)qfr[kk][j]) << 16);
#pragma unroll
            for (int vt = 0; vt < 4; ++vt) oacc[vt] = __builtin_amdgcn_mfma_f32_16x16x32_f16(*(const f16x8*)(S + (size_t)(64 * vh + 16 * vt + fr) * 128 + 32 * kk + 8 * fq), q16, oacc[vt], 0, 0, 0); }
    }
    float ss = 0.f;
#pragma unroll
    for (int vt = 0; vt < 4; ++vt) ss += oacc[vt].x * oacc[vt].x + oacc[vt].y * oacc[vt].y + oacc[vt].z * oacc[vt].z + oacc[vt].w * oacc[vt].w;
    ss += __shfl_xor(ss, 16); ss += __shfl_xor(ss, 32);
    if (fq == 0) red[vh * 64 + l] = ss;
    __syncthreads();
    const float rstd = rsqrtf((red[l] + red[64 + l]) * (1.f / 128.f) + EPS);
    const size_t urow = (size_t)(row0 + l) * NU + UG + h * 128;
    f16* yrow = F.Y + (size_t)(row0 + l) * DM + 512 + h * 128;
#pragma unroll
    for (int vt = 0; vt < 4; ++vt) { const int v = 64 * vh + 16 * vt + 4 * fq;
        const f16x4 gz = *(const f16x4*)(F.U + urow + v); const f32x4 nw = *(const f32x4*)(F.hgrn_nw + h * 128 + v);
        f16x4 o; o.x = (f16)(oacc[vt].x * rstd * nw.x * silu_f((float)gz.x)); o.y = (f16)(oacc[vt].y * rstd * nw.y * silu_f((float)gz.y));
        o.z = (f16)(oacc[vt].z * rstd * nw.z * silu_f((float)gz.z)); o.w = (f16)(oacc[vt].w * rstd * nw.w * silu_f((float)gz.w));
        *(f16x4*)(yrow + v) = o; }
    __syncthreads();
}
}

__global__ void __launch_bounds__(512, 2) mk_fwd(Args args) {
    extern __shared__ __attribute__((aligned(16))) unsigned char lds_raw[];
    Ctx F;
    F.lds = (LAS unsigned char*)lds_raw;
    F.tid = threadIdx.x; F.lane = F.tid & 63; F.wave = __builtin_amdgcn_readfirstlane(F.tid >> 6); F.G = gridDim.x; F.c = blockIdx.x;
    unsigned char* ws = args.ws;
    F.x = args.in[0]; F.cvec = args.in[1]; F.ctx = args.in[2]; F.c_ctx = args.in[3]; F.ada_w = args.in[4]; F.ada_b = args.in[5]; F.norm_w = args.in[6]; F.w_in = args.in[7];
    F.conv_w = args.in[8]; F.conv_b = args.in[9]; F.dt_bias = args.in[10]; F.a_log = args.in[11]; F.ssd_d = args.in[12]; F.ssd_nw = args.in[13]; F.hgrn_lb = args.in[14]; F.hgrn_nw = args.in[15];
    F.w_out = args.in[16]; F.w_router = args.in[17]; F.w_gate = args.in[18]; F.w_up = args.in[19]; F.w_down = args.in[20];
    F.out = args.out;
    F.MOD = (float*)(ws + WS_MOD); F.DT = (float*)(ws + WS_DT); F.WDT = (float*)(ws + WS_WDT); F.AFF = (float*)(ws + WS_AFF);
    F.IDX = (int*)(ws + WS_IDX); F.GATEV = (float*)(ws + WS_GATEV); F.SLOT = (int*)(ws + WS_SLOT);
    F.WIN = (f16*)(ws + WS_WIN); F.WOUT = (f16*)(ws + WS_WOUT); F.WGU = (f16*)(ws + WS_WGU); F.WD = (f16*)(ws + WS_WD);
    F.H = (f16*)(ws + WS_H); F.U = (f16*)(ws + WS_U); F.Y = (f16*)(ws + WS_Y);
    F.XBC = F.H; F.H2 = F.H; F.R = (float*)(ws + WS_R); F.ACT = (f16*)(ws + WS_ACT); F.YM = (f16*)(ws + WS_YM);
    F.YS = F.out; F.OH = F.out + (size_t)MLAT * 512; F.XLAT = F.out;
    const int lo = args.ph_lo, hi = args.ph_hi;
    volatile LAS unsigned* misc = (volatile LAS unsigned*)(F.lds + LDS_MISC_OFF);
    if (F.tid < 16) misc[F.tid] = 0u;
    __syncthreads();
    XcdBarrier bar; bar.bar = (unsigned*)(ws + WS_BAR); bar.x = 0; bar.st = misc + 8;
    const bool multi = hi - lo > 1;
    if (multi) bar = xcd_barrier_post((unsigned*)(ws + WS_BAR), misc + 8);
#define IN(k) (lo <= (k) && (k) < hi)
#define SEAM(k) do { if (IN(k) && IN((k) + 1)) xcd_barrier(bar); } while (0)
    if (IN(PH_PREP)) { phase_prep(F); } SEAM(PH_PREP);
    if (IN(PH_HROWS)) { phase_hrows(F); } SEAM(PH_HROWS);
    if (IN(PH_GEMM_IN)) { gm::ProbIn p{F.H, F.WIN, F.U}; gm::gemm_phase(F.lds, p, F.G, F.c); } SEAM(PH_GEMM_IN);
    f16* SST = (f16*)(ws + WS_H); float* TOTS = (float*)(ws + WS_Y); float* DEC = (float*)(ws + WS_Y + 65536);
    f16* HCT = (f16*)(ws + WS_AFF); f16* HLAT = (f16*)F.out;
    if (IN(PH_MA)) {
        for (int u = F.c; u < 2112; u += F.G) mx::ssd_a_unit(F, SST, TOTS, u / (66 * 8), (u / 8) % 66, u & 7);
        for (int v = (F.c + 64) % F.G; v < 2112; v += F.G) mx::hg_a_unit(F, HCT, HLAT, DEC, v / (132 * 4), (v / 4) % 132, v & 3);
    } SEAM(PH_MA);
    if (IN(PH_MB)) { mx::ssd_b(F, SST, TOTS); mx::hg_b(F, HCT, HLAT, DEC); } SEAM(PH_MB);
    if (IN(PH_MC)) {
        for (int u = F.c; u < 512; u += F.G) mx::ssd_c_unit(F, SST, u >> 7, (u >> 1) & 63, u & 1);
        for (int u = F.c; u < 2048; u += F.G) mx::hg_c_unit(F, HCT, HLAT, u >> 9, (u >> 2) & 127, u & 3);
    } SEAM(PH_MC);
    if (IN(PH_GEMM_OUT)) { gm::ProbOut p{F.Y, F.WOUT, F.R}; gm::gemm_phase(F.lds, p, F.G, F.c); } SEAM(PH_GEMM_OUT);
    if (IN(PH_POST)) { phase_post(F); } SEAM(PH_POST);
    if (IN(PH_TOPK)) { phase_topk(F); } SEAM(PH_TOPK);
    if (IN(PH_GEMM_GU)) {
        LAS int* tab = (LAS int*)(F.lds + LDS_TAB_OFF);
        for (int i = 0; i < 8; ++i) { gm::Unit u; if (!gm::unit_at(i, F.G, F.c, gm::ProbGU::nM, gm::ProbGU::nN, u)) break;
            if (F.tid < 256) { const int b = (u.pm >> 2) & 3; tab[i * 256 + F.tid] = b * SEQ + F.IDX[u.pm * 256 + F.tid]; } }
        __syncthreads();
        gm::ProbGU p{F.H2, F.WGU, F.ACT, F.IDX, tab}; gm::gemm_phase(F.lds, p, F.G, F.c);
    } SEAM(PH_GEMM_GU);
    if (IN(PH_GEMM_DOWN)) { gm::ProbDown p{F.ACT, F.WD, F.YM, F.GATEV}; gm::gemm_phase(F.lds, p, F.G, F.c); } SEAM(PH_GEMM_DOWN);
    if (IN(PH_COMBINE)) { phase_combine(F); }
#undef IN
#undef SEAM
}

#ifndef MK_SPLIT
#define MK_SPLIT 0
#endif
extern "C" void kernel_launch(void* const* d_in, const int* in_sizes, int n_in, void* d_out, int out_size, void* d_ws, size_t ws_size, hipStream_t stream) {
    if (ws_size < WS_END || n_in < 21) { fprintf(stderr, "kernel_launch: bad workspace/inputs: ws %zu n_in %d\n", ws_size, n_in); return; }
    static bool attr_set = false;
    if (!attr_set) { (void)hipFuncSetAttribute((const void*)mk_fwd, hipFuncAttributeMaxDynamicSharedMemorySize, LDS_BYTES); attr_set = true; }
    Args a{}; for (int i = 0; i < 21; ++i) a.in[i] = (const float*)d_in[i]; a.out = (float*)d_out; a.ws = (unsigned char*)d_ws;
    (void)hipMemsetAsync((char*)d_ws + WS_BAR, 0, WS_CTL_BYTES, stream);
#if MK_SPLIT
    for (int ph = 0; ph < PH_COUNT; ++ph) { a.ph_lo = ph; a.ph_hi = ph + 1; hipLaunchKernelGGL(mk_fwd, dim3(256), dim3(512), LDS_BYTES, stream, a); }
#else
    a.ph_lo = 0; a.ph_hi = PH_COUNT; hipLaunchKernelGGL(mk_fwd, dim3(256), dim3(512), LDS_BYTES, stream, a);
#endif
}
```

```cpp
#include <hip/hip_runtime.h>
#include <cstdio>
#include <cstdint>

#define DI __device__ __forceinline__
typedef _Float16 f16;
typedef _Float16 f16x8 __attribute__((ext_vector_type(8)));
typedef _Float16 f16x4 __attribute__((ext_vector_type(4)));
typedef float f32x4 __attribute__((ext_vector_type(4)));

constexpr int DM = 1024, NB = 4, SEQ = 8192, CTXL = 256;
constexpr int MLAT = NB * SEQ;
constexpr int MCTX = NB * CTXL;
constexpr int MTOT = MLAT + MCTX;
constexpr int INCOLS = 4112, NU = 4096;
constexpr int UZ = 0, UXBC = 512, UQ = 1536, UFF = 2048, UFB = 2560, UI = 3072, UG = 3584;
constexpr int NE = 16, FF = 1024, CAP = 1024;
constexpr float EPS = 1e-6f;

constexpr size_t MiB = 1u << 20;
constexpr size_t WS_MOD = 1 * MiB;
constexpr size_t WS_DT = 2 * MiB;
constexpr size_t WS_WDT = 5 * MiB;
constexpr size_t WS_AFF = 6 * MiB;
constexpr size_t WS_IDX = 8 * MiB;
constexpr size_t WS_GATEV = 8 * MiB + 256 * 1024;
constexpr size_t WS_SLOT = 9 * MiB;
constexpr size_t WS_WIN = 12 * MiB;
constexpr size_t WS_WOUT = 20 * MiB;
constexpr size_t WS_WGU = 22 * MiB;
constexpr size_t WS_WD = 86 * MiB;
constexpr size_t WS_H = 118 * MiB;
constexpr size_t WS_U = 184 * MiB;
constexpr size_t WS_Y = 448 * MiB;
constexpr size_t WS_END = 512 * MiB;
constexpr size_t WS_ACT = WS_U;
constexpr size_t WS_YM = WS_U + 128 * MiB;
constexpr size_t WS_R = WS_U;

DI float silu_f(float x) { return x * __builtin_amdgcn_rcpf(1.f + __expf(-x)); }
DI float sigmoid_f(float x) { return __builtin_amdgcn_rcpf(1.f + __expf(-x)); }
DI float softplus_f(float x) { return x > 20.f ? x : log1pf(__expf(x)); }
DI float wave_sum(float v) {
#pragma unroll
    for (int o = 1; o < 64; o <<= 1) v += __shfl_xor(v, o);
    return v;
}


DI float reduce16(const float (&v)[16]) {
    const int lane = threadIdx.x & 63;
    float w8[8], w4[4], w2[2];
    const bool b0 = lane & 1, b1 = lane & 2, b2 = lane & 4, b3 = lane & 8;
#pragma unroll
    for (int i = 0; i < 8; ++i) { const float keep = b0 ? v[2 * i + 1] : v[2 * i], send = b0 ? v[2 * i] : v[2 * i + 1]; w8[i] = keep + __shfl_xor(send, 1); }
#pragma unroll
    for (int i = 0; i < 4; ++i) { const float keep = b1 ? w8[2 * i + 1] : w8[2 * i], send = b1 ? w8[2 * i] : w8[2 * i + 1]; w4[i] = keep + __shfl_xor(send, 2); }
#pragma unroll
    for (int i = 0; i < 2; ++i) { const float keep = b2 ? w4[2 * i + 1] : w4[2 * i], send = b2 ? w4[2 * i] : w4[2 * i + 1]; w2[i] = keep + __shfl_xor(send, 4); }
    float r = (b3 ? w2[1] : w2[0]) + __shfl_xor(b3 ? w2[0] : w2[1], 8);
    r += __shfl_xor(r, 16); r += __shfl_xor(r, 32);
    return r;
}
#define LAS __attribute__((address_space(3)))
typedef unsigned u32x4 __attribute__((ext_vector_type(4)));
namespace gm {
constexpr int BM = 256, BK = 64, HALF = 128, HTB = HALF * BK * 2, STAGE_BYTES = 8 * HTB, NXCD = 8, WGM = 8, KD = 1024, NT = KD / BK;
DI int lds_byte(int r, int c) { const int st = (r >> 4) * 2 + (c >> 5), rr = r & 15, cc = c & 31, ob = rr * 64 + cc * 2; return st * 1024 + (ob ^ (((ob >> 9) & 1) << 5)); }
DI void stage_rc(int b, int& R, int& C) { const int st = b / 1024, sb = b % 1024, swz = sb ^ (((sb >> 9) & 1) << 5); R = (st >> 1) * 16 + swz / 64; C = (st & 1) * 32 + (swz % 64) / 2; }
DI int perm32(int rho) { const int n = rho >> 4, i = rho & 15; return 8 * (i >> 2) + 4 * n + (i & 3); }
struct Unit { int pm, pn; };
DI bool unit_at(int i, int G, int c, int nM, int nN, Unit& u) {
    const int nwg = nM * nN; const long L = (long)i * G + c; if (L >= nwg) return false;
    int wgid = (int)L; { const int q = nwg / NXCD, r = nwg % NXCD, xcd = wgid % NXCD, off = wgid / NXCD; wgid = (xcd < r ? xcd * (q + 1) : r * (q + 1) + (xcd - r) * q) + off; }
    const int nig = WGM * nN, gid = wgid / nig, fm = gid * WGM, gsz = (nM - fm) < WGM ? (nM - fm) : WGM;
    u.pm = fm + ((wgid % nig) % gsz); u.pn = (wgid % nig) / gsz; return true;
}
typedef f32x4 Acc[2][2][4][2];
DI unsigned pack2(float a, float b) { typedef _Float16 h2 __attribute__((ext_vector_type(2))); h2 v; v.x = (f16)a; v.y = (f16)b; return __builtin_bit_cast(unsigned, v); }

template <class P>
DI void gemm_phase(LAS unsigned char* lds, const P& p, int G, int c, int tid) {
    const int wid = __builtin_amdgcn_readfirstlane(tid >> 6), lane = tid & 63, wr = wid >> 2, wc = wid & 3, fr = lane & 15, fq = lane >> 4;
    constexpr int K = KD, nt = NT;
    int Rr[2], Cc[2]; unsigned voffB[2];
#pragma unroll
    for (int i = 0; i < 2; ++i) { stage_rc(tid * 16 + i * 8192, Rr[i], Cc[i]); const int Rb = P::PERM ? ((Rr[i] & ~31) + perm32(Rr[i] & 31)) : Rr[i]; voffB[i] = (unsigned)(Rb * K + Cc[i]) * 2u; }
    const size_t kstep = (size_t)(BK * 2);
    const size_t hstep = (size_t)HALF * K * 2;
    const unsigned ldsw = (unsigned)wid * 1024u;
    const int aoff = lds_byte(wr * 64 + fr, fq * 8), boff = lds_byte(wc * 32 + fr, fq * 8);
#define G_SA(b, h) (((b) * 2 + (h)) * HTB)
#define G_SB(b, h) ((4 + (b) * 2 + (h)) * HTB)
#define G_STAGEB(bufoff, gbase) do { _Pragma("unroll") for (int _i = 0; _i < 2; ++_i) \
        __builtin_amdgcn_global_load_lds((const unsigned*)((const char*)(gbase) + voffB[_i]), (LAS unsigned*)(lds + (bufoff) + ldsw + _i * 8192), 16, 0, 0); } while (0)
#define G_STAGEA(bufoff, offs, h, koff) do { _Pragma("unroll") for (int _i = 0; _i < 2; ++_i) \
        __builtin_amdgcn_global_load_lds((const unsigned*)(gA + (offs)[h][_i] + (koff)), (LAS unsigned*)(lds + (bufoff) + ldsw + _i * 8192), 16, 0, 0); } while (0)
#define G_LDA(dst, b, h) do { _Pragma("unroll") for (int m = 0; m < 4; ++m) _Pragma("unroll") for (int k = 0; k < 2; ++k) dst[m][k] = *(const LAS f16x8*)(lds + G_SA(b, h) + aoff + m * 2048 + k * 1024); } while (0)
#define G_LDB(dst, b, h) do { _Pragma("unroll") for (int n = 0; n < 2; ++n) _Pragma("unroll") for (int k = 0; k < 2; ++k) dst[n][k] = *(const LAS f16x8*)(lds + G_SB(b, h) + boff + n * 2048 + k * 1024); } while (0)
#define G_MMA(ai, bj, At, Bt) do { __builtin_amdgcn_s_setprio(1); _Pragma("unroll") for (int m = 0; m < 4; ++m) _Pragma("unroll") for (int n = 0; n < 2; ++n) _Pragma("unroll") for (int k = 0; k < 2; ++k) \
        acc[ai][bj][m][n] = __builtin_amdgcn_mfma_f32_16x16x32_f16(Bt[n][k], At[m][k], acc[ai][bj][m][n], 0, 0, 0); __builtin_amdgcn_s_setprio(0); } while (0)
#define G_WAIT_V(n) asm volatile("s_waitcnt vmcnt(" #n ")" ::: "memory")
#define G_WAIT_L(n) asm volatile("s_waitcnt lgkmcnt(" #n ")" ::: "memory")
#define G_BAR __builtin_amdgcn_s_barrier()
#define G_SCHED __builtin_amdgcn_sched_barrier(0)
    Unit cur, nxt; int ui = 0;
    if (!unit_at(0, G, c, P::nM, P::nN, cur)) return;
    Acc acc;
#pragma unroll
    for (int a = 0; a < 2; ++a)
#pragma unroll
        for (int b = 0; b < 2; ++b)
#pragma unroll
            for (int m = 0; m < 4; ++m)
#pragma unroll
                for (int n = 0; n < 2; ++n) acc[a][b][m][n] = (f32x4){0.f, 0.f, 0.f, 0.f};
    f16x8 At[4][2], B0[2][2], B1[2][2];
    const char* gA = (const char*)p.A;
    unsigned offC[2][2], offN[2][2];
#pragma unroll
    for (int h = 0; h < 2; ++h)
#pragma unroll
        for (int i = 0; i < 2; ++i) offC[h][i] = p.arow(0, cur, 128 * h + Rr[i]) * (unsigned)(K * 2) + (unsigned)Cc[i] * 2u;
    const char* cB = p.bptr(cur);
    G_STAGEB(G_SB(0, 0), cB); G_STAGEA(G_SA(0, 0), offC, 0, 0); G_STAGEB(G_SB(0, 1), cB + hstep); G_STAGEA(G_SA(0, 1), offC, 1, 0);
    if (wr == 1) G_BAR;
    G_WAIT_V(4); G_BAR;
    G_STAGEB(G_SB(1, 0), cB + kstep); G_STAGEA(G_SA(1, 0), offC, 0, kstep); G_STAGEB(G_SB(1, 1), cB + hstep + kstep);
    G_WAIT_V(6); G_BAR;
    for (;;) {
        const bool has_next = unit_at(ui + 1, G, c, P::nM, P::nN, nxt);
        const char* nB = has_next ? p.bptr(nxt) : cB;
#pragma unroll
        for (int h = 0; h < 2; ++h)
#pragma unroll
            for (int i = 0; i < 2; ++i) offN[h][i] = has_next ? p.arow(ui + 1, nxt, 128 * h + Rr[i]) * (unsigned)(K * 2) + (unsigned)Cc[i] * 2u : offC[h][i];
        for (int t = 0; t < nt; t += 2) {
            const bool last = (t == nt - 2);
            const size_t k1 = (size_t)(t + 1) * kstep;
            const size_t k2 = last ? 0 : (size_t)(t + 2) * kstep, k3 = k2 + kstep;
            const char* b2 = last ? nB : cB + (size_t)(t + 2) * kstep; const char* b3 = b2 + kstep;
            unsigned o2[2][2];
#pragma unroll
            for (int h = 0; h < 2; ++h)
#pragma unroll
                for (int i = 0; i < 2; ++i) o2[h][i] = last ? offN[h][i] : offC[h][i];
            G_LDB(B0, 0, 0); G_SCHED; G_LDA(At, 0, 0); G_STAGEA(G_SA(1, 1), offC, 1, k1);
            G_WAIT_L(8); G_BAR; G_WAIT_L(0); G_MMA(0, 0, At, B0); G_BAR; G_SCHED;
            G_LDB(B1, 0, 1); G_STAGEB(G_SB(0, 0), b2);
            G_BAR; G_WAIT_L(0); G_MMA(0, 1, At, B1); G_BAR;
            G_LDA(At, 0, 1); G_STAGEA(G_SA(0, 0), o2, 0, k2);
            G_BAR; G_WAIT_L(0); G_MMA(1, 0, At, B0); G_BAR; G_SCHED;
            G_STAGEB(G_SB(0, 1), b2 + hstep);
            G_WAIT_V(6); G_BAR; G_MMA(1, 1, At, B1); G_BAR;
            G_LDB(B0, 1, 0); G_SCHED; G_LDA(At, 1, 0); G_STAGEA(G_SA(0, 1), o2, 1, k2);
            G_WAIT_L(8); G_BAR; G_WAIT_L(0); G_MMA(0, 0, At, B0); G_BAR; G_SCHED;
            G_LDB(B1, 1, 1); G_STAGEB(G_SB(1, 0), b3);
            G_BAR; G_WAIT_L(0); G_MMA(0, 1, At, B1); G_BAR;
            G_LDA(At, 1, 1); G_STAGEA(G_SA(1, 0), o2, 0, k3);
            G_BAR; G_WAIT_L(0); G_MMA(1, 0, At, B0); G_BAR; G_SCHED;
            G_STAGEB(G_SB(1, 1), b3 + hstep);
            G_WAIT_V(6); G_BAR; G_MMA(1, 1, At, B1); G_BAR;
        }
        p.epi(acc, cur, wr, wc, fr, fq);
        if (!has_next) break;
#pragma unroll
        for (int a = 0; a < 2; ++a)
#pragma unroll
            for (int b = 0; b < 2; ++b)
#pragma unroll
                for (int m = 0; m < 4; ++m)
#pragma unroll
                    for (int n = 0; n < 2; ++n) acc[a][b][m][n] = (f32x4){0.f, 0.f, 0.f, 0.f};
        cur = nxt; cB = nB; ++ui;
#pragma unroll
        for (int h = 0; h < 2; ++h)
#pragma unroll
            for (int i = 0; i < 2; ++i) offC[h][i] = offN[h][i];
    }
    G_WAIT_V(0);
    if (wr == 0) G_BAR;
    G_BAR;
#undef G_SA
#undef G_SB
#undef G_STAGEA
#undef G_STAGEB
#undef G_LDA
#undef G_LDB
#undef G_MMA
#undef G_WAIT_V
#undef G_WAIT_L
#undef G_BAR
#undef G_SCHED
}

struct ProbIn {
    static constexpr int nM = MTOT / 256, nN = NU / 256; static constexpr bool PERM = true;
    const f16* A; const f16* BT; f16* U;
    DI unsigned arow(int, const Unit& u, int r) const { return (unsigned)(u.pm * 256 + r); }
    DI const char* bptr(const Unit& u) const { return (const char*)(BT + (size_t)u.pn * 256 * KD); }
    DI void epi(const Acc& acc, const Unit& u, int wr, int wc, int fr, int fq) const {
        const int row0 = u.pm * BM + wr * 64 + fr, col0 = u.pn * BM + wc * 32 + 8 * fq;
#pragma unroll
        for (int ai = 0; ai < 2; ++ai)
#pragma unroll
            for (int m = 0; m < 4; ++m) { f16* rowp = U + (size_t)(row0 + ai * HALF + m * 16) * NU + col0;
#pragma unroll
                for (int bj = 0; bj < 2; ++bj) { const f32x4 v0 = acc[ai][bj][m][0], v1 = acc[ai][bj][m][1];
                    u32x4 w; w.x = pack2(v0[0], v0[1]); w.y = pack2(v0[2], v0[3]); w.z = pack2(v1[0], v1[1]); w.w = pack2(v1[2], v1[3]);
                    *(u32x4*)(rowp + bj * HALF) = w; } }
    }
};
struct ProbOut {
    static constexpr int nM = MLAT / 256, nN = DM / 256; static constexpr bool PERM = false;
    const f16* A; const f16* BT; float* R;
    DI unsigned arow(int, const Unit& u, int r) const { return (unsigned)(u.pm * 256 + r); }
    DI const char* bptr(const Unit& u) const { return (const char*)(BT + (size_t)u.pn * 256 * KD); }
    DI void epi(const Acc& acc, const Unit& u, int wr, int wc, int fr, int fq) const {
        const int row0 = u.pm * BM + wr * 64 + fr, col0 = u.pn * BM + wc * 32 + 4 * fq;
#pragma unroll
        for (int ai = 0; ai < 2; ++ai)
#pragma unroll
            for (int m = 0; m < 4; ++m) { float* rowp = R + (size_t)(row0 + ai * HALF + m * 16) * DM + col0;
#pragma unroll
                for (int bj = 0; bj < 2; ++bj)
#pragma unroll
                    for (int n = 0; n < 2; ++n) *(f32x4*)(rowp + bj * HALF + n * 16) = acc[ai][bj][m][n]; }
    }
};
struct ProbGU {
    static constexpr int nM = (NE * NB * CAP) / 256, nN = 2048 / 256; static constexpr bool PERM = true;
    const f16* A; const f16* BT; f16* ACT; const int* IDX; const LAS int* tab;
    DI unsigned arow(int ui, const Unit& u, int r) const { return (unsigned)tab[ui * 256 + r]; }
    DI const char* bptr(const Unit& u) const { return (const char*)(BT + ((size_t)(u.pm >> 4) * 2048 + (size_t)u.pn * 256) * KD); }
    DI void epi(const Acc& acc, const Unit& u, int wr, int wc, int fr, int fq) const {
        const int row0 = u.pm * BM + wr * 64 + fr, col0 = u.pn * 128 + wc * 32 + 8 * fq;
#pragma unroll
        for (int ai = 0; ai < 2; ++ai)
#pragma unroll
            for (int m = 0; m < 4; ++m) { f16* rowp = ACT + (size_t)(row0 + ai * HALF + m * 16) * FF + col0;
                const f32x4 g0 = acc[ai][0][m][0], g1 = acc[ai][0][m][1], u0 = acc[ai][1][m][0], u1 = acc[ai][1][m][1];
                u32x4 w; w.x = pack2(silu_f(g0[0]) * u0[0], silu_f(g0[1]) * u0[1]); w.y = pack2(silu_f(g0[2]) * u0[2], silu_f(g0[3]) * u0[3]);
                w.z = pack2(silu_f(g1[0]) * u1[0], silu_f(g1[1]) * u1[1]); w.w = pack2(silu_f(g1[2]) * u1[2], silu_f(g1[3]) * u1[3]);
                *(u32x4*)rowp = w; }
    }
};
struct ProbDown {
    static constexpr int nM = (NE * NB * CAP) / 256, nN = DM / 256; static constexpr bool PERM = true;
    const f16* A; const f16* BT; f16* YM; const float* GV;
    DI unsigned arow(int, const Unit& u, int r) const { return (unsigned)(u.pm * 256 + r); }
    DI const char* bptr(const Unit& u) const { return (const char*)(BT + ((size_t)(u.pm >> 4) * 1024 + (size_t)u.pn * 256) * KD); }
    DI void epi(const Acc& acc, const Unit& u, int wr, int wc, int fr, int fq) const {
        const int row0 = u.pm * BM + wr * 64 + fr, col0 = u.pn * BM + wc * 32 + 8 * fq;
#pragma unroll
        for (int ai = 0; ai < 2; ++ai)
#pragma unroll
            for (int m = 0; m < 4; ++m) { const int row = row0 + ai * HALF + m * 16; const float g = GV[row]; f16* rowp = YM + (size_t)row * DM + col0;
#pragma unroll
                for (int bj = 0; bj < 2; ++bj) { const f32x4 v0 = acc[ai][bj][m][0] * g, v1 = acc[ai][bj][m][1] * g;
                    u32x4 w; w.x = pack2(v0[0], v0[1]); w.y = pack2(v0[2], v0[3]); w.z = pack2(v1[0], v1[1]); w.w = pack2(v1[2], v1[3]);
                    *(u32x4*)(rowp + bj * HALF) = w; } }
    }
};
}

#define XB_TMO      128
#define XB_XCNT(j)  (256  + 64 * (j))
#define XB_XSUB(j)  (1280 + 64 * (j))
#define XB_XGEN(j)  (2304 + 64 * (j))
#define XB_TOP      3328
#define XB_TOPGEN   3392
#define XCD_BAR_WORDS 3456
#define XB_SPIN_CAP (1u << 22)
DI unsigned xb_ld(unsigned* p)              { return __hip_atomic_load(p, __ATOMIC_RELAXED, __HIP_MEMORY_SCOPE_AGENT); }
DI unsigned xb_add(unsigned* p, unsigned v) { return __hip_atomic_fetch_add(p, v, __ATOMIC_RELAXED, __HIP_MEMORY_SCOPE_AGENT); }
DI unsigned xb_xcc_id() { return (unsigned)__builtin_amdgcn_s_getreg((3 << 11) | 20) & 0xFu; }
#define XB_SPIN(cond, bar) do { unsigned _sp = 0; while (cond) { __builtin_amdgcn_s_sleep(1); \
    if ((++_sp & 255u) == 0u) { if (xb_ld(&(bar)[XB_TMO])) break; if (_sp > XB_SPIN_CAP) { atomicAdd(&(bar)[XB_TMO], 1u); break; } } } } while (0)
struct XcdBarrier { unsigned* bar; unsigned x; volatile LAS unsigned* st; };
DI XcdBarrier xcd_barrier_post(unsigned* bar, volatile LAS unsigned* st) {
    XcdBarrier b; b.bar = bar; b.x = xb_xcc_id(); b.st = st;
    if (threadIdx.x == 0) (void)xb_add(&bar[XB_XCNT(b.x)], 1u);
    return b;
}
DI void xcd_barrier_complete(unsigned* bar, unsigned x, unsigned& nloc, unsigned& nx) {
    const unsigned G = gridDim.x * gridDim.y * gridDim.z;
    unsigned sum, cnt, mine, sp = 0u;
    for (;;) {
        sum = 0u; cnt = 0u; mine = 0u;
#pragma unroll
        for (unsigned j = 0; j < 16; ++j) { const unsigned c = xb_ld(&bar[XB_XCNT(j)]); sum += c; cnt += (c > 0u) ? 1u : 0u; mine = (j == x) ? c : mine; }
        if (sum == G) break;
        __builtin_amdgcn_s_sleep(1);
        if ((++sp & 255u) == 0u) { if (xb_ld(&bar[XB_TMO])) break; if (sp > XB_SPIN_CAP) { atomicAdd(&bar[XB_TMO], 1u); break; } }
    }
    nloc = mine > 0u ? mine : 1u; nx = cnt > 0u ? cnt : 1u;
}
DI void xcd_barrier(const XcdBarrier& b) {
    asm volatile("s_waitcnt vmcnt(0)" ::: "memory");
    __syncthreads();
    if (threadIdx.x == 0) {
        unsigned* bar = b.bar;
        __builtin_amdgcn_s_waitcnt(0);
        unsigned nloc = b.st[0], nx = b.st[1];
        if (nloc == 0u) { xcd_barrier_complete(bar, b.x, nloc, nx); b.st[0] = nloc; b.st[1] = nx; }
        const unsigned old = xb_add(&bar[XB_XSUB(b.x)], 1u);
        const unsigned gen = old / nloc;
        if (old + 1u == (gen + 1u) * nloc) {
            __builtin_amdgcn_fence(__ATOMIC_RELEASE, "agent");
            asm volatile("s_waitcnt vmcnt(0)" ::: "memory");
            const unsigned og = xb_add(&bar[XB_TOP], 1u);
            const unsigned tg = og / nx;
            if (og + 1u == (tg + 1u) * nx) xb_add(&bar[XB_TOPGEN], 1u);
            else XB_SPIN(xb_ld(&bar[XB_TOPGEN]) == tg, bar);
            __builtin_amdgcn_fence(__ATOMIC_ACQUIRE, "agent");
            xb_add(&bar[XB_XGEN(b.x)], 1u);
            asm volatile("s_waitcnt vmcnt(0)" ::: "memory");
        } else {
            XB_SPIN(xb_ld(&bar[XB_XGEN(b.x)]) == gen, bar);
            __builtin_amdgcn_fence(__ATOMIC_ACQUIRE, "agent");
            asm volatile("s_waitcnt vmcnt(0)" ::: "memory");
        }
    }
    __syncthreads();
}

constexpr int LDS_TAB_OFF = 131072;
constexpr int LDS_MISC_OFF = 131072 + 8192;
constexpr int LDS_BYTES = 147456;
constexpr size_t WS_BAR = 0;
constexpr size_t WS_CTL_BYTES = 65536;
struct Args { const float* in[21]; float* out; unsigned char* ws; int hi; int pad; };
enum { PH_PREP = 0, PH_HROWS, PH_GEMM_IN, PH_MA, PH_MB, PH_MC, PH_GEMM_OUT, PH_POST, PH_TOPK, PH_GEMM_GU, PH_GEMM_DOWN, PH_COMBINE, PH_COUNT };

struct Ctx {
    LAS unsigned char* lds; int tid, lane, wave, G, c;
    const float *x, *cvec, *ctx, *c_ctx, *ada_w, *ada_b, *norm_w, *w_in, *conv_w, *conv_b, *dt_bias, *a_log, *ssd_d, *ssd_nw, *hgrn_lb, *hgrn_nw, *w_out, *w_router, *w_gate, *w_up, *w_down;
    float* out; unsigned char* ws;
    DI float* MOD() const { return (float*)(ws + WS_MOD); }   DI float* DT() const { return (float*)(ws + WS_DT); }   DI float* WDT() const { return (float*)(ws + WS_WDT); }
    DI float* AFF() const { return (float*)(ws + WS_AFF); }   DI float* GATEV() const { return (float*)(ws + WS_GATEV); }   DI float* R() const { return (float*)(ws + WS_R); }
    DI float* XLAT() const { return out; }   DI int* IDX() const { return (int*)(ws + WS_IDX); }   DI int* SLOT() const { return (int*)(ws + WS_SLOT); }
    DI f16* WIN() const { return (f16*)(ws + WS_WIN); }   DI f16* WOUT() const { return (f16*)(ws + WS_WOUT); }   DI f16* WGU() const { return (f16*)(ws + WS_WGU); }   DI f16* WD() const { return (f16*)(ws + WS_WD); }
    DI f16* H() const { return (f16*)(ws + WS_H); }   DI f16* H2() const { return (f16*)(ws + WS_H); }   DI f16* U() const { return (f16*)(ws + WS_U); }   DI f16* Y() const { return (f16*)(ws + WS_Y); }
    DI f16* ACT() const { return (f16*)(ws + WS_ACT); }   DI f16* YM() const { return (f16*)(ws + WS_YM); }
};

DI void tr_item(const float* src, int ld, int col0, int k0, f16* dst_row0, int ldd, LAS float* scr, int lane) {
#pragma unroll 8
    for (int i = 0; i < 32; ++i) { const int kk = 2 * i + (lane >> 5); scr[kk * 33 + (lane & 31)] = src[(size_t)(k0 + kk) * ld + col0 + (lane & 31)]; }
    asm volatile("s_waitcnt lgkmcnt(0)" ::: "memory");
    const int cc = lane & 7;
#pragma unroll
    for (int j = 0; j < 4; ++j) { const int n = (lane >> 3) + 8 * j; const LAS float* s = scr + (8 * cc) * 33 + n;
        u32x4 o; o.x = gm::pack2(s[0 * 33], s[1 * 33]); o.y = gm::pack2(s[2 * 33], s[3 * 33]); o.z = gm::pack2(s[4 * 33], s[5 * 33]); o.w = gm::pack2(s[6 * 33], s[7 * 33]);
        *(u32x4*)(dst_row0 + (size_t)n * ldd + k0 + 8 * cc) = o; }
    asm volatile("s_waitcnt lgkmcnt(0)" ::: "memory");
}
DI void phase_prep(const Ctx& F) {
    {
        LAS float* sv = (LAS float*)F.lds;
        LAS float* red = sv + 5 * DM;
        for (int i = F.tid; i < 5 * DM; i += 512) { const int r = i >> 10, k = i & 1023; sv[i] = silu_f(r < 4 ? F.cvec[r * DM + k] : F.c_ctx[k]); }
        __syncthreads();
        const int col = F.tid % 24, kg = F.tid / 24, j = F.c * 24 + col;
        if (kg < 21) {
            float a[5] = {0, 0, 0, 0, 0};
            for (int k = kg; k < DM; k += 21) { const float w = F.ada_w[(size_t)k * 6144 + j];
#pragma unroll
                for (int r = 0; r < 5; ++r) a[r] += sv[r * DM + k] * w; }
#pragma unroll
            for (int r = 0; r < 5; ++r) red[(kg * 24 + col) * 5 + r] = a[r];
        }
        __syncthreads();
        if (F.tid < 120) { const int cl = F.tid % 24, r = F.tid / 24; float s = 0.f; for (int g = 0; g < 21; ++g) s += red[(g * 24 + cl) * 5 + r]; const int jj = F.c * 24 + cl; F.MOD()[r * 6144 + jj] = s + F.ada_b[jj]; }
        __syncthreads();
    }
    for (int i = F.c * 512 + F.tid; i < 16 * DM; i += F.G * 512) { const int j = i >> 10, k = i & 1023; F.WDT()[i] = F.w_in[(size_t)k * INCOLS + 1536 + j]; }
    LAS float* scr = (LAS float*)(F.lds + F.wave * 8704);
    const int gw = F.c * 8 + F.wave, NGW = F.G * 8;
    constexpr int I_IN = 16 * 128, I_OUT = 16 * 32, I_GU = 16 * 16 * 64, I_D = 16 * 16 * 32;
    for (int it = gw; it < I_IN + I_OUT + I_GU + I_D; it += NGW) {
        int r = it;
        if (r < I_IN) { const int kb = r / 128, nb = r % 128, n0 = nb * 32; tr_item(F.w_in, INCOLS, n0 < 1536 ? n0 : n0 + 16, kb * 64, F.WIN() + (size_t)n0 * DM, DM, scr, F.lane); continue; } r -= I_IN;
        if (r < I_OUT) { const int kb = r / 32, nb = r % 32; tr_item(F.w_out, DM, nb * 32, kb * 64, F.WOUT() + (size_t)nb * 32 * DM, DM, scr, F.lane); continue; } r -= I_OUT;
        if (r < I_GU) { const int e = r / 1024, q = r % 1024, kb = q / 64, nb = q % 64, r0 = nb * 32, blk = r0 >> 7, within = r0 & 127, isu = blk & 1, f0 = (blk >> 1) * 128 + within;
            tr_item((isu ? F.w_up : F.w_gate) + (size_t)e * DM * FF, FF, f0, kb * 64, F.WGU() + ((size_t)e * 2048 + r0) * DM, DM, scr, F.lane); continue; } r -= I_GU;
        { const int e = r / 512, q = r % 512, kb = q / 32, nb = q % 32; tr_item(F.w_down + (size_t)e * FF * DM, DM, nb * 32, kb * 64, F.WD() + ((size_t)e * DM + nb * 32) * FF, FF, scr, F.lane); }
    }
}

DI void phase_hrows(const Ctx& F) {
    LAS float* wdt = (LAS float*)F.lds;
    for (int i = F.tid; i < 16 * DM / 4; i += 512) *(LAS f32x4*)(wdt + 4 * i) = *(const f32x4*)(F.WDT() + 4 * i);
    __syncthreads();
    const int gw = F.c * 8 + F.wave, NGW = F.G * 8, lane = F.lane;
    f32x4 nx[4];
    if (gw < MTOT) { const float* xr = gw < MLAT ? F.x + (size_t)gw * DM : F.ctx + (size_t)(gw - MLAT) * DM;
#pragma unroll
        for (int j = 0; j < 4; ++j) nx[j] = *(const f32x4*)(xr + 4 * lane + 256 * j); }
    for (int row = gw; row < MTOT; row += NGW) {
        const int r = row < MLAT ? row / SEQ : 4;
        const float* shift = F.MOD() + r * 6144, *scale = F.MOD() + r * 6144 + 1024;
        f32x4 v[4]; float ss = 0.f;
#pragma unroll
        for (int j = 0; j < 4; ++j) { v[j] = nx[j]; ss += v[j].x * v[j].x + v[j].y * v[j].y + v[j].z * v[j].z + v[j].w * v[j].w; }
        { const int nr = row + NGW; if (nr < MTOT) { const float* xr = nr < MLAT ? F.x + (size_t)nr * DM : F.ctx + (size_t)(nr - MLAT) * DM;
#pragma unroll
            for (int j = 0; j < 4; ++j) nx[j] = *(const f32x4*)(xr + 4 * lane + 256 * j); } }
        const float rstd = rsqrtf(wave_sum(ss) * (1.f / DM) + EPS);
#pragma unroll
        for (int j = 0; j < 4; ++j) {
            const int k = 4 * lane + 256 * j;
            const f32x4 nw = *(const f32x4*)(F.norm_w + k), sc = *(const f32x4*)(scale + k), sh = *(const f32x4*)(shift + k);
            v[j] = v[j] * rstd * nw * (1.f + sc) + sh;
            f16x4 o; o.x = (f16)v[j].x; o.y = (f16)v[j].y; o.z = (f16)v[j].z; o.w = (f16)v[j].w;
            *(f16x4*)(F.H() + (size_t)row * DM + k) = o;
        }
        float pd[16];
#pragma unroll
        for (int d = 0; d < 16; ++d) {
            float p = 0.f;
#pragma unroll
            for (int j = 0; j < 4; ++j) { const f32x4 w = *(const LAS f32x4*)(wdt + d * DM + 4 * lane + 256 * j); p += v[j].x * w.x + v[j].y * w.y + v[j].z * w.z + v[j].w * w.w; }
            pd[d] = p;
            if ((d & 3) == 3) __builtin_amdgcn_sched_barrier(0);
        }
        const float tot = reduce16(pd);
        if (lane < 16) F.DT()[(size_t)row * 16 + lane] = tot;
    }
    __syncthreads();
}

DI void phase_post(const Ctx& F) {
    LAS float* wr = (LAS float*)F.lds;
    for (int i = F.tid; i < DM * 16; i += 512) wr[(i & 15) * DM + (i >> 4)] = F.w_router[i];
    __syncthreads();
    const int lane = F.lane, gw = F.c * 8 + F.wave, NGW = F.G * 8;

    for (int row = gw; row < MLAT; row += NGW) {
        const int b = row / SEQ, t = row % SEQ;
        const float* mod = F.MOD() + b * 6144;
        int lo = 4 * lane; asm volatile("" : "+v"(lo));
        f32x4 r[4], xl[4]; float ss = 0.f;
#pragma unroll
        for (int j = 0; j < 4; ++j) { r[j] = *(const f32x4*)(F.R() + (size_t)row * DM + 4 * lane + 256 * j); xl[j] = *(const f32x4*)(F.x + (size_t)row * DM + 4 * lane + 256 * j); }
#pragma unroll
        for (int j = 0; j < 4; ++j) ss += r[j].x * r[j].x + r[j].y * r[j].y + r[j].z * r[j].z + r[j].w * r[j].w;
        const float rstd = rsqrtf(wave_sum(ss) * (1.f / DM) + EPS);
        float s2 = 0.f;
#pragma unroll
        for (int j = 0; j < 4; ++j) {
            const int k = lo + 256 * j;
            const f32x4 nw = *(const f32x4*)(F.norm_w + 1024 + k), gt = *(const f32x4*)(mod + 2048 + k);
            xl[j] = xl[j] + gt * (r[j] * rstd * nw);
            *(f32x4*)(F.XLAT() + (size_t)row * DM + k) = xl[j];
            s2 += xl[j].x * xl[j].x + xl[j].y * xl[j].y + xl[j].z * xl[j].z + xl[j].w * xl[j].w;
        }
        const float rstd2 = rsqrtf(wave_sum(s2) * (1.f / DM) + EPS);
        float lg[16];
#pragma unroll
        for (int e = 0; e < 16; ++e) lg[e] = 0.f;
#pragma unroll
        for (int j = 0; j < 4; ++j) {
            const int k = lo + 256 * j;
            const f32x4 nw = *(const f32x4*)(F.norm_w + 2048 + k), sh = *(const f32x4*)(mod + 3072 + k), sc = *(const f32x4*)(mod + 4096 + k);
            const f32x4 hv = xl[j] * rstd2 * nw * (1.f + sc) + sh;
            f16x4 o; o.x = (f16)hv.x; o.y = (f16)hv.y; o.z = (f16)hv.z; o.w = (f16)hv.w;
            *(f16x4*)(F.H2() + (size_t)row * DM + k) = o;
#pragma unroll
            for (int e = 0; e < 16; ++e) { const f32x4 w = *(const LAS f32x4*)(wr + e * DM + k); lg[e] += hv.x * w.x + hv.y * w.y + hv.z * w.z + hv.w * w.w; if ((e & 3) == 3) __builtin_amdgcn_sched_barrier(0); }
        }
        const float mylogit = reduce16(lg);
        float mx = mylogit;
#pragma unroll
        for (int o = 1; o < 16; o <<= 1) mx = fmaxf(mx, __shfl_xor(mx, o));
        const float ex = __expf(mylogit - mx);
        float den = ex;
#pragma unroll
        for (int o = 1; o < 16; o <<= 1) den += __shfl_xor(den, o);
        if (lane < 16) F.AFF()[((size_t)b * 16 + lane) * SEQ + t] = ex * __builtin_amdgcn_rcpf(den);
    }
    __syncthreads();
}

DI void phase_topk(const Ctx& F) {
    if (F.c >= 64) return;
    LAS unsigned* vals = (LAS unsigned*)F.lds;
    LAS unsigned* hist = vals + SEQ;
    LAS unsigned* sm = hist + 256;
    const int be = F.c, tid = F.tid;
    const float* a = F.AFF() + (size_t)be * SEQ;
    for (int i = tid; i < SEQ; i += 512) vals[i] = __float_as_uint(a[i]);
    if (tid == 0) { sm[0] = 0u; sm[1] = CAP; }
    __syncthreads();
    unsigned mask = 0u;
    for (int pass = 0; pass < 4; ++pass) {
        const int shift = 24 - 8 * pass;
        if (tid < 256) hist[tid] = 0u;
        __syncthreads();
        const unsigned prefix = sm[0];
        for (int i = tid; i < SEQ; i += 512) { const unsigned v = vals[i]; if ((v & mask) == prefix) atomicAdd((unsigned*)&hist[(v >> shift) & 255u], 1u); }
        __syncthreads();
        {
            const unsigned kcur = sm[1];
            unsigned hv = 0u, suf = 0u;
            if (tid < 256) { hv = hist[255 - tid]; suf = hv;
                for (int o = 1; o < 64; o <<= 1) { const unsigned tt = __shfl_up(suf, o); if ((tid & 63) >= o) suf += tt; }
                if ((tid & 63) == 63) sm[18 + (tid >> 6)] = suf; }
            __syncthreads();
            if (tid < 256) { for (int i = 0; i < (tid >> 6); ++i) suf += sm[18 + i];
                if (suf >= kcur && suf - hv < kcur) { sm[1] = kcur - (suf - hv); sm[0] = prefix | ((unsigned)(255 - tid) << shift); } }
        }
        mask |= 255u << shift;
        __syncthreads();
    }
    const unsigned T = sm[0], keq = sm[1];
    unsigned cg = 0, ce = 0;
    for (int j = 0; j < 16; ++j) { const unsigned v = vals[tid * 16 + j]; cg += v > T; ce += v == T; }
    const int lane = tid & 63, w = tid >> 6;
    unsigned ig = cg, ie = ce;
    for (int o = 1; o < 64; o <<= 1) { const unsigned tg = __shfl_up(ig, o), te = __shfl_up(ie, o); if (lane >= o) { ig += tg; ie += te; } }
    if (lane == 63) { sm[2 + w] = ig; sm[10 + w] = ie; }
    __syncthreads();
    unsigned og = 0, oe = 0;
    for (int i = 0; i < w; ++i) { og += sm[2 + i]; oe += sm[10 + i]; }
    unsigned pg = og + ig - cg, pe = oe + ie - ce;
    const int rowbase = ((be & 15) * 4 + (be >> 4)) * CAP;
    for (int j = 0; j < 16; ++j) {
        const int t = tid * 16 + j; const unsigned v = vals[t];
        int slot = -1;
        if (v > T) { slot = (int)(pg + (pe < keq ? pe : keq)); pg++; }
        else if (v == T) { if (pe < keq) slot = (int)(pg + pe); pe++; }
        F.SLOT()[(size_t)be * SEQ + t] = slot;
        if (slot >= 0) { F.IDX()[rowbase + slot] = t; F.GATEV()[rowbase + slot] = __uint_as_float(v); }
    }
    __syncthreads();
}

DI void phase_combine(const Ctx& F) {
    const int lane = F.lane, gw = F.c * 8 + F.wave, NGW = F.G * 8;
    for (int row = gw; row < MLAT; row += NGW) {
        const int b = row / SEQ, t = row % SEQ;
        const int myslot = F.SLOT()[((size_t)b * 16 + (lane & 15)) * SEQ + t];
        f32x4 xl[4];
#pragma unroll
        for (int j = 0; j < 4; ++j) xl[j] = *(const f32x4*)(F.XLAT() + (size_t)row * DM + 4 * lane + 256 * j);
        unsigned mask = (unsigned)(__ballot(myslot >= 0) & 0xffffull);
        f32x4 acc[4];
#pragma unroll
        for (int j = 0; j < 4; ++j) acc[j] = (f32x4){0, 0, 0, 0};
        while (mask) {
            const int e0 = __builtin_ctz(mask); mask &= mask - 1;
            const int s0 = __shfl(myslot, e0);
            const f16* y0 = F.YM() + (size_t)((e0 * 4 + b) * CAP + s0) * DM + 4 * lane;
            f16x4 v0[4], v1[4];
#pragma unroll
            for (int j = 0; j < 4; ++j) v0[j] = *(const f16x4*)(y0 + 256 * j);
            const bool two = mask != 0;
            if (two) {
                const int e1 = __builtin_ctz(mask); mask &= mask - 1;
                const int s1 = __shfl(myslot, e1);
                const f16* y1 = F.YM() + (size_t)((e1 * 4 + b) * CAP + s1) * DM + 4 * lane;
#pragma unroll
                for (int j = 0; j < 4; ++j) v1[j] = *(const f16x4*)(y1 + 256 * j);
            } else {
#pragma unroll
                for (int j = 0; j < 4; ++j) v1[j] = (f16x4){0, 0, 0, 0};
            }
#pragma unroll
            for (int j = 0; j < 4; ++j) { acc[j].x += (float)v0[j].x + (float)v1[j].x; acc[j].y += (float)v0[j].y + (float)v1[j].y; acc[j].z += (float)v0[j].z + (float)v1[j].z; acc[j].w += (float)v0[j].w + (float)v1[j].w; }
        }
        float ss = 0.f;
#pragma unroll
        for (int j = 0; j < 4; ++j) ss += acc[j].x * acc[j].x + acc[j].y * acc[j].y + acc[j].z * acc[j].z + acc[j].w * acc[j].w;
        const float rstd = rsqrtf(wave_sum(ss) * (1.f / DM) + EPS);
#pragma unroll
        for (int j = 0; j < 4; ++j) {
            const int k = 4 * lane + 256 * j;
            const f32x4 nw = *(const f32x4*)(F.norm_w + 3072 + k), gt = *(const f32x4*)(F.MOD() + b * 6144 + 5120 + k);
            *(f32x4*)(F.out + (size_t)row * DM + k) = xl[j] + gt * (acc[j] * rstd * nw);
        }
    }
}

#ifndef PROBE_PH
#define PROBE_PH -1
#endif

namespace mx {
DI int swz(int row, int chunk) { return row * 256 + ((chunk ^ (row & 15)) << 4); }
template <bool TR>
DI void conv_tile(const f16* U, int row0, int s0, int seglo, int seghi, int ucol, const float* cw, const float* cb, LAS unsigned char* T, int rbase, int chunk) {
    f16x8 raw[12];
#pragma unroll
    for (int i = 0; i < 12; ++i) { const int s = s0 - 2 + i; const bool ok = s >= seglo && s < seghi;
        if (ok) raw[i] = *(const f16x8*)(U + (size_t)(row0 + s) * NU + ucol); else raw[i] = (f16x8){0, 0, 0, 0, 0, 0, 0, 0}; }
    const int cc = ucol - UXBC;
    float w[5][8], bb[8];
#pragma unroll
    for (int j = 0; j < 8; ++j) bb[j] = cb[cc + j];
#pragma unroll
    for (int tp = 0; tp < 5; ++tp)
#pragma unroll
        for (int j = 0; j < 8; ++j) w[tp][j] = cw[tp * 1024 + cc + j];
    f16x8 vt[8];
#pragma unroll
    for (int t = 0; t < 8; ++t) { f16x8 v;
#pragma unroll
        for (int j = 0; j < 8; ++j) { float a = bb[j];
#pragma unroll
            for (int tp = 0; tp < 5; ++tp) a += w[tp][j] * (float)raw[t + tp][j];
            const f16 r = (f16)silu_f(a);
            if (TR) vt[j][t] = r; else v[j] = r; }
        if (!TR) *(LAS f16x8*)(T + swz(rbase + t, chunk)) = v; }
    if (TR) {
#pragma unroll
        for (int j = 0; j < 8; ++j) *(LAS f16x8*)(T + swz(rbase + j, chunk)) = vt[j]; }
}
DI void scan128(float a0, float a1, float& c0, float& c1, float& tot) {
    float p = a0 + a1;
#pragma unroll
    for (int o = 1; o < 64; o <<= 1) { const float t = __shfl_up(p, o); if ((int)(threadIdx.x & 63) >= o) p += t; }
    c1 = p; c0 = p - a1; tot = __shfl(p, 63);
}
constexpr size_t SSD_SLOT = 8192;
DI size_t ssd_sid(int b, int ck, int h, int dir) { return (size_t)(((b * 66 + ck) * 8 + h) * 2 + dir); }

DI void ssd_a_unit(const Ctx& F, f16* ST, float* TOTS, int b, int ck, int h) {
    const int g = h >> 2, tid = F.tid, lane = F.lane;
    const int row0 = ck < 2 ? MLAT + b * CTXL + 128 * ck : b * SEQ + 128 * (ck - 2);
    LAS unsigned char* XT = F.lds;
    LAS unsigned char* BT = F.lds + 64 * 256;
    LAS float* dtA = (LAS float*)(F.lds + 192 * 256);
    LAS float* laA = dtA + 256;
    LAS f16* w16 = (LAS f16*)(laA + 256);
    if (tid < 384) {
        const int tr = tid & 15, g8 = tid >> 4;
        const int s0 = 8 * tr;
        int seglo, seghi;
        if (ck < 2) { seglo = -128 * ck; seghi = seglo + 256; } else { seglo = s0 & ~63; seghi = seglo + 64; }
        const int ucol = g8 < 8 ? UXBC + h * 64 + 8 * g8 : UXBC + 512 + g * 128 + 8 * (g8 - 8);
        conv_tile<true>(F.U(), row0, s0, seglo, seghi, ucol, F.conv_w, F.conv_b, g8 < 8 ? XT : BT, g8 < 8 ? 8 * g8 : 8 * (g8 - 8), tr);
    } else {
        const int s = tid - 384;
#pragma unroll
        for (int dir = 0; dir < 2; ++dir) { const float d = softplus_f(F.DT()[(size_t)(row0 + s) * 16 + dir * 8 + h] + F.dt_bias[dir * 8 + h]);
            dtA[dir * 128 + s] = d; laA[dir * 128 + s] = -d * __expf(F.a_log[dir * 8 + h]); }
    }
    __syncthreads();
    if (F.wave < 2) {
        const int dir = F.wave; const float a0 = laA[dir * 128 + 2 * lane], a1 = laA[dir * 128 + 2 * lane + 1];
        float c0, c1, tot; scan128(a0, a1, c0, c1, tot);
        const float e0 = dir == 0 ? tot - c0 : c0 - a0, e1 = dir == 0 ? tot - c1 : c1 - a1;
        w16[dir * 128 + 2 * lane] = (f16)(dtA[dir * 128 + 2 * lane] * __expf(e0));
        w16[dir * 128 + 2 * lane + 1] = (f16)(dtA[dir * 128 + 2 * lane + 1] * __expf(e1));
        if (lane == 0) TOTS[ssd_sid(b, ck, h, dir)] = __expf(tot);
    }
    __syncthreads();
    {
        int t2 = tid; asm volatile("" : "+v"(t2));
        const int lane2 = t2 & 63, fr = lane2 & 15, fq = lane2 >> 4, wv = __builtin_amdgcn_readfirstlane(t2 >> 6);
        const int dir = wv & 1, ntp = wv >> 1;
        f32x4 acc[2][4];
#pragma unroll
        for (int i = 0; i < 2; ++i)
#pragma unroll
            for (int j = 0; j < 4; ++j) acc[i][j] = (f32x4){0, 0, 0, 0};
#pragma unroll
        for (int kk = 0; kk < 4; ++kk) {
            const f16x8 wv = *(const LAS f16x8*)(w16 + dir * 128 + 32 * kk + 8 * fq);
            f16x8 a[2], bf[4];
#pragma unroll
            for (int nt = 0; nt < 2; ++nt) a[nt] = *(const LAS f16x8*)(BT + swz(16 * (2 * ntp + nt) + fr, 4 * kk + fq)) * wv;
#pragma unroll
            for (int pt = 0; pt < 4; ++pt) bf[pt] = *(const LAS f16x8*)(XT + swz(16 * pt + fr, 4 * kk + fq));
#pragma unroll
            for (int nt = 0; nt < 2; ++nt)
#pragma unroll
                for (int pt = 0; pt < 4; ++pt) acc[nt][pt] = __builtin_amdgcn_mfma_f32_16x16x32_f16(a[nt], bf[pt], acc[nt][pt], 0, 0, 0);
        }
        f16* S = ST + ssd_sid(b, ck, h, dir) * SSD_SLOT;
#pragma unroll
        for (int nt = 0; nt < 2; ++nt)
#pragma unroll
            for (int pt = 0; pt < 4; ++pt) { f16x4 o; o.x = (f16)acc[nt][pt].x; o.y = (f16)acc[nt][pt].y; o.z = (f16)acc[nt][pt].z; o.w = (f16)acc[nt][pt].w;
                *(f16x4*)(S + (size_t)(16 * pt + fr) * 128 + 16 * (2 * ntp + nt) + 4 * fq) = o; }
    }
    __syncthreads();
}

DI void ssd_b(const Ctx& F, f16* ST, const float* TOTS) {
    const int idx = F.c * 512 + F.tid; if (idx >= 64 * 2048) return;
    const int e = idx & 2047, chain = idx >> 11, dir = chain & 1, h = (chain >> 1) & 7, b = chain >> 4;
    float run[4] = {0.f, 0.f, 0.f, 0.f};
    for (int s0 = 0; s0 < 66; s0 += 6) {
        f16x4 loc[6]; float d[6]; f16* p[6];
#pragma unroll
        for (int i = 0; i < 6; ++i) { const int st = s0 + i; const int ck = dir == 0 ? st : (st < 2 ? 1 - st : 67 - st);
            const size_t sid = ssd_sid(b, ck, h, dir); p[i] = ST + sid * SSD_SLOT + (size_t)e * 4; loc[i] = *(const f16x4*)p[i]; d[i] = TOTS[sid]; }
#pragma unroll
        for (int i = 0; i < 6; ++i) { f16x4 o; o.x = (f16)run[0]; o.y = (f16)run[1]; o.z = (f16)run[2]; o.w = (f16)run[3]; *(f16x4*)p[i] = o;
            run[0] = d[i] * run[0] + (float)loc[i].x; run[1] = d[i] * run[1] + (float)loc[i].y; run[2] = d[i] * run[2] + (float)loc[i].z; run[3] = d[i] * run[3] + (float)loc[i].w; }
    }
}

DI void ssd_c_unit(const Ctx& F, const f16* ST, int b, int c, int g) {
    const int tid = F.tid, lane = F.lane;
    const int row0 = b * SEQ + 128 * c;
    LAS unsigned char* CT = F.lds;
    LAS unsigned char* BM = F.lds + 128 * 256;
    LAS unsigned char* XT = F.lds + 256 * 256;
    LAS float* dtA = (LAS float*)(F.lds + 131072);
    LAS float* csA = dtA + 1024;
    {
        const int tr = tid & 15, g8 = tid >> 4, s0 = 8 * tr, seglo = s0 & ~63;
        conv_tile<true>(F.U(), row0, s0, seglo, seglo + 64, UXBC + g * 256 + 8 * g8, F.conv_w, F.conv_b, XT, 8 * g8, tr);
    }
    __builtin_amdgcn_sched_barrier(0);
    {
        const int g8 = tid & 31, tr = tid >> 5, s0 = 8 * tr, seglo = s0 & ~63;
        conv_tile<false>(F.U(), row0, s0, seglo, seglo + 64, UXBC + 512 + (g8 >> 4) * 256 + g * 128 + 8 * (g8 & 15), F.conv_w, F.conv_b, g8 < 16 ? BM : CT, s0, g8 & 15);
    }
    __builtin_amdgcn_sched_barrier(0);
#pragma unroll
    for (int q = 0; q < 2; ++q) { const int idx = tid + 512 * q, s = idx & 127, hd = idx >> 7, hh = hd >> 1, dir = hd & 1, h = g * 4 + hh;
        const float d = softplus_f(F.DT()[(size_t)(row0 + s) * 16 + dir * 8 + h] + F.dt_bias[dir * 8 + h]);
        dtA[hd * 128 + s] = d; csA[hd * 128 + s] = -d * __expf(F.a_log[dir * 8 + h]); }
    __syncthreads();
    {
        const int wv = F.wave;
        const float a0 = csA[wv * 128 + 2 * lane], a1 = csA[wv * 128 + 2 * lane + 1];
        float c0, c1, tot; scan128(a0, a1, c0, c1, tot);
        if (wv & 1) { c0 = tot - c0 + a0; c1 = tot - c1 + a1; }
        csA[wv * 128 + 2 * lane] = c0; csA[wv * 128 + 2 * lane + 1] = c1;
    }
    __syncthreads();
    int t2 = tid; asm volatile("" : "+v"(t2));
    const int lane2 = t2 & 63, fr = lane2 & 15, fq = lane2 >> 4, w = __builtin_amdgcn_readfirstlane(t2 >> 6);
    const int l0 = 16 * w + fr;
    f16x8 cfr[4];
#pragma unroll
    for (int kk = 0; kk < 4; ++kk) cfr[kk] = *(const LAS f16x8*)(CT + swz(l0, 4 * kk + fq));
    f32x4 gacc[8];
#pragma unroll
    for (int st = 0; st < 8; ++st) { gacc[st] = (f32x4){0, 0, 0, 0};
#pragma unroll
        for (int kk = 0; kk < 4; ++kk) gacc[st] = __builtin_amdgcn_mfma_f32_16x16x32_f16(*(const LAS f16x8*)(BM + swz(16 * st + fr, 4 * kk + fq)), cfr[kk], gacc[st], 0, 0, 0); }
    __syncthreads();
    const size_t urow = (size_t)(row0 + l0) * NU + UZ + g * 256;
    float ss = 0.f;
#pragma unroll 1
    for (int hh = 0; hh < 4; ++hh) {
        const int h = g * 4 + hh;
        int l = l0; asm volatile("" : "+v"(l));
        const LAS float* dtf = dtA + (2 * hh) * 128, *dtb = dtA + (2 * hh + 1) * 128, *csf = csA + (2 * hh) * 128, *rcb = csA + (2 * hh + 1) * 128;
        const float csf_l = csf[l], rcb_l = rcb[l], dsum_l = dtf[l] + dtb[l], dskip = F.ssd_d[h];
        f32x4 yacc[4];
#pragma unroll
        for (int pt = 0; pt < 4; ++pt) yacc[pt] = (f32x4){0, 0, 0, 0};
#pragma unroll
        for (int kk = 0; kk < 4; ++kk) {
            f16x8 m;
#pragma unroll
            for (int hf = 0; hf < 2; ++hf) { const int st = 2 * kk + hf, sb = 16 * st + 4 * fq;
                const f32x4 cf = *(const LAS f32x4*)(csf + sb), rb = *(const LAS f32x4*)(rcb + sb), df = *(const LAS f32x4*)(dtf + sb), db = *(const LAS f32x4*)(dtb + sb);
#pragma unroll
                for (int r = 0; r < 4; ++r) { const int s = sb + r;
                    const float arg = s < l ? csf_l - cf[r] : (s > l ? rcb_l - rb[r] : 0.f);
                    const float dsel = s < l ? df[r] : (s > l ? db[r] : dsum_l);
                    float val = gacc[st][r] * __expf(arg) * dsel; if (s == l) val += dskip;
                    m[hf * 4 + r] = (f16)val; } }
            __builtin_amdgcn_sched_barrier(0);
#pragma unroll
            for (int pt = 0; pt < 4; ++pt) { const int p = 64 * hh + 16 * pt + fr;
                const f16x4 x0 = *(const LAS f16x4*)(XT + swz(p, 4 * kk + (fq >> 1)) + 8 * (fq & 1));
                const f16x4 x1 = *(const LAS f16x4*)(XT + swz(p, 4 * kk + 2 + (fq >> 1)) + 8 * (fq & 1));
                f16x8 xf; xf[0] = x0[0]; xf[1] = x0[1]; xf[2] = x0[2]; xf[3] = x0[3]; xf[4] = x1[0]; xf[5] = x1[1]; xf[6] = x1[2]; xf[7] = x1[3];
                yacc[pt] = __builtin_amdgcn_mfma_f32_16x16x32_f16(xf, m, yacc[pt], 0, 0, 0); }
            __builtin_amdgcn_sched_barrier(0);
        }
#pragma unroll
        for (int dir = 0; dir < 2; ++dir) {
            const f16* S = ST + ssd_sid(b, c + 2, h, dir) * SSD_SLOT;
            f32x4 off[4];
#pragma unroll
            for (int pt = 0; pt < 4; ++pt) off[pt] = (f32x4){0, 0, 0, 0};
#pragma unroll
            for (int kk = 0; kk < 4; ++kk)
#pragma unroll
                for (int pt = 0; pt < 4; ++pt) off[pt] = __builtin_amdgcn_mfma_f32_16x16x32_f16(*(const f16x8*)(S + (size_t)(16 * pt + fr) * 128 + 32 * kk + 8 * fq), cfr[kk], off[pt], 0, 0, 0);
            const float e = __expf(dir == 0 ? csf_l : rcb_l);
#pragma unroll
            for (int pt = 0; pt < 4; ++pt) yacc[pt] += off[pt] * e;
        }
        LAS unsigned char* stg = (hh < 2 ? CT : BM) + w * 4096 + (hh & 1) * 2048;
#pragma unroll
        for (int pt = 0; pt < 4; ++pt) { const f16x4 z = *(const f16x4*)(F.U() + urow + 64 * hh + 16 * pt + 4 * fq); f16x4 o;
#pragma unroll
            for (int r = 0; r < 4; ++r) { const float v = yacc[pt][r] * silu_f((float)z[r]); ss += v * v; o[r] = (f16)v; }
            *(LAS f16x4*)(stg + fr * 128 + (16 * pt + 4 * fq) * 2) = o; }
    }
    ss += __shfl_xor(ss, 16); ss += __shfl_xor(ss, 32);
    const float rstd = rsqrtf(ss * (1.f / 256.f) + EPS);
    f16* yrow = F.Y() + (size_t)(row0 + l0) * DM + g * 256;
#pragma unroll
    for (int hh = 0; hh < 4; ++hh) {
        const LAS unsigned char* stg = (hh < 2 ? CT : BM) + w * 4096 + (hh & 1) * 2048;
#pragma unroll
        for (int pt = 0; pt < 4; ++pt) { const int ch = 64 * hh + 16 * pt + 4 * fq; const f32x4 nw = *(const f32x4*)(F.ssd_nw + g * 256 + ch);
            const f16x4 v = *(const LAS f16x4*)(stg + fr * 128 + (16 * pt + 4 * fq) * 2);
            f16x4 o; o.x = (f16)((float)v.x * rstd * nw.x); o.y = (f16)((float)v.y * rstd * nw.y); o.z = (f16)((float)v.z * rstd * nw.z); o.w = (f16)((float)v.w * rstd * nw.w);
            *(f16x4*)(yrow + ch) = o; }
    }
    __syncthreads();
}
}

namespace mx {
typedef short s16x8 __attribute__((ext_vector_type(8)));
DI int swz64(int row, int chunk) { return row * 128 + ((chunk ^ ((row >> 1) & 7)) << 4); }
DI unsigned short f2bf(float f) { unsigned u = __builtin_bit_cast(unsigned, f); return (unsigned short)((u + 0x7fffu + ((u >> 16) & 1u)) >> 16); }
constexpr size_t HG_SLOT = 16384;
DI size_t hg_sid(int b, int ck, int h, int dir) { return (size_t)(((b * 132 + ck) * 4 + h) * 2 + dir); }
DI f16* hg_slot(f16* HCT, f16* HLAT, int b, int ck, int h, int dir) {
    return ck < 4 ? HCT + (size_t)(((b * 4 + ck) * 4 + h) * 2 + dir) * HG_SLOT : HLAT + (size_t)(((b * 128 + (ck - 4)) * 4 + h) * 2 + dir) * HG_SLOT;
}
template <int NCH>
DI void load_raw(const Ctx& F, int row0, int ucol, LAS unsigned char* RAW) {
    constexpr int CPR = NCH / 8;
    for (int i = F.tid; i < 64 * CPR; i += 512) { const int t = i / CPR, cch = i % CPR;
        *(LAS f16x8*)(RAW + (t * NCH + cch * 8) * 2) = *(const f16x8*)(F.U() + (size_t)(row0 + t) * NU + ucol + cch * 8); }
}
DI void load_vt(const Ctx& F, int row0, int h, LAS unsigned char* VT) {
    const int i = F.tid & 31, g8 = F.tid >> 5;
    const f16x8 a = *(const f16x8*)(F.U() + (size_t)(row0 + 2 * i) * NU + UI + h * 128 + 8 * g8);
    const f16x8 b = *(const f16x8*)(F.U() + (size_t)(row0 + 2 * i + 1) * NU + UI + h * 128 + 8 * g8);
#pragma unroll
    for (int j = 0; j < 8; ++j) { typedef _Float16 h2 __attribute__((ext_vector_type(2))); h2 p; p.x = a[j]; p.y = b[j];
        *(LAS h2*)(VT + swz64(8 * g8 + j, i >> 2) + (i & 3) * 4) = p; }
}

template <int T0, int SGN>
DI float hg_gates(const LAS f16* rf, float lb, float (&f)[32]) {
    float prod = 1.f;
#pragma unroll
    for (int i = 0; i < 32; ++i) { const int t = T0 + SGN * i; f[i] = lb + (1.f - lb) * sigmoid_f((float)rf[t * 128]); prod *= f[i]; }
    return prod;
}
template <int T0, int SGN>
DI void hg_a_write(const float (&f)[32], float R, LAS unsigned char* T, int k) {
    f16 v[32];
#pragma unroll
    for (int i = 0; i < 32; ++i) { v[i] = (f16)((1.f - f[i]) * R); R *= f[i]; }
#pragma unroll
    for (int j = 0; j < 4; ++j) { f16x8 o;
#pragma unroll
        for (int q = 0; q < 8; ++q) { const int t = (T0 < 32 ? 0 : 32) + 8 * j + q; const int i = SGN > 0 ? t - T0 : T0 - t; o[q] = v[i]; }
        const int ch = ((T0 < 32 ? 0 : 32) >> 3) + j;
        *(LAS f16x8*)(T + k * 128 + ((ch ^ ((k >> 1) & 7)) << 4)) = o; }
}
template <int T0, int SGN>
DI void hg_c_write(const float (&f)[32], float P, const LAS f16* rq, LAS unsigned char* TQ, LAS unsigned char* TK, int k) {
    const int cb = (k & 7) * 2, cx = (k >> 3) << 4;
#pragma unroll
    for (int i = 0; i < 32; ++i) { const int t = T0 + SGN * i; P *= f[i];
        const float qv = silu_f((float)rq[t * 128]);
        const int off = t * 256 + (cx ^ ((t & 15) << 4)) + cb;
        *(LAS unsigned short*)(TQ + off) = f2bf(qv * P);
        *(LAS unsigned short*)(TK + off) = f2bf((1.f - f[i]) * __builtin_amdgcn_rcpf(P)); }
}

DI void hg_a_unit(const Ctx& F, f16* HCT, f16* HLAT, float* DEC, int b, int ck, int h) {
    const int tid = F.tid;
    const int row0 = ck < 4 ? MLAT + b * CTXL + 64 * ck : b * SEQ + 64 * (ck - 4);
    LAS unsigned char* RAW = F.lds;
    LAS unsigned char* KD = F.lds + 32768;
    LAS unsigned char* VT = F.lds + 65536;
    load_raw<128>(F, row0, UFF + h * 128, RAW);
    load_raw<128>(F, row0, UFB + h * 128, RAW + 64 * 256);
    load_vt(F, row0, h, VT);
    LAS float* PX = (LAS float*)(F.lds + 81920);
    __syncthreads();
    {
        const int k = tid & 127, dir = (tid >> 7) & 1, half = tid >> 8, ch = h * 128 + k;
        const float l0 = F.hgrn_lb[dir * 512 + ch], l1 = F.hgrn_lb[1024 + dir * 512 + ch];
        const float lb = __builtin_amdgcn_rcpf(1.f + __expf(l1 - l0));
        const LAS f16* rw = (const LAS f16*)(RAW + dir * 64 * 256) + k;
        float f[32]; float prod;
        if (dir == 0) prod = half == 0 ? hg_gates<31, -1>(rw, lb, f) : hg_gates<63, -1>(rw, lb, f);
        else          prod = half == 0 ? hg_gates<0, 1>(rw, lb, f) : hg_gates<32, 1>(rw, lb, f);
        PX[(dir * 2 + half) * 128 + k] = prod;
        __syncthreads();
        const float other = PX[(dir * 2 + (half ^ 1)) * 128 + k];
        LAS unsigned char* T = KD + dir * 16384;
        if (dir == 0) { if (half == 0) hg_a_write<31, -1>(f, other, T, k); else hg_a_write<63, -1>(f, 1.f, T, k); }
        else          { if (half == 0) hg_a_write<0, 1>(f, 1.f, T, k); else hg_a_write<32, 1>(f, other, T, k); }
        if (half == 0) DEC[hg_sid(b, ck, h, dir) * 128 + k] = prod * other;
    }
    __syncthreads();
    {
        int t2 = tid; asm volatile("" : "+v"(t2));
        const int lane2 = t2 & 63, fr = lane2 & 15, fq = lane2 >> 4, w = __builtin_amdgcn_readfirstlane(t2 >> 6);
        const int dir = w & 1, q = w >> 1;
        const LAS unsigned char* T = KD + dir * 16384;
        f32x4 acc[2][8];
#pragma unroll
        for (int i = 0; i < 2; ++i)
#pragma unroll
            for (int j = 0; j < 8; ++j) acc[i][j] = (f32x4){0, 0, 0, 0};
#pragma unroll
        for (int kk = 0; kk < 2; ++kk) {
            f16x8 a[2];
#pragma unroll
            for (int i = 0; i < 2; ++i) a[i] = *(const LAS f16x8*)(T + swz64(16 * (2 * q + i) + fr, 4 * kk + fq));
#pragma unroll
            for (int vt = 0; vt < 8; ++vt) { const f16x8 bv = *(const LAS f16x8*)(VT + swz64(16 * vt + fr, 4 * kk + fq));
#pragma unroll
                for (int i = 0; i < 2; ++i) acc[i][vt] = __builtin_amdgcn_mfma_f32_16x16x32_f16(a[i], bv, acc[i][vt], 0, 0, 0); }
        }
        f16* S = hg_slot(HCT, HLAT, b, ck, h, dir);
#pragma unroll
        for (int i = 0; i < 2; ++i)
#pragma unroll
            for (int vt = 0; vt < 8; ++vt) { f16x4 o; o.x = (f16)acc[i][vt].x; o.y = (f16)acc[i][vt].y; o.z = (f16)acc[i][vt].z; o.w = (f16)acc[i][vt].w;
                *(f16x4*)(S + (size_t)(16 * vt + fr) * 128 + 16 * (2 * q + i) + 4 * fq) = o; }
    }
    __syncthreads();
}

DI void hg_b(const Ctx& F, f16* HCT, f16* HLAT, const float* DEC) {
    const int idx = F.c * 512 + F.tid; if (idx >= 32 * 4096) return;
    const int e = idx & 4095, chain = idx >> 12, dir = chain & 1, h = (chain >> 1) & 3, b = chain >> 3;
    const int k0 = (e & 31) * 4;
    float run[4] = {0.f, 0.f, 0.f, 0.f};
    for (int s0 = 0; s0 < 132; s0 += 6) {
        f16x4 loc[6]; f32x4 d[6]; f16* p[6];
#pragma unroll
        for (int i = 0; i < 6; ++i) { const int st = s0 + i; const int ck = dir == 0 ? st : (st < 4 ? 3 - st : 135 - st);
            p[i] = hg_slot(HCT, HLAT, b, ck, h, dir) + (size_t)e * 4; loc[i] = *(const f16x4*)p[i]; d[i] = *(const f32x4*)(DEC + hg_sid(b, ck, h, dir) * 128 + k0); }
#pragma unroll
        for (int i = 0; i < 6; ++i) { f16x4 o; o.x = (f16)run[0]; o.y = (f16)run[1]; o.z = (f16)run[2]; o.w = (f16)run[3]; *(f16x4*)p[i] = o;
            run[0] = d[i].x * run[0] + (float)loc[i].x; run[1] = d[i].y * run[1] + (float)loc[i].y; run[2] = d[i].z * run[2] + (float)loc[i].z; run[3] = d[i].w * run[3] + (float)loc[i].w; }
    }
}

DI void hg_c_unit(const Ctx& F, f16* HCT, f16* HLAT, int b, int c, int h) {
    const int tid = F.tid;
    const int row0 = b * SEQ + 64 * c;
    LAS unsigned char* RAW = F.lds;
    LAS unsigned char* QD = F.lds + 49152;
    LAS unsigned char* KI = F.lds + 81920;
    LAS unsigned char* VT = F.lds + 114688;
    LAS float* red = (LAS float*)(F.lds + 131072);
    load_raw<128>(F, row0, UQ + h * 128, RAW);
    load_raw<128>(F, row0, UFF + h * 128, RAW + 16384);
    load_raw<128>(F, row0, UFB + h * 128, RAW + 32768);
    load_vt(F, row0, h, VT);
    LAS float* PX = red + 128;
    __syncthreads();
    {
        const int k = tid & 127, dir = (tid >> 7) & 1, half = tid >> 8, ch = h * 128 + k;
        const float l0 = F.hgrn_lb[dir * 512 + ch], l1 = F.hgrn_lb[1024 + dir * 512 + ch];
        const float lb = __builtin_amdgcn_rcpf(1.f + __expf(l1 - l0));
        const LAS f16* rf = (const LAS f16*)(RAW + 16384 + dir * 16384) + k;
        const LAS f16* rq = (const LAS f16*)RAW + k;
        float f[32]; float prod;
        if (dir == 0) prod = half == 0 ? hg_gates<0, 1>(rf, lb, f) : hg_gates<32, 1>(rf, lb, f);
        else          prod = half == 0 ? hg_gates<31, -1>(rf, lb, f) : hg_gates<63, -1>(rf, lb, f);
        PX[(dir * 2 + half) * 128 + k] = prod;
        __syncthreads();
        const float other = PX[(dir * 2 + (half ^ 1)) * 128 + k];
        LAS unsigned char* TQ = QD + dir * 16384; LAS unsigned char* TK = KI + dir * 16384;
        if (dir == 0) { if (half == 0) hg_c_write<0, 1>(f, 1.f, rq, TQ, TK, k); else hg_c_write<32, 1>(f, other, rq, TQ, TK, k); }
        else          { if (half == 0) hg_c_write<31, -1>(f, other, rq, TQ, TK, k); else hg_c_write<63, -1>(f, 1.f, rq, TQ, TK, k); }
    }
    __syncthreads();
    int t2 = tid; asm volatile("" : "+v"(t2));
    const int lane2 = t2 & 63, fr = lane2 & 15, fq = lane2 >> 4, w = __builtin_amdgcn_readfirstlane(t2 >> 6);
    const int lt = w & 3, vh = w >> 2, l = 16 * lt + fr;
    f32x4 oacc[4];
#pragma unroll
    for (int vt = 0; vt < 4; ++vt) oacc[vt] = (f32x4){0, 0, 0, 0};
#pragma unroll
    for (int dir = 0; dir < 2; ++dir) {
        const LAS unsigned char* TQ = QD + dir * 16384; const LAS unsigned char* TK = KI + dir * 16384;
        s16x8 qfr[4];
#pragma unroll
        for (int kk = 0; kk < 4; ++kk) qfr[kk] = *(const LAS s16x8*)(TQ + swz(l, 4 * kk + fq));
        f32x4 att[4];
#pragma unroll
        for (int st = 0; st < 4; ++st) { att[st] = (f32x4){0, 0, 0, 0};
#pragma unroll
            for (int kk = 0; kk < 4; ++kk) att[st] = __builtin_amdgcn_mfma_f32_16x16x32_bf16(*(const LAS s16x8*)(TK + swz(16 * st + fr, 4 * kk + fq)), qfr[kk], att[st], 0, 0, 0); }
#pragma unroll
        for (int k2 = 0; k2 < 2; ++k2) {
            f16x8 m;
#pragma unroll
            for (int hf = 0; hf < 2; ++hf)
#pragma unroll
                for (int r = 0; r < 4; ++r) { const int s = 16 * (2 * k2 + hf) + 4 * fq + r; const bool keep = dir == 0 ? s <= l : s >= l; m[hf * 4 + r] = keep ? (f16)att[2 * k2 + hf][r] : (f16)0.f; }
#pragma unroll
            for (int vt = 0; vt < 4; ++vt) { const int v = 64 * vh + 16 * vt + fr;
                const f16x4 x0 = *(const LAS f16x4*)(VT + swz64(v, 4 * k2 + (fq >> 1)) + 8 * (fq & 1));
                const f16x4 x1 = *(const LAS f16x4*)(VT + swz64(v, 4 * k2 + 2 + (fq >> 1)) + 8 * (fq & 1));
                f16x8 xf; xf[0] = x0[0]; xf[1] = x0[1]; xf[2] = x0[2]; xf[3] = x0[3]; xf[4] = x1[0]; xf[5] = x1[1]; xf[6] = x1[2]; xf[7] = x1[3];
                oacc[vt] = __builtin_amdgcn_mfma_f32_16x16x32_f16(xf, m, oacc[vt], 0, 0, 0); }
        }
        const f16* S = hg_slot(HCT, HLAT, b, c + 4, h, dir);
#pragma unroll
        for (int kk = 0; kk < 4; ++kk) { f16x8 q16;
#pragma unroll
            for (int j = 0; j < 8; ++j) q16[j] = (f16)__builtin_bit_cast(float, ((unsigned)(unsigned short)qfr[kk][j]) << 16);
#pragma unroll
            for (int vt = 0; vt < 4; ++vt) oacc[vt] = __builtin_amdgcn_mfma_f32_16x16x32_f16(*(const f16x8*)(S + (size_t)(64 * vh + 16 * vt + fr) * 128 + 32 * kk + 8 * fq), q16, oacc[vt], 0, 0, 0); }
    }
    float ss = 0.f;
#pragma unroll
    for (int vt = 0; vt < 4; ++vt) ss += oacc[vt].x * oacc[vt].x + oacc[vt].y * oacc[vt].y + oacc[vt].z * oacc[vt].z + oacc[vt].w * oacc[vt].w;
    ss += __shfl_xor(ss, 16); ss += __shfl_xor(ss, 32);
    if (fq == 0) red[vh * 64 + l] = ss;
    __syncthreads();
    const float rstd = rsqrtf((red[l] + red[64 + l]) * (1.f / 128.f) + EPS);
    const size_t urow = (size_t)(row0 + l) * NU + UG + h * 128;
    f16* yrow = F.Y() + (size_t)(row0 + l) * DM + 512 + h * 128;
#pragma unroll
    for (int vt = 0; vt < 4; ++vt) { const int v = 64 * vh + 16 * vt + 4 * fq;
        const f16x4 gz = *(const f16x4*)(F.U() + urow + v); const f32x4 nw = *(const f32x4*)(F.hgrn_nw + h * 128 + v);
        f16x4 o; o.x = (f16)(oacc[vt].x * rstd * nw.x * silu_f((float)gz.x)); o.y = (f16)(oacc[vt].y * rstd * nw.y * silu_f((float)gz.y));
        o.z = (f16)(oacc[vt].z * rstd * nw.z * silu_f((float)gz.z)); o.w = (f16)(oacc[vt].w * rstd * nw.w * silu_f((float)gz.w));
        *(f16x4*)(yrow + v) = o; }
    __syncthreads();
}
}

__global__ void __launch_bounds__(512, 2) mk_fwd(Args args) {
    extern __shared__ __attribute__((aligned(16))) unsigned char lds_raw[];
    Ctx F;
    F.lds = (LAS unsigned char*)lds_raw;
    F.tid = threadIdx.x; F.lane = F.tid & 63; F.wave = __builtin_amdgcn_readfirstlane(F.tid >> 6); F.G = gridDim.x; F.c = blockIdx.x;
    unsigned char* ws = args.ws;
    F.x = args.in[0]; F.cvec = args.in[1]; F.ctx = args.in[2]; F.c_ctx = args.in[3]; F.ada_w = args.in[4]; F.ada_b = args.in[5]; F.norm_w = args.in[6]; F.w_in = args.in[7];
    F.conv_w = args.in[8]; F.conv_b = args.in[9]; F.dt_bias = args.in[10]; F.a_log = args.in[11]; F.ssd_d = args.in[12]; F.ssd_nw = args.in[13]; F.hgrn_lb = args.in[14]; F.hgrn_nw = args.in[15];
    F.w_out = args.in[16]; F.w_router = args.in[17]; F.w_gate = args.in[18]; F.w_up = args.in[19]; F.w_down = args.in[20];
    F.out = args.out;
    F.ws = ws;
    volatile LAS unsigned* misc = (volatile LAS unsigned*)(F.lds + LDS_MISC_OFF);
    if (F.tid < 16) misc[F.tid] = 0u;
    __syncthreads();
    XcdBarrier bar = xcd_barrier_post((unsigned*)(ws + WS_BAR), misc + 8);
    f16* SST = (f16*)(ws + WS_H); float* TOTS = (float*)(ws + WS_Y); float* DEC = (float*)(ws + WS_Y + 65536);
    f16* HCT = (f16*)(ws + WS_AFF); f16* HLAT = (f16*)F.out;
    const int hi = args.hi;
#define REFRESH() do { int _t = threadIdx.x; asm volatile("" : "+v"(_t)); F.tid = _t; F.lane = _t & 63; F.wave = __builtin_amdgcn_readfirstlane(_t >> 6); } while (0)
#define PHASE(k, last, ...) do { if ((k) < hi) { REFRESH(); __VA_ARGS__; if (!(last) && (k) + 1 < hi) xcd_barrier(bar); } } while (0)
    PHASE(PH_PREP, false, phase_prep(F));
    PHASE(PH_HROWS, false, phase_hrows(F));
    PHASE(PH_GEMM_IN, false, { gm::ProbIn p{F.H(), F.WIN(), F.U()}; gm::gemm_phase(F.lds, p, F.G, F.c, F.tid); });
    PHASE(PH_MA, false, {
        for (int u = F.c; u < 2112; u += F.G) mx::ssd_a_unit(F, SST, TOTS, u / (66 * 8), (u / 8) % 66, u & 7);
        for (int v = (F.c + 64) % F.G; v < 2112; v += F.G) mx::hg_a_unit(F, HCT, HLAT, DEC, v / (132 * 4), (v / 4) % 132, v & 3); });
    PHASE(PH_MB, false, { mx::ssd_b(F, SST, TOTS); mx::hg_b(F, HCT, HLAT, DEC); });
    PHASE(PH_MC, false, {
        for (int u = F.c; u < 512; u += F.G) mx::ssd_c_unit(F, SST, u >> 7, (u >> 1) & 63, u & 1);
        for (int u = F.c; u < 2048; u += F.G) mx::hg_c_unit(F, HCT, HLAT, u >> 9, (u >> 2) & 127, u & 3); });
    PHASE(PH_GEMM_OUT, false, { gm::ProbOut p{F.Y(), F.WOUT(), F.R()}; gm::gemm_phase(F.lds, p, F.G, F.c, F.tid); });
    PHASE(PH_POST, false, phase_post(F));
    PHASE(PH_TOPK, false, phase_topk(F));
    PHASE(PH_GEMM_GU, false, {
        LAS int* tab = (LAS int*)(F.lds + LDS_TAB_OFF);
        for (int i = 0; i < 8; ++i) { gm::Unit u; if (!gm::unit_at(i, F.G, F.c, gm::ProbGU::nM, gm::ProbGU::nN, u)) break;
            if (F.tid < 256) { const int b = (u.pm >> 2) & 3; tab[i * 256 + F.tid] = b * SEQ + F.IDX()[u.pm * 256 + F.tid]; } }
        __syncthreads();
        gm::ProbGU p{F.H2(), F.WGU(), F.ACT(), F.IDX(), tab}; gm::gemm_phase(F.lds, p, F.G, F.c, F.tid); });
    PHASE(PH_GEMM_DOWN, false, { gm::ProbDown p{F.ACT(), F.WD(), F.YM(), F.GATEV()}; gm::gemm_phase(F.lds, p, F.G, F.c, F.tid); });
    PHASE(PH_COMBINE, true, phase_combine(F));
#undef PHASE
}

extern "C" void kernel_launch(void* const* d_in, const int* in_sizes, int n_in, void* d_out, int out_size, void* d_ws, size_t ws_size, hipStream_t stream) {
    if (ws_size < WS_END || n_in < 21) { fprintf(stderr, "kernel_launch: bad workspace/inputs: ws %zu n_in %d\n", ws_size, n_in); return; }
    static bool attr_set = false;
    if (!attr_set) { (void)hipFuncSetAttribute((const void*)mk_fwd, hipFuncAttributeMaxDynamicSharedMemorySize, LDS_BYTES); attr_set = true; }
    Args a{}; for (int i = 0; i < 21; ++i) a.in[i] = (const float*)d_in[i]; a.out = (float*)d_out; a.ws = (unsigned char*)d_ws;
#if PROBE_PH >= 0
    (void)hipMemsetAsync((char*)d_ws + WS_BAR, 0, WS_CTL_BYTES, stream);
    a.hi = PROBE_PH; hipLaunchKernelGGL(mk_fwd, dim3(256), dim3(512), LDS_BYTES, stream, a);
#endif
    (void)hipMemsetAsync((char*)d_ws + WS_BAR, 0, WS_CTL_BYTES, stream);
    a.hi = PH_COUNT; hipLaunchKernelGGL(mk_fwd, dim3(256), dim3(512), LDS_BYTES, stream, a);
}
```

```cpp
#include <hip/hip_runtime.h>
#include <cstdio>
#include <cstdint>

#define DI __device__ __forceinline__
typedef _Float16 f16;
typedef _Float16 f16x8 __attribute__((ext_vector_type(8)));
typedef _Float16 f16x4 __attribute__((ext_vector_type(4)));
typedef float f32x4 __attribute__((ext_vector_type(4)));

constexpr int DM = 1024, NB = 4, SEQ = 8192, CTXL = 256;
constexpr int MLAT = NB * SEQ;
constexpr int MCTX = NB * CTXL;
constexpr int MTOT = MLAT + MCTX;
constexpr int INCOLS = 4112, NU = 4096;
constexpr int UZ = 0, UXBC = 512, UQ = 1536, UFF = 2048, UFB = 2560, UI = 3072, UG = 3584;
constexpr int NE = 16, FF = 1024, CAP = 1024;
constexpr float EPS = 1e-6f;

constexpr size_t MiB = 1u << 20;
constexpr size_t WS_MOD = 1 * MiB;
constexpr size_t WS_DT = 2 * MiB;
constexpr size_t WS_WDT = 5 * MiB;
constexpr size_t WS_AFF = 6 * MiB;
constexpr size_t WS_IDX = 8 * MiB;
constexpr size_t WS_GATEV = 8 * MiB + 256 * 1024;
constexpr size_t WS_SLOT = 9 * MiB;
constexpr size_t WS_WIN = 12 * MiB;
constexpr size_t WS_WOUT = 20 * MiB;
constexpr size_t WS_WGU = 22 * MiB;
constexpr size_t WS_WD = 86 * MiB;
constexpr size_t WS_H = 118 * MiB;
constexpr size_t WS_U = 184 * MiB;
constexpr size_t WS_Y = 448 * MiB;
constexpr size_t WS_END = 512 * MiB;
constexpr size_t WS_ACT = WS_U;
constexpr size_t WS_YM = WS_U + 128 * MiB;
constexpr size_t WS_R = WS_U;

DI float silu_f(float x) { return x * __builtin_amdgcn_rcpf(1.f + __expf(-x)); }
DI float sigmoid_f(float x) { return __builtin_amdgcn_rcpf(1.f + __expf(-x)); }
DI float softplus_f(float x) { return x > 20.f ? x : log1pf(__expf(x)); }
DI float wave_sum(float v) {
#pragma unroll
    for (int o = 1; o < 64; o <<= 1) v += __shfl_xor(v, o);
    return v;
}


DI float reduce16(const float (&v)[16]) {
    const int lane = threadIdx.x & 63;
    float w8[8], w4[4], w2[2];
    const bool b0 = lane & 1, b1 = lane & 2, b2 = lane & 4, b3 = lane & 8;
#pragma unroll
    for (int i = 0; i < 8; ++i) { const float keep = b0 ? v[2 * i + 1] : v[2 * i], send = b0 ? v[2 * i] : v[2 * i + 1]; w8[i] = keep + __shfl_xor(send, 1); }
#pragma unroll
    for (int i = 0; i < 4; ++i) { const float keep = b1 ? w8[2 * i + 1] : w8[2 * i], send = b1 ? w8[2 * i] : w8[2 * i + 1]; w4[i] = keep + __shfl_xor(send, 2); }
#pragma unroll
    for (int i = 0; i < 2; ++i) { const float keep = b2 ? w4[2 * i + 1] : w4[2 * i], send = b2 ? w4[2 * i] : w4[2 * i + 1]; w2[i] = keep + __shfl_xor(send, 4); }
    float r = (b3 ? w2[1] : w2[0]) + __shfl_xor(b3 ? w2[0] : w2[1], 8);
    r += __shfl_xor(r, 16); r += __shfl_xor(r, 32);
    return r;
}
#define LAS __attribute__((address_space(3)))
typedef unsigned u32x4 __attribute__((ext_vector_type(4)));
namespace gm {
constexpr int BM = 256, BK = 64, HALF = 128, HTB = HALF * BK * 2, STAGE_BYTES = 8 * HTB, NXCD = 8, WGM = 8, KD = 1024, NT = KD / BK;
DI int lds_byte(int r, int c) { const int st = (r >> 4) * 2 + (c >> 5), rr = r & 15, cc = c & 31, ob = rr * 64 + cc * 2; return st * 1024 + (ob ^ (((ob >> 9) & 1) << 5)); }
DI void stage_rc(int b, int& R, int& C) { const int st = b / 1024, sb = b % 1024, swz = sb ^ (((sb >> 9) & 1) << 5); R = (st >> 1) * 16 + swz / 64; C = (st & 1) * 32 + (swz % 64) / 2; }
DI int perm32(int rho) { const int n = rho >> 4, i = rho & 15; return 8 * (i >> 2) + 4 * n + (i & 3); }
struct Unit { int pm, pn; };
DI bool unit_at(int i, int G, int c, int nM, int nN, Unit& u) {
    const int nwg = nM * nN; const long L = (long)i * G + c; if (L >= nwg) return false;
    int wgid = (int)L; { const int q = nwg / NXCD, r = nwg % NXCD, xcd = wgid % NXCD, off = wgid / NXCD; wgid = (xcd < r ? xcd * (q + 1) : r * (q + 1) + (xcd - r) * q) + off; }
    const int nig = WGM * nN, gid = wgid / nig, fm = gid * WGM, gsz = (nM - fm) < WGM ? (nM - fm) : WGM;
    u.pm = fm + ((wgid % nig) % gsz); u.pn = (wgid % nig) / gsz; return true;
}
typedef f32x4 Acc[2][2][4][2];
DI unsigned pack2(float a, float b) { typedef _Float16 h2 __attribute__((ext_vector_type(2))); h2 v; v.x = (f16)a; v.y = (f16)b; return __builtin_bit_cast(unsigned, v); }

template <class P>
DI void gemm_phase(LAS unsigned char* lds, const P& p, int G, int c, int tid) {
    const int wid = __builtin_amdgcn_readfirstlane(tid >> 6), lane = tid & 63, wr = wid >> 2, wc = wid & 3, fr = lane & 15, fq = lane >> 4;
    constexpr int K = KD, nt = NT;
    int Rr[2], Cc[2]; unsigned voffB[2];
#pragma unroll
    for (int i = 0; i < 2; ++i) { stage_rc(tid * 16 + i * 8192, Rr[i], Cc[i]); const int Rb = P::PERM ? ((Rr[i] & ~31) + perm32(Rr[i] & 31)) : Rr[i]; voffB[i] = (unsigned)(Rb * K + Cc[i]) * 2u; }
    const size_t kstep = (size_t)(BK * 2);
    const size_t hstep = (size_t)HALF * K * 2;
    const unsigned ldsw = (unsigned)wid * 1024u;
    const int aoff = lds_byte(wr * 64 + fr, fq * 8), boff = lds_byte(wc * 32 + fr, fq * 8);
#define G_SA(b, h) (((b) * 2 + (h)) * HTB)
#define G_SB(b, h) ((4 + (b) * 2 + (h)) * HTB)
#define G_STAGEB(bufoff, gbase) do { _Pragma("unroll") for (int _i = 0; _i < 2; ++_i) \
        __builtin_amdgcn_global_load_lds((const unsigned*)((const char*)(gbase) + voffB[_i]), (LAS unsigned*)(lds + (bufoff) + ldsw + _i * 8192), 16, 0, 0); } while (0)
#define G_STAGEA(bufoff, offs, h, koff) do { _Pragma("unroll") for (int _i = 0; _i < 2; ++_i) \
        __builtin_amdgcn_global_load_lds((const unsigned*)(gA + (offs)[h][_i] + (koff)), (LAS unsigned*)(lds + (bufoff) + ldsw + _i * 8192), 16, 0, 0); } while (0)
#define G_LDA(dst, b, h) do { _Pragma("unroll") for (int m = 0; m < 4; ++m) _Pragma("unroll") for (int k = 0; k < 2; ++k) dst[m][k] = *(const LAS f16x8*)(lds + G_SA(b, h) + aoff + m * 2048 + k * 1024); } while (0)
#define G_LDB(dst, b, h) do { _Pragma("unroll") for (int n = 0; n < 2; ++n) _Pragma("unroll") for (int k = 0; k < 2; ++k) dst[n][k] = *(const LAS f16x8*)(lds + G_SB(b, h) + boff + n * 2048 + k * 1024); } while (0)
#define G_MMA(ai, bj, At, Bt) do { __builtin_amdgcn_s_setprio(1); _Pragma("unroll") for (int m = 0; m < 4; ++m) _Pragma("unroll") for (int n = 0; n < 2; ++n) _Pragma("unroll") for (int k = 0; k < 2; ++k) \
        acc[ai][bj][m][n] = __builtin_amdgcn_mfma_f32_16x16x32_f16(Bt[n][k], At[m][k], acc[ai][bj][m][n], 0, 0, 0); __builtin_amdgcn_s_setprio(0); } while (0)
#define G_WAIT_V(n) asm volatile("s_waitcnt vmcnt(" #n ")" ::: "memory")
#define G_WAIT_L(n) asm volatile("s_waitcnt lgkmcnt(" #n ")" ::: "memory")
#define G_BAR __builtin_amdgcn_s_barrier()
#define G_SCHED __builtin_amdgcn_sched_barrier(0)
    Unit cur, nxt; int ui = 0;
    if (!unit_at(0, G, c, P::nM, P::nN, cur)) return;
    Acc acc;
#pragma unroll
    for (int a = 0; a < 2; ++a)
#pragma unroll
        for (int b = 0; b < 2; ++b)
#pragma unroll
            for (int m = 0; m < 4; ++m)
#pragma unroll
                for (int n = 0; n < 2; ++n) acc[a][b][m][n] = (f32x4){0.f, 0.f, 0.f, 0.f};
    f16x8 At[4][2], B0[2][2], B1[2][2];
    const char* gA = (const char*)p.A;
    unsigned offC[2][2], offN[2][2];
#pragma unroll
    for (int h = 0; h < 2; ++h)
#pragma unroll
        for (int i = 0; i < 2; ++i) offC[h][i] = p.arow(0, cur, 128 * h + Rr[i]) * (unsigned)(K * 2) + (unsigned)Cc[i] * 2u;
    const char* cB = p.bptr(cur);
    G_STAGEB(G_SB(0, 0), cB); G_STAGEA(G_SA(0, 0), offC, 0, 0); G_STAGEB(G_SB(0, 1), cB + hstep); G_STAGEA(G_SA(0, 1), offC, 1, 0);
    if (wr == 1) G_BAR;
    G_WAIT_V(4); G_BAR;
    G_STAGEB(G_SB(1, 0), cB + kstep); G_STAGEA(G_SA(1, 0), offC, 0, kstep); G_STAGEB(G_SB(1, 1), cB + hstep + kstep);
    G_WAIT_V(6); G_BAR;
    for (;;) {
        const bool has_next = unit_at(ui + 1, G, c, P::nM, P::nN, nxt);
        const char* nB = has_next ? p.bptr(nxt) : cB;
#pragma unroll
        for (int h = 0; h < 2; ++h)
#pragma unroll
            for (int i = 0; i < 2; ++i) offN[h][i] = has_next ? p.arow(ui + 1, nxt, 128 * h + Rr[i]) * (unsigned)(K * 2) + (unsigned)Cc[i] * 2u : offC[h][i];
        for (int t = 0; t < nt; t += 2) {
            const bool last = (t == nt - 2);
            const size_t k1 = (size_t)(t + 1) * kstep;
            const size_t k2 = last ? 0 : (size_t)(t + 2) * kstep, k3 = k2 + kstep;
            const char* b2 = last ? nB : cB + (size_t)(t + 2) * kstep; const char* b3 = b2 + kstep;
            unsigned o2[2][2];
#pragma unroll
            for (int h = 0; h < 2; ++h)
#pragma unroll
                for (int i = 0; i < 2; ++i) o2[h][i] = last ? offN[h][i] : offC[h][i];
            G_LDB(B0, 0, 0); G_SCHED; G_LDA(At, 0, 0); G_STAGEA(G_SA(1, 1), offC, 1, k1);
            G_WAIT_L(8); G_BAR; G_WAIT_L(0); G_MMA(0, 0, At, B0); G_BAR; G_SCHED;
            G_LDB(B1, 0, 1); G_STAGEB(G_SB(0, 0), b2);
            G_BAR; G_WAIT_L(0); G_MMA(0, 1, At, B1); G_BAR;
            G_LDA(At, 0, 1); G_STAGEA(G_SA(0, 0), o2, 0, k2);
            G_BAR; G_WAIT_L(0); G_MMA(1, 0, At, B0); G_BAR; G_SCHED;
            G_STAGEB(G_SB(0, 1), b2 + hstep);
            G_WAIT_V(6); G_BAR; G_MMA(1, 1, At, B1); G_BAR;
            G_LDB(B0, 1, 0); G_SCHED; G_LDA(At, 1, 0); G_STAGEA(G_SA(0, 1), o2, 1, k2);
            G_WAIT_L(8); G_BAR; G_WAIT_L(0); G_MMA(0, 0, At, B0); G_BAR; G_SCHED;
            G_LDB(B1, 1, 1); G_STAGEB(G_SB(1, 0), b3);
            G_BAR; G_WAIT_L(0); G_MMA(0, 1, At, B1); G_BAR;
            G_LDA(At, 1, 1); G_STAGEA(G_SA(1, 0), o2, 0, k3);
            G_BAR; G_WAIT_L(0); G_MMA(1, 0, At, B0); G_BAR; G_SCHED;
            G_STAGEB(G_SB(1, 1), b3 + hstep);
            G_WAIT_V(6); G_BAR; G_MMA(1, 1, At, B1); G_BAR;
        }
        p.epi(acc, cur, wr, wc, fr, fq);
        if (!has_next) break;
#pragma unroll
        for (int a = 0; a < 2; ++a)
#pragma unroll
            for (int b = 0; b < 2; ++b)
#pragma unroll
                for (int m = 0; m < 4; ++m)
#pragma unroll
                    for (int n = 0; n < 2; ++n) acc[a][b][m][n] = (f32x4){0.f, 0.f, 0.f, 0.f};
        cur = nxt; cB = nB; ++ui;
#pragma unroll
        for (int h = 0; h < 2; ++h)
#pragma unroll
            for (int i = 0; i < 2; ++i) offC[h][i] = offN[h][i];
    }
    G_WAIT_V(0);
    if (wr == 0) G_BAR;
    G_BAR;
#undef G_SA
#undef G_SB
#undef G_STAGEA
#undef G_STAGEB
#undef G_LDA
#undef G_LDB
#undef G_MMA
#undef G_WAIT_V
#undef G_WAIT_L
#undef G_BAR
#undef G_SCHED
}

struct ProbIn {
    static constexpr int nM = MTOT / 256, nN = NU / 256; static constexpr bool PERM = true;
    const f16* A; const f16* BT; f16* U;
    DI unsigned arow(int, const Unit& u, int r) const { return (unsigned)(u.pm * 256 + r); }
    DI const char* bptr(const Unit& u) const { return (const char*)(BT + (size_t)u.pn * 256 * KD); }
    DI void epi(const Acc& acc, const Unit& u, int wr, int wc, int fr, int fq) const {
        const int row0 = u.pm * BM + wr * 64 + fr, col0 = u.pn * BM + wc * 32 + 8 * fq;
#pragma unroll
        for (int ai = 0; ai < 2; ++ai)
#pragma unroll
            for (int m = 0; m < 4; ++m) { f16* rowp = U + (size_t)(row0 + ai * HALF + m * 16) * NU + col0;
#pragma unroll
                for (int bj = 0; bj < 2; ++bj) { const f32x4 v0 = acc[ai][bj][m][0], v1 = acc[ai][bj][m][1];
                    u32x4 w; w.x = pack2(v0[0], v0[1]); w.y = pack2(v0[2], v0[3]); w.z = pack2(v1[0], v1[1]); w.w = pack2(v1[2], v1[3]);
                    *(u32x4*)(rowp + bj * HALF) = w; } }
    }
};
struct ProbOut {
    static constexpr int nM = MLAT / 256, nN = DM / 256; static constexpr bool PERM = true;
    const f16* A; const f16* BT; f16* R;
    DI unsigned arow(int, const Unit& u, int r) const { return (unsigned)(u.pm * 256 + r); }
    DI const char* bptr(const Unit& u) const { return (const char*)(BT + (size_t)u.pn * 256 * KD); }
    DI void epi(const Acc& acc, const Unit& u, int wr, int wc, int fr, int fq) const {
        const int row0 = u.pm * BM + wr * 64 + fr, col0 = u.pn * BM + wc * 32 + 8 * fq;
#pragma unroll
        for (int ai = 0; ai < 2; ++ai)
#pragma unroll
            for (int m = 0; m < 4; ++m) { f16* rowp = R + (size_t)(row0 + ai * HALF + m * 16) * DM + col0;
#pragma unroll
                for (int bj = 0; bj < 2; ++bj) { const f32x4 v0 = acc[ai][bj][m][0], v1 = acc[ai][bj][m][1];
                    u32x4 w; w.x = pack2(v0[0], v0[1]); w.y = pack2(v0[2], v0[3]); w.z = pack2(v1[0], v1[1]); w.w = pack2(v1[2], v1[3]);
                    *(u32x4*)(rowp + bj * HALF) = w; } }
    }
};
struct ProbGU {
    static constexpr int nM = (NE * NB * CAP) / 256, nN = 2048 / 256; static constexpr bool PERM = true;
    const f16* A; const f16* BT; f16* ACT; const int* IDX; const LAS int* tab;
    DI unsigned arow(int ui, const Unit& u, int r) const { return (unsigned)tab[ui * 256 + r]; }
    DI const char* bptr(const Unit& u) const { return (const char*)(BT + ((size_t)(u.pm >> 4) * 2048 + (size_t)u.pn * 256) * KD); }
    DI void epi(const Acc& acc, const Unit& u, int wr, int wc, int fr, int fq) const {
        const int row0 = u.pm * BM + wr * 64 + fr, col0 = u.pn * 128 + wc * 32 + 8 * fq;
#pragma unroll
        for (int ai = 0; ai < 2; ++ai)
#pragma unroll
            for (int m = 0; m < 4; ++m) { f16* rowp = ACT + (size_t)(row0 + ai * HALF + m * 16) * FF + col0;
                const f32x4 g0 = acc[ai][0][m][0], g1 = acc[ai][0][m][1], u0 = acc[ai][1][m][0], u1 = acc[ai][1][m][1];
                u32x4 w; w.x = pack2(silu_f(g0[0]) * u0[0], silu_f(g0[1]) * u0[1]); w.y = pack2(silu_f(g0[2]) * u0[2], silu_f(g0[3]) * u0[3]);
                w.z = pack2(silu_f(g1[0]) * u1[0], silu_f(g1[1]) * u1[1]); w.w = pack2(silu_f(g1[2]) * u1[2], silu_f(g1[3]) * u1[3]);
                *(u32x4*)rowp = w; }
    }
};
struct ProbDown {
    static constexpr int nM = (NE * NB * CAP) / 256, nN = DM / 256; static constexpr bool PERM = true;
    const f16* A; const f16* BT; f16* YM; const float* GV;
    DI unsigned arow(int, const Unit& u, int r) const { return (unsigned)(u.pm * 256 + r); }
    DI const char* bptr(const Unit& u) const { return (const char*)(BT + ((size_t)(u.pm >> 4) * 1024 + (size_t)u.pn * 256) * KD); }
    DI void epi(const Acc& acc, const Unit& u, int wr, int wc, int fr, int fq) const {
        const int row0 = u.pm * BM + wr * 64 + fr, col0 = u.pn * BM + wc * 32 + 8 * fq;
#pragma unroll
        for (int ai = 0; ai < 2; ++ai)
#pragma unroll
            for (int m = 0; m < 4; ++m) { const int row = row0 + ai * HALF + m * 16; const float g = GV[row]; f16* rowp = YM + (size_t)row * DM + col0;
#pragma unroll
                for (int bj = 0; bj < 2; ++bj) { const f32x4 v0 = acc[ai][bj][m][0] * g, v1 = acc[ai][bj][m][1] * g;
                    u32x4 w; w.x = pack2(v0[0], v0[1]); w.y = pack2(v0[2], v0[3]); w.z = pack2(v1[0], v1[1]); w.w = pack2(v1[2], v1[3]);
                    *(u32x4*)(rowp + bj * HALF) = w; } }
    }
};
}

#define XB_TMO      128
#define XB_XCNT(j)  (256  + 64 * (j))
#define XB_XSUB(j)  (1280 + 64 * (j))
#define XB_XGEN(j)  (2304 + 64 * (j))
#define XB_TOP      3328
#define XB_TOPGEN   3392
#define XCD_BAR_WORDS 3456
#define XB_SPIN_CAP (1u << 22)
DI unsigned xb_ld(unsigned* p)              { return __hip_atomic_load(p, __ATOMIC_RELAXED, __HIP_MEMORY_SCOPE_AGENT); }
DI unsigned xb_add(unsigned* p, unsigned v) { return __hip_atomic_fetch_add(p, v, __ATOMIC_RELAXED, __HIP_MEMORY_SCOPE_AGENT); }
DI unsigned xb_xcc_id() { return (unsigned)__builtin_amdgcn_s_getreg((3 << 11) | 20) & 0xFu; }
#define XB_SPIN(cond, bar) do { unsigned _sp = 0; while (cond) { __builtin_amdgcn_s_sleep(1); \
    if ((++_sp & 255u) == 0u) { if (xb_ld(&(bar)[XB_TMO])) break; if (_sp > XB_SPIN_CAP) { atomicAdd(&(bar)[XB_TMO], 1u); break; } } } } while (0)
struct XcdBarrier { unsigned* bar; unsigned x; volatile LAS unsigned* st; };
DI XcdBarrier xcd_barrier_post(unsigned* bar, volatile LAS unsigned* st) {
    XcdBarrier b; b.bar = bar; b.x = xb_xcc_id(); b.st = st;
    if (threadIdx.x == 0) (void)xb_add(&bar[XB_XCNT(b.x)], 1u);
    return b;
}
DI void xcd_barrier_complete(unsigned* bar, unsigned x, unsigned& nloc, unsigned& nx) {
    const unsigned G = gridDim.x * gridDim.y * gridDim.z;
    unsigned sum, cnt, mine, sp = 0u;
    for (;;) {
        sum = 0u; cnt = 0u; mine = 0u;
#pragma unroll
        for (unsigned j = 0; j < 16; ++j) { const unsigned c = xb_ld(&bar[XB_XCNT(j)]); sum += c; cnt += (c > 0u) ? 1u : 0u; mine = (j == x) ? c : mine; }
        if (sum == G) break;
        __builtin_amdgcn_s_sleep(1);
        if ((++sp & 255u) == 0u) { if (xb_ld(&bar[XB_TMO])) break; if (sp > XB_SPIN_CAP) { atomicAdd(&bar[XB_TMO], 1u); break; } }
    }
    nloc = mine > 0u ? mine : 1u; nx = cnt > 0u ? cnt : 1u;
}
DI void xcd_barrier(const XcdBarrier& b) {
    asm volatile("s_waitcnt vmcnt(0)" ::: "memory");
    __syncthreads();
    if (threadIdx.x == 0) {
        unsigned* bar = b.bar;
        __builtin_amdgcn_s_waitcnt(0);
        unsigned nloc = b.st[0], nx = b.st[1];
        if (nloc == 0u) { xcd_barrier_complete(bar, b.x, nloc, nx); b.st[0] = nloc; b.st[1] = nx; }
        const unsigned old = xb_add(&bar[XB_XSUB(b.x)], 1u);
        const unsigned gen = old / nloc;
        if (old + 1u == (gen + 1u) * nloc) {
            __builtin_amdgcn_fence(__ATOMIC_RELEASE, "agent");
            asm volatile("s_waitcnt vmcnt(0)" ::: "memory");
            const unsigned og = xb_add(&bar[XB_TOP], 1u);
            const unsigned tg = og / nx;
            if (og + 1u == (tg + 1u) * nx) xb_add(&bar[XB_TOPGEN], 1u);
            else XB_SPIN(xb_ld(&bar[XB_TOPGEN]) == tg, bar);
            __builtin_amdgcn_fence(__ATOMIC_ACQUIRE, "agent");
            xb_add(&bar[XB_XGEN(b.x)], 1u);
            asm volatile("s_waitcnt vmcnt(0)" ::: "memory");
        } else {
            XB_SPIN(xb_ld(&bar[XB_XGEN(b.x)]) == gen, bar);
            __builtin_amdgcn_fence(__ATOMIC_ACQUIRE, "agent");
            asm volatile("s_waitcnt vmcnt(0)" ::: "memory");
        }
    }
    __syncthreads();
}

constexpr int LDS_TAB_OFF = 131072;
constexpr int LDS_MISC_OFF = 163840 - 256;
constexpr int LDS_BYTES = 163840;
constexpr size_t WS_BAR = 0;
constexpr size_t WS_CTL_BYTES = 65536;
struct Args { const float* in[21]; float* out; unsigned char* ws; int hi; int pad; };
enum { PH_PREP = 0, PH_HROWS, PH_GEMM_IN, PH_CONV, PH_MA, PH_MB, PH_MC, PH_GEMM_OUT, PH_POST, PH_TOPK, PH_GEMM_GU, PH_GEMM_DOWN, PH_COMBINE, PH_COUNT };

struct Ctx {
    LAS unsigned char* lds; int tid, lane, wave, G, c;
    const float *x, *cvec, *ctx, *c_ctx, *ada_w, *ada_b, *norm_w, *w_in, *conv_w, *conv_b, *dt_bias, *a_log, *ssd_d, *ssd_nw, *hgrn_lb, *hgrn_nw, *w_out, *w_router, *w_gate, *w_up, *w_down;
    float* out; unsigned char* ws;
    DI float* MOD() const { return (float*)(ws + WS_MOD); }   DI float* DT() const { return (float*)(ws + WS_DT); }   DI float* WDT() const { return (float*)(ws + WS_WDT); }
    DI float* AFF() const { return (float*)(ws + WS_AFF); }   DI float* GATEV() const { return (float*)(ws + WS_GATEV); }   DI f16* R() const { return (f16*)(ws + WS_R); }
    DI float* XLAT() const { return out; }   DI int* IDX() const { return (int*)(ws + WS_IDX); }   DI int* SLOT() const { return (int*)(ws + WS_SLOT); }
    DI f16* WIN() const { return (f16*)(ws + WS_WIN); }   DI f16* WOUT() const { return (f16*)(ws + WS_WOUT); }   DI f16* WGU() const { return (f16*)(ws + WS_WGU); }   DI f16* WD() const { return (f16*)(ws + WS_WD); }
    DI f16* H() const { return (f16*)(ws + WS_H); }   DI f16* H2() const { return (f16*)(ws + WS_H); }   DI f16* U() const { return (f16*)(ws + WS_U); }   DI f16* Y() const { return (f16*)(ws + WS_Y); }
    DI f16* ACT() const { return (f16*)(ws + WS_ACT); }   DI f16* YM() const { return (f16*)(ws + WS_YM); }
};

DI void tr_item(const float* src, int ld, int col0, int k0, f16* dst_row0, int ldd, LAS float* scr, int lane) {
#pragma unroll 8
    for (int i = 0; i < 32; ++i) { const int kk = 2 * i + (lane >> 5); scr[kk * 33 + (lane & 31)] = src[(size_t)(k0 + kk) * ld + col0 + (lane & 31)]; }
    asm volatile("s_waitcnt lgkmcnt(0)" ::: "memory");
    const int cc = lane & 7;
#pragma unroll
    for (int j = 0; j < 4; ++j) { const int n = (lane >> 3) + 8 * j; const LAS float* s = scr + (8 * cc) * 33 + n;
        u32x4 o; o.x = gm::pack2(s[0 * 33], s[1 * 33]); o.y = gm::pack2(s[2 * 33], s[3 * 33]); o.z = gm::pack2(s[4 * 33], s[5 * 33]); o.w = gm::pack2(s[6 * 33], s[7 * 33]);
        *(u32x4*)(dst_row0 + (size_t)n * ldd + k0 + 8 * cc) = o; }
    asm volatile("s_waitcnt lgkmcnt(0)" ::: "memory");
}
DI void phase_prep(const Ctx& F) {
    {
        LAS float* sv = (LAS float*)F.lds;
        LAS float* red = sv + 5 * DM;
        for (int i = F.tid; i < 5 * DM; i += 512) { const int r = i >> 10, k = i & 1023; sv[i] = silu_f(r < 4 ? F.cvec[r * DM + k] : F.c_ctx[k]); }
        __syncthreads();
        const int col = F.tid % 24, kg = F.tid / 24, j = F.c * 24 + col;
        if (kg < 21) {
            float a[5] = {0, 0, 0, 0, 0};
            for (int k = kg; k < DM; k += 21) { const float w = F.ada_w[(size_t)k * 6144 + j];
#pragma unroll
                for (int r = 0; r < 5; ++r) a[r] += sv[r * DM + k] * w; }
#pragma unroll
            for (int r = 0; r < 5; ++r) red[(kg * 24 + col) * 5 + r] = a[r];
        }
        __syncthreads();
        if (F.tid < 120) { const int cl = F.tid % 24, r = F.tid / 24; float s = 0.f; for (int g = 0; g < 21; ++g) s += red[(g * 24 + cl) * 5 + r]; const int jj = F.c * 24 + cl; F.MOD()[r * 6144 + jj] = s + F.ada_b[jj]; }
        __syncthreads();
    }
    for (int i = F.c * 512 + F.tid; i < 16 * DM; i += F.G * 512) { const int j = i >> 10, k = i & 1023; F.WDT()[i] = F.w_in[(size_t)k * INCOLS + 1536 + j]; }
    LAS float* scr = (LAS float*)(F.lds + F.wave * 8704);
    const int gw = F.c * 8 + F.wave, NGW = F.G * 8;
    constexpr int I_IN = 16 * 128, I_OUT = 16 * 32, I_GU = 16 * 16 * 64, I_D = 16 * 16 * 32;
    for (int it = gw; it < I_IN + I_OUT + I_GU + I_D; it += NGW) {
        int r = it;
        if (r < I_IN) { const int kb = r / 128, nb = r % 128, n0 = nb * 32; tr_item(F.w_in, INCOLS, n0 < 1536 ? n0 : n0 + 16, kb * 64, F.WIN() + (size_t)n0 * DM, DM, scr, F.lane); continue; } r -= I_IN;
        if (r < I_OUT) { const int kb = r / 32, nb = r % 32; tr_item(F.w_out, DM, nb * 32, kb * 64, F.WOUT() + (size_t)nb * 32 * DM, DM, scr, F.lane); continue; } r -= I_OUT;
        if (r < I_GU) { const int e = r / 1024, q = r % 1024, kb = q / 64, nb = q % 64, r0 = nb * 32, blk = r0 >> 7, within = r0 & 127, isu = blk & 1, f0 = (blk >> 1) * 128 + within;
            tr_item((isu ? F.w_up : F.w_gate) + (size_t)e * DM * FF, FF, f0, kb * 64, F.WGU() + ((size_t)e * 2048 + r0) * DM, DM, scr, F.lane); continue; } r -= I_GU;
        { const int e = r / 512, q = r % 512, kb = q / 32, nb = q % 32; tr_item(F.w_down + (size_t)e * FF * DM, DM, nb * 32, kb * 64, F.WD() + ((size_t)e * DM + nb * 32) * FF, FF, scr, F.lane); }
    }
}

DI void phase_hrows(const Ctx& F) {
    LAS float* wdt = (LAS float*)F.lds;
    for (int i = F.tid; i < 16 * DM / 4; i += 512) *(LAS f32x4*)(wdt + 4 * i) = *(const f32x4*)(F.WDT() + 4 * i);
    __syncthreads();
    const int gw = F.c * 8 + F.wave, NGW = F.G * 8, lane = F.lane;
    f32x4 nx[4];
    if (gw < MTOT) { const float* xr = gw < MLAT ? F.x + (size_t)gw * DM : F.ctx + (size_t)(gw - MLAT) * DM;
#pragma unroll
        for (int j = 0; j < 4; ++j) nx[j] = *(const f32x4*)(xr + 4 * lane + 256 * j); }
    for (int row = gw; row < MTOT; row += NGW) {
        const int r = row < MLAT ? row / SEQ : 4;
        const float* shift = F.MOD() + r * 6144, *scale = F.MOD() + r * 6144 + 1024;
        f32x4 v[4]; float ss = 0.f;
#pragma unroll
        for (int j = 0; j < 4; ++j) { v[j] = nx[j]; ss += v[j].x * v[j].x + v[j].y * v[j].y + v[j].z * v[j].z + v[j].w * v[j].w; }
        { const int nr = row + NGW; if (nr < MTOT) { const float* xr = nr < MLAT ? F.x + (size_t)nr * DM : F.ctx + (size_t)(nr - MLAT) * DM;
#pragma unroll
            for (int j = 0; j < 4; ++j) nx[j] = *(const f32x4*)(xr + 4 * lane + 256 * j); } }
        const float rstd = rsqrtf(wave_sum(ss) * (1.f / DM) + EPS);
#pragma unroll
        for (int j = 0; j < 4; ++j) {
            const int k = 4 * lane + 256 * j;
            const f32x4 nw = *(const f32x4*)(F.norm_w + k), sc = *(const f32x4*)(scale + k), sh = *(const f32x4*)(shift + k);
            v[j] = v[j] * rstd * nw * (1.f + sc) + sh;
            f16x4 o; o.x = (f16)v[j].x; o.y = (f16)v[j].y; o.z = (f16)v[j].z; o.w = (f16)v[j].w;
            *(f16x4*)(F.H() + (size_t)row * DM + k) = o;
        }
        float pd[16];
#pragma unroll
        for (int d = 0; d < 16; ++d) {
            float p = 0.f;
#pragma unroll
            for (int j = 0; j < 4; ++j) { const f32x4 w = *(const LAS f32x4*)(wdt + d * DM + 4 * lane + 256 * j); p += v[j].x * w.x + v[j].y * w.y + v[j].z * w.z + v[j].w * w.w; }
            pd[d] = p;
            if ((d & 3) == 3) __builtin_amdgcn_sched_barrier(0);
        }
        const float tot = reduce16(pd);
        if (lane < 16) F.DT()[(size_t)row * 16 + lane] = tot;
    }
    __syncthreads();
}


DI void phase_conv(const Ctx& F) {
    const int tid = F.tid, cg = tid & 15, tg = tid >> 4, s0 = 8 * tg;
    for (int u = F.c; u < (MTOT / 256) * 8; u += F.G) {
        const int rb = u >> 3, cb8 = u & 7, row0 = rb * 256, cc = cb8 * 128 + cg * 8;
        int seglo, seghi;
        if (rb < MLAT / 256) { seglo = s0 & ~63; seghi = seglo + 64; } else { seglo = 0; seghi = 256; }
        f16* base = F.U() + (size_t)row0 * NU + UXBC + cc;
        f16x8 raw[12];
#pragma unroll
        for (int i = 0; i < 12; ++i) { const int s = s0 - 2 + i; const bool ok = s >= seglo && s < seghi;
            if (ok) raw[i] = *(const f16x8*)(base + (size_t)s * NU); else raw[i] = (f16x8){0, 0, 0, 0, 0, 0, 0, 0}; }
        float w[5][8], bb[8];
        { const f32x4 b0 = *(const f32x4*)(F.conv_b + cc), b1 = *(const f32x4*)(F.conv_b + cc + 4);
#pragma unroll
          for (int j = 0; j < 4; ++j) { bb[j] = b0[j]; bb[4 + j] = b1[j]; } }
#pragma unroll
        for (int tp = 0; tp < 5; ++tp) { const f32x4 w0 = *(const f32x4*)(F.conv_w + tp * 1024 + cc), w1 = *(const f32x4*)(F.conv_w + tp * 1024 + cc + 4);
#pragma unroll
            for (int j = 0; j < 4; ++j) { w[tp][j] = w0[j]; w[tp][4 + j] = w1[j]; } }
        f16x8 o[8];
#pragma unroll
        for (int t = 0; t < 8; ++t)
#pragma unroll
            for (int j = 0; j < 8; ++j) { float a = bb[j];
#pragma unroll
                for (int tp = 0; tp < 5; ++tp) a += w[tp][j] * (float)raw[t + tp][j];
                o[t][j] = (f16)silu_f(a); }
        asm volatile("s_waitcnt vmcnt(0)" ::: "memory");
        __syncthreads();
#pragma unroll
        for (int t = 0; t < 8; ++t) *(f16x8*)(base + (size_t)(s0 + t) * NU) = o[t];
    }
}

DI void phase_post(const Ctx& F) {
    LAS float* wr = (LAS float*)F.lds;
    for (int i = F.tid; i < DM * 16; i += 512) wr[(i & 15) * DM + (i >> 4)] = F.w_router[i];
    __syncthreads();
    const int lane = F.lane, gw = F.c * 8 + F.wave, NGW = F.G * 8;

    for (int row = gw; row < MLAT; row += NGW) {
        const int b = row / SEQ, t = row % SEQ;
        const float* mod = F.MOD() + b * 6144;
        int lo = 4 * lane; asm volatile("" : "+v"(lo));
        f32x4 r[4], xl[4]; float ss = 0.f;
#pragma unroll
        for (int j = 0; j < 4; ++j) { const f16x4 rh = *(const f16x4*)(F.R() + (size_t)row * DM + 4 * lane + 256 * j); r[j] = (f32x4){(float)rh.x, (float)rh.y, (float)rh.z, (float)rh.w}; xl[j] = *(const f32x4*)(F.x + (size_t)row * DM + 4 * lane + 256 * j); }
#pragma unroll
        for (int j = 0; j < 4; ++j) ss += r[j].x * r[j].x + r[j].y * r[j].y + r[j].z * r[j].z + r[j].w * r[j].w;
        const float rstd = rsqrtf(wave_sum(ss) * (1.f / DM) + EPS);
        float s2 = 0.f;
#pragma unroll
        for (int j = 0; j < 4; ++j) {
            const int k = lo + 256 * j;
            const f32x4 nw = *(const f32x4*)(F.norm_w + 1024 + k), gt = *(const f32x4*)(mod + 2048 + k);
            xl[j] = xl[j] + gt * (r[j] * rstd * nw);
            *(f32x4*)(F.XLAT() + (size_t)row * DM + k) = xl[j];
            s2 += xl[j].x * xl[j].x + xl[j].y * xl[j].y + xl[j].z * xl[j].z + xl[j].w * xl[j].w;
        }
        const float rstd2 = rsqrtf(wave_sum(s2) * (1.f / DM) + EPS);
        float lg[16];
#pragma unroll
        for (int e = 0; e < 16; ++e) lg[e] = 0.f;
#pragma unroll
        for (int j = 0; j < 4; ++j) {
            const int k = lo + 256 * j;
            const f32x4 nw = *(const f32x4*)(F.norm_w + 2048 + k), sh = *(const f32x4*)(mod + 3072 + k), sc = *(const f32x4*)(mod + 4096 + k);
            const f32x4 hv = xl[j] * rstd2 * nw * (1.f + sc) + sh;
            f16x4 o; o.x = (f16)hv.x; o.y = (f16)hv.y; o.z = (f16)hv.z; o.w = (f16)hv.w;
            *(f16x4*)(F.H2() + (size_t)row * DM + k) = o;
#pragma unroll
            for (int e = 0; e < 16; ++e) { const f32x4 w = *(const LAS f32x4*)(wr + e * DM + k); lg[e] += hv.x * w.x + hv.y * w.y + hv.z * w.z + hv.w * w.w; if ((e & 3) == 3) __builtin_amdgcn_sched_barrier(0); }
        }
        const float mylogit = reduce16(lg);
        float mx = mylogit;
#pragma unroll
        for (int o = 1; o < 16; o <<= 1) mx = fmaxf(mx, __shfl_xor(mx, o));
        const float ex = __expf(mylogit - mx);
        float den = ex;
#pragma unroll
        for (int o = 1; o < 16; o <<= 1) den += __shfl_xor(den, o);
        if (lane < 16) F.AFF()[((size_t)b * 16 + lane) * SEQ + t] = ex * __builtin_amdgcn_rcpf(den);
    }
    __syncthreads();
}

DI void phase_topk(const Ctx& F) {
    if (F.c >= 64) return;
    LAS unsigned* vals = (LAS unsigned*)F.lds;
    LAS unsigned* hist = vals + SEQ;
    LAS unsigned* sm = hist + 256;
    const int be = F.c, tid = F.tid;
    const float* a = F.AFF() + (size_t)be * SEQ;
    for (int i = tid; i < SEQ; i += 512) vals[i] = __float_as_uint(a[i]);
    if (tid == 0) { sm[0] = 0u; sm[1] = CAP; }
    __syncthreads();
    unsigned mask = 0u;
    for (int pass = 0; pass < 4; ++pass) {
        const int shift = 24 - 8 * pass;
        if (tid < 256) hist[tid] = 0u;
        __syncthreads();
        const unsigned prefix = sm[0];
        for (int i = tid; i < SEQ; i += 512) { const unsigned v = vals[i]; if ((v & mask) == prefix) atomicAdd((unsigned*)&hist[(v >> shift) & 255u], 1u); }
        __syncthreads();
        {
            const unsigned kcur = sm[1];
            unsigned hv = 0u, suf = 0u;
            if (tid < 256) { hv = hist[255 - tid]; suf = hv;
                for (int o = 1; o < 64; o <<= 1) { const unsigned tt = __shfl_up(suf, o); if ((tid & 63) >= o) suf += tt; }
                if ((tid & 63) == 63) sm[18 + (tid >> 6)] = suf; }
            __syncthreads();
            if (tid < 256) { for (int i = 0; i < (tid >> 6); ++i) suf += sm[18 + i];
                if (suf >= kcur && suf - hv < kcur) { sm[1] = kcur - (suf - hv); sm[0] = prefix | ((unsigned)(255 - tid) << shift); } }
        }
        mask |= 255u << shift;
        __syncthreads();
    }
    const unsigned T = sm[0], keq = sm[1];
    unsigned cg = 0, ce = 0;
    for (int j = 0; j < 16; ++j) { const unsigned v = vals[tid * 16 + j]; cg += v > T; ce += v == T; }
    const int lane = tid & 63, w = tid >> 6;
    unsigned ig = cg, ie = ce;
    for (int o = 1; o < 64; o <<= 1) { const unsigned tg = __shfl_up(ig, o), te = __shfl_up(ie, o); if (lane >= o) { ig += tg; ie += te; } }
    if (lane == 63) { sm[2 + w] = ig; sm[10 + w] = ie; }
    __syncthreads();
    unsigned og = 0, oe = 0;
    for (int i = 0; i < w; ++i) { og += sm[2 + i]; oe += sm[10 + i]; }
    unsigned pg = og + ig - cg, pe = oe + ie - ce;
    const int rowbase = ((be & 15) * 4 + (be >> 4)) * CAP;
    for (int j = 0; j < 16; ++j) {
        const int t = tid * 16 + j; const unsigned v = vals[t];
        int slot = -1;
        if (v > T) { slot = (int)(pg + (pe < keq ? pe : keq)); pg++; }
        else if (v == T) { if (pe < keq) slot = (int)(pg + pe); pe++; }
        F.SLOT()[(size_t)be * SEQ + t] = slot;
        if (slot >= 0) { F.IDX()[rowbase + slot] = t; F.GATEV()[rowbase + slot] = __uint_as_float(v); }
    }
    __syncthreads();
}

DI void phase_combine(const Ctx& F) {
    const int lane = F.lane, gw = F.c * 8 + F.wave, NGW = F.G * 8;
    for (int row = gw; row < MLAT; row += NGW) {
        const int b = row / SEQ, t = row % SEQ;
        const int myslot = F.SLOT()[((size_t)b * 16 + (lane & 15)) * SEQ + t];
        f32x4 xl[4];
#pragma unroll
        for (int j = 0; j < 4; ++j) xl[j] = *(const f32x4*)(F.XLAT() + (size_t)row * DM + 4 * lane + 256 * j);
        unsigned mask = (unsigned)(__ballot(myslot >= 0) & 0xffffull);
        f32x4 acc[4];
#pragma unroll
        for (int j = 0; j < 4; ++j) acc[j] = (f32x4){0, 0, 0, 0};
        while (mask) {
            const int e0 = __builtin_ctz(mask); mask &= mask - 1;
            const int s0 = __shfl(myslot, e0);
            const f16* y0 = F.YM() + (size_t)((e0 * 4 + b) * CAP + s0) * DM + 4 * lane;
            f16x4 v0[4], v1[4];
#pragma unroll
            for (int j = 0; j < 4; ++j) v0[j] = *(const f16x4*)(y0 + 256 * j);
            const bool two = mask != 0;
            if (two) {
                const int e1 = __builtin_ctz(mask); mask &= mask - 1;
                const int s1 = __shfl(myslot, e1);
                const f16* y1 = F.YM() + (size_t)((e1 * 4 + b) * CAP + s1) * DM + 4 * lane;
#pragma unroll
                for (int j = 0; j < 4; ++j) v1[j] = *(const f16x4*)(y1 + 256 * j);
            } else {
#pragma unroll
                for (int j = 0; j < 4; ++j) v1[j] = (f16x4){0, 0, 0, 0};
            }
#pragma unroll
            for (int j = 0; j < 4; ++j) { acc[j].x += (float)v0[j].x + (float)v1[j].x; acc[j].y += (float)v0[j].y + (float)v1[j].y; acc[j].z += (float)v0[j].z + (float)v1[j].z; acc[j].w += (float)v0[j].w + (float)v1[j].w; }
        }
        float ss = 0.f;
#pragma unroll
        for (int j = 0; j < 4; ++j) ss += acc[j].x * acc[j].x + acc[j].y * acc[j].y + acc[j].z * acc[j].z + acc[j].w * acc[j].w;
        const float rstd = rsqrtf(wave_sum(ss) * (1.f / DM) + EPS);
#pragma unroll
        for (int j = 0; j < 4; ++j) {
            const int k = 4 * lane + 256 * j;
            const f32x4 nw = *(const f32x4*)(F.norm_w + 3072 + k), gt = *(const f32x4*)(F.MOD() + b * 6144 + 5120 + k);
            *(f32x4*)(F.out + (size_t)row * DM + k) = xl[j] + gt * (acc[j] * rstd * nw);
        }
    }
}

#ifndef PROBE_PH
#define PROBE_PH -1
#endif

namespace mx {
DI int swz(int row, int chunk) { return row * 256 + ((chunk ^ (row & 15)) << 4); }
template <bool TR>
DI void load_tile(const f16* U, int row0, int s0, int ucol, LAS unsigned char* T, int rbase, int chunk) {
    f16x8 raw[8];
#pragma unroll
    for (int t = 0; t < 8; ++t) raw[t] = *(const f16x8*)(U + (size_t)(row0 + s0 + t) * NU + ucol);
    if (!TR) {
#pragma unroll
        for (int t = 0; t < 8; ++t) *(LAS f16x8*)(T + swz(rbase + t, chunk)) = raw[t];
    } else {
#pragma unroll
        for (int j = 0; j < 8; ++j) { f16x8 v;
#pragma unroll
            for (int t = 0; t < 8; ++t) v[t] = raw[t][j];
            *(LAS f16x8*)(T + swz(rbase + j, chunk)) = v; }
    }
}
DI void scan128(float a0, float a1, float& c0, float& c1, float& tot) {
    float p = a0 + a1;
#pragma unroll
    for (int o = 1; o < 64; o <<= 1) { const float t = __shfl_up(p, o); if ((int)(threadIdx.x & 63) >= o) p += t; }
    c1 = p; c0 = p - a1; tot = __shfl(p, 63);
}
constexpr size_t SSD_SLOT = 8192;
DI size_t ssd_sid(int b, int ck, int h, int dir) { return (size_t)(((b * 66 + ck) * 8 + h) * 2 + dir); }

struct SsaPre { f16x8 raw[8]; float d0, d1; };
DI void ssa_ids(int u, int& b, int& ck, int& h) { b = u / (66 * 8); ck = (u / 8) % 66; h = u & 7; }
DI int ssa_row0(int b, int ck) { return ck < 2 ? MLAT + b * CTXL + 128 * ck : b * SEQ + 128 * (ck - 2); }
DI void ssa_prefetch(const Ctx& F, int u, SsaPre& P) {
    int b, ck, h; ssa_ids(u, b, ck, h);
    const int tid = F.tid, row0 = ssa_row0(b, ck), g = h >> 2;
    if (tid < 384) {
        const int tr = tid & 15, g8 = tid >> 4;
        const int ucol = g8 < 8 ? UXBC + h * 64 + 8 * g8 : UXBC + 512 + g * 128 + 8 * (g8 - 8);
#pragma unroll
        for (int t = 0; t < 8; ++t) P.raw[t] = *(const f16x8*)(F.U() + (size_t)(row0 + 8 * tr + t) * NU + ucol);
    } else {
        const int s = tid - 384;
        P.d0 = F.DT()[(size_t)(row0 + s) * 16 + h]; P.d1 = F.DT()[(size_t)(row0 + s) * 16 + 8 + h];
    }
}
DI void ssd_a_phase(const Ctx& F, f16* ST, float* TOTS) {
    const int tid = F.tid, lane = F.lane;
    LAS unsigned char* XT = F.lds;
    LAS unsigned char* BT = F.lds + 64 * 256;
    LAS float* dtA = (LAS float*)(F.lds + 192 * 256);
    LAS float* laA = dtA + 256;
    LAS f16* w16 = (LAS f16*)(laA + 256);
    int u = F.c; if (u >= 2112) return;
    SsaPre P; ssa_prefetch(F, u, P);
    for (; u < 2112; u += F.G) {
        int b, ck, h; ssa_ids(u, b, ck, h);
        if (tid < 384) {
            const int tr = tid & 15, g8 = tid >> 4;
            LAS unsigned char* T = g8 < 8 ? XT : BT; const int rbase = g8 < 8 ? 8 * g8 : 8 * (g8 - 8);
#pragma unroll
            for (int j = 0; j < 8; ++j) { f16x8 v;
#pragma unroll
                for (int t = 0; t < 8; ++t) v[t] = P.raw[t][j];
                *(LAS f16x8*)(T + swz(rbase + j, tr)) = v; }
        } else {
            const int s = tid - 384;
            const float da = softplus_f(P.d0 + F.dt_bias[h]), db = softplus_f(P.d1 + F.dt_bias[8 + h]);
            dtA[s] = da; laA[s] = -da * __expf(F.a_log[h]); dtA[128 + s] = db; laA[128 + s] = -db * __expf(F.a_log[8 + h]);
        }
        if (u + F.G < 2112) ssa_prefetch(F, u + F.G, P);
        __syncthreads();
        if (F.wave < 2) {
            const int dir = F.wave; const float a0 = laA[dir * 128 + 2 * lane], a1 = laA[dir * 128 + 2 * lane + 1];
            float c0, c1, tot; scan128(a0, a1, c0, c1, tot);
            const float e0 = dir == 0 ? tot - c0 : c0 - a0, e1 = dir == 0 ? tot - c1 : c1 - a1;
            w16[dir * 128 + 2 * lane] = (f16)(dtA[dir * 128 + 2 * lane] * __expf(e0));
            w16[dir * 128 + 2 * lane + 1] = (f16)(dtA[dir * 128 + 2 * lane + 1] * __expf(e1));
            if (lane == 0) TOTS[ssd_sid(b, ck, h, dir)] = __expf(tot);
        }
        __syncthreads();
        {
            int t2 = tid; asm volatile("" : "+v"(t2));
            const int lane2 = t2 & 63, fr = lane2 & 15, fq = lane2 >> 4, wv = __builtin_amdgcn_readfirstlane(t2 >> 6);
            const int dir = wv & 1, ntp = wv >> 1;
            f32x4 acc[2][4];
#pragma unroll
            for (int i = 0; i < 2; ++i)
#pragma unroll
                for (int j = 0; j < 4; ++j) acc[i][j] = (f32x4){0, 0, 0, 0};
#pragma unroll
            for (int kk = 0; kk < 4; ++kk) {
                const f16x8 wv8 = *(const LAS f16x8*)(w16 + dir * 128 + 32 * kk + 8 * fq);
                f16x8 a[2], bf[4];
#pragma unroll
                for (int nt = 0; nt < 2; ++nt) a[nt] = *(const LAS f16x8*)(BT + swz(16 * (2 * ntp + nt) + fr, 4 * kk + fq)) * wv8;
#pragma unroll
                for (int pt = 0; pt < 4; ++pt) bf[pt] = *(const LAS f16x8*)(XT + swz(16 * pt + fr, 4 * kk + fq));
#pragma unroll
                for (int nt = 0; nt < 2; ++nt)
#pragma unroll
                    for (int pt = 0; pt < 4; ++pt) acc[nt][pt] = __builtin_amdgcn_mfma_f32_16x16x32_f16(a[nt], bf[pt], acc[nt][pt], 0, 0, 0);
            }
            f16* S = ST + ssd_sid(b, ck, h, dir) * SSD_SLOT;
#pragma unroll
            for (int nt = 0; nt < 2; ++nt)
#pragma unroll
                for (int pt = 0; pt < 4; ++pt) { f16x4 o; o.x = (f16)acc[nt][pt].x; o.y = (f16)acc[nt][pt].y; o.z = (f16)acc[nt][pt].z; o.w = (f16)acc[nt][pt].w;
                    *(f16x4*)(S + (size_t)(16 * pt + fr) * 128 + 16 * (2 * ntp + nt) + 4 * fq) = o; }
        }
        __syncthreads();
    }
}

DI void ssd_b(const Ctx& F, f16* ST, const float* TOTS) {
    const int idx = F.c * 512 + F.tid; if (idx >= 64 * 2048) return;
    const int e = idx & 2047, chain = idx >> 11, dir = chain & 1, h = (chain >> 1) & 7, b = chain >> 4;
    float run[4] = {0.f, 0.f, 0.f, 0.f};
    for (int s0 = 0; s0 < 66; s0 += 6) {
        f16x4 loc[6]; float d[6]; f16* p[6];
#pragma unroll
        for (int i = 0; i < 6; ++i) { const int st = s0 + i; const int ck = dir == 0 ? st : (st < 2 ? 1 - st : 67 - st);
            const size_t sid = ssd_sid(b, ck, h, dir); p[i] = ST + sid * SSD_SLOT + (size_t)e * 4; loc[i] = *(const f16x4*)p[i]; d[i] = TOTS[sid]; }
#pragma unroll
        for (int i = 0; i < 6; ++i) { f16x4 o; o.x = (f16)run[0]; o.y = (f16)run[1]; o.z = (f16)run[2]; o.w = (f16)run[3]; *(f16x4*)p[i] = o;
            run[0] = d[i] * run[0] + (float)loc[i].x; run[1] = d[i] * run[1] + (float)loc[i].y; run[2] = d[i] * run[2] + (float)loc[i].z; run[3] = d[i] * run[3] + (float)loc[i].w; }
    }
}

DI void ssd_c_unit(const Ctx& F, const f16* ST, int b, int c, int g) {
    const int tid = F.tid, lane = F.lane;
    const int row0 = b * SEQ + 128 * c;
    LAS unsigned char* CT = F.lds;
    LAS unsigned char* BM = F.lds + 128 * 256;
    LAS unsigned char* XT = F.lds + 256 * 256;
    LAS float* dtA = (LAS float*)(F.lds + 131072);
    LAS float* csA = dtA + 1024;
    {
        const int tr = tid & 15, g8 = tid >> 4;
        load_tile<true>(F.U(), row0, 8 * tr, UXBC + g * 256 + 8 * g8, XT, 8 * g8, tr);
    }
    {
        const int g8 = tid & 31, tr = tid >> 5;
        load_tile<false>(F.U(), row0, 8 * tr, UXBC + 512 + (g8 >> 4) * 256 + g * 128 + 8 * (g8 & 15), g8 < 16 ? BM : CT, 8 * tr, g8 & 15);
    }
#pragma unroll
    for (int q = 0; q < 2; ++q) { const int idx = tid + 512 * q, s = idx & 127, hd = idx >> 7, hh = hd >> 1, dir = hd & 1, h = g * 4 + hh;
        const float d = softplus_f(F.DT()[(size_t)(row0 + s) * 16 + dir * 8 + h] + F.dt_bias[dir * 8 + h]);
        dtA[hd * 128 + s] = d; csA[hd * 128 + s] = -d * __expf(F.a_log[dir * 8 + h]); }
    __syncthreads();
    {
        const int wv = F.wave;
        const float a0 = csA[wv * 128 + 2 * lane], a1 = csA[wv * 128 + 2 * lane + 1];
        float c0, c1, tot; scan128(a0, a1, c0, c1, tot);
        if (wv & 1) { c0 = tot - c0 + a0; c1 = tot - c1 + a1; }
        csA[wv * 128 + 2 * lane] = c0; csA[wv * 128 + 2 * lane + 1] = c1;
    }
    __syncthreads();
    int t2 = tid; asm volatile("" : "+v"(t2));
    const int lane2 = t2 & 63, fr = lane2 & 15, fq = lane2 >> 4, w = __builtin_amdgcn_readfirstlane(t2 >> 6);
    const int l0 = 16 * w + fr;
    f16x8 cfr[4];
#pragma unroll
    for (int kk = 0; kk < 4; ++kk) cfr[kk] = *(const LAS f16x8*)(CT + swz(l0, 4 * kk + fq));
    f32x4 gacc[8];
#pragma unroll
    for (int st = 0; st < 8; ++st) { gacc[st] = (f32x4){0, 0, 0, 0};
#pragma unroll
        for (int kk = 0; kk < 4; ++kk) gacc[st] = __builtin_amdgcn_mfma_f32_16x16x32_f16(*(const LAS f16x8*)(BM + swz(16 * st + fr, 4 * kk + fq)), cfr[kk], gacc[st], 0, 0, 0); }
    float dsk4 = F.ssd_d[g * 4 + (lane2 & 3)]; asm volatile("s_waitcnt vmcnt(0)" : "+v"(dsk4) :: "memory");
    __syncthreads();
#define SSD_RING_ISSUE(q) do { const f16* _S = ST + ssd_sid(b, c + 2, g * 4 + ((q) >> 1), (q) & 1) * SSD_SLOT; \
        _Pragma("unroll") for (int _p = 0; _p < 2; ++_p) { const int _o = (w * 2 + _p) * 1024 + lane2 * 16, _row = _o >> 8, _pch = (_o >> 4) & 15, _lch = _pch ^ (_row & 15); \
            __builtin_amdgcn_global_load_lds((const unsigned*)((const char*)_S + _row * 256 + _lch * 16), (LAS unsigned*)(CT + ((q) & 3) * 16384 + (w * 2 + _p) * 1024), 16, 0, 0); } } while (0)
    SSD_RING_ISSUE(0); SSD_RING_ISSUE(1); SSD_RING_ISSUE(2); SSD_RING_ISSUE(3);
    f16* yrow = F.Y() + (size_t)(row0 + l0) * DM + g * 256;
#pragma unroll 1
    for (int hh = 0; hh < 4; ++hh) {
        const int h = g * 4 + hh;
        int l = l0; asm volatile("" : "+v"(l));
        const LAS float* dtf = dtA + (2 * hh) * 128, *dtb = dtA + (2 * hh + 1) * 128, *csf = csA + (2 * hh) * 128, *rcb = csA + (2 * hh + 1) * 128;
        const float csf_l = csf[l], rcb_l = rcb[l], dsum_l = dtf[l] + dtb[l], dskip = __shfl(dsk4, hh);
        f32x4 yacc[4];
#pragma unroll
        for (int pt = 0; pt < 4; ++pt) yacc[pt] = (f32x4){0, 0, 0, 0};
#pragma unroll
        for (int kk = 0; kk < 4; ++kk) {
            f16x8 m;
#pragma unroll
            for (int hf = 0; hf < 2; ++hf) { const int st = 2 * kk + hf, sb = 16 * st + 4 * fq;
                const f32x4 cf = *(const LAS f32x4*)(csf + sb), rb = *(const LAS f32x4*)(rcb + sb), df = *(const LAS f32x4*)(dtf + sb), db = *(const LAS f32x4*)(dtb + sb);
#pragma unroll
                for (int r = 0; r < 4; ++r) { const int s = sb + r;
                    const float arg = s < l ? csf_l - cf[r] : (s > l ? rcb_l - rb[r] : 0.f);
                    const float dsel = s < l ? df[r] : (s > l ? db[r] : dsum_l);
                    float val = gacc[st][r] * __expf(arg) * dsel; if (s == l) val += dskip;
                    m[hf * 4 + r] = (f16)val; } }
            __builtin_amdgcn_sched_barrier(0);
#pragma unroll
            for (int pt = 0; pt < 4; ++pt) { const int p = 64 * hh + 16 * pt + fr;
                const f16x4 x0 = *(const LAS f16x4*)(XT + swz(p, 4 * kk + (fq >> 1)) + 8 * (fq & 1));
                const f16x4 x1 = *(const LAS f16x4*)(XT + swz(p, 4 * kk + 2 + (fq >> 1)) + 8 * (fq & 1));
                f16x8 xf; xf[0] = x0[0]; xf[1] = x0[1]; xf[2] = x0[2]; xf[3] = x0[3]; xf[4] = x1[0]; xf[5] = x1[1]; xf[6] = x1[2]; xf[7] = x1[3];
                yacc[pt] = __builtin_amdgcn_mfma_f32_16x16x32_f16(xf, m, yacc[pt], 0, 0, 0); }
            __builtin_amdgcn_sched_barrier(0);
        }
        asm volatile("s_waitcnt vmcnt(0)" ::: "memory");
        __syncthreads();
#pragma unroll
        for (int dir = 0; dir < 2; ++dir) {
            const LAS unsigned char* SL = CT + ((2 * hh + dir) & 3) * 16384;
            f32x4 off[4];
#pragma unroll
            for (int pt = 0; pt < 4; ++pt) off[pt] = (f32x4){0, 0, 0, 0};
#pragma unroll
            for (int kk = 0; kk < 4; ++kk)
#pragma unroll
                for (int pt = 0; pt < 4; ++pt) off[pt] = __builtin_amdgcn_mfma_f32_16x16x32_f16(*(const LAS f16x8*)(SL + swz(16 * pt + fr, 4 * kk + fq)), cfr[kk], off[pt], 0, 0, 0);
            const float e = __expf(dir == 0 ? csf_l : rcb_l);
#pragma unroll
            for (int pt = 0; pt < 4; ++pt) yacc[pt] += off[pt] * e;
        }
#pragma unroll
        for (int pt = 0; pt < 4; ++pt) { f16x4 o; o.x = (f16)yacc[pt].x; o.y = (f16)yacc[pt].y; o.z = (f16)yacc[pt].z; o.w = (f16)yacc[pt].w;
            *(f16x4*)(yrow + 64 * hh + 16 * pt + 4 * fq) = o; }
        __syncthreads();
        if (hh < 2) { SSD_RING_ISSUE(2 * hh + 4); SSD_RING_ISSUE(2 * hh + 5); }
    }
#undef SSD_RING_ISSUE
    asm volatile("s_waitcnt vmcnt(0)" ::: "memory");
    const size_t urow = (size_t)(row0 + l0) * NU + UZ + g * 256;
    f16x4 yv[16], zv[16];
#pragma unroll
    for (int i = 0; i < 16; ++i) { yv[i] = *(const f16x4*)(yrow + 16 * i + 4 * fq); zv[i] = *(const f16x4*)(F.U() + urow + 16 * i + 4 * fq); }
    float ss = 0.f; f32x4 gv[16];
#pragma unroll
    for (int i = 0; i < 16; ++i) { gv[i].x = (float)yv[i].x * silu_f((float)zv[i].x); gv[i].y = (float)yv[i].y * silu_f((float)zv[i].y); gv[i].z = (float)yv[i].z * silu_f((float)zv[i].z); gv[i].w = (float)yv[i].w * silu_f((float)zv[i].w);
        ss += gv[i].x * gv[i].x + gv[i].y * gv[i].y + gv[i].z * gv[i].z + gv[i].w * gv[i].w; }
    ss += __shfl_xor(ss, 16); ss += __shfl_xor(ss, 32);
    const float rstd = rsqrtf(ss * (1.f / 256.f) + EPS);
#pragma unroll
    for (int i = 0; i < 16; ++i) { const int ch = 16 * i + 4 * fq; const f32x4 nw = *(const f32x4*)(F.ssd_nw + g * 256 + ch);
        f16x4 o; o.x = (f16)(gv[i].x * rstd * nw.x); o.y = (f16)(gv[i].y * rstd * nw.y); o.z = (f16)(gv[i].z * rstd * nw.z); o.w = (f16)(gv[i].w * rstd * nw.w);
        *(f16x4*)(yrow + ch) = o; }
    __syncthreads();
}
}

namespace mx {
typedef short s16x8 __attribute__((ext_vector_type(8)));
typedef float f32x2 __attribute__((ext_vector_type(2)));
DI int swz64(int row, int chunk) { return row * 128 + ((chunk ^ ((row >> 1) & 7)) << 4); }
DI unsigned short f2bf(float f) { unsigned u = __builtin_bit_cast(unsigned, f); return (unsigned short)((u + 0x7fffu + ((u >> 16) & 1u)) >> 16); }
constexpr size_t HG_SLOT = 16384;
DI size_t hg_sid(int b, int ck, int h, int dir) { return (size_t)(((b * 132 + ck) * 4 + h) * 2 + dir); }
DI f16* hg_slot(f16* HCT, f16* HLAT, int b, int ck, int h, int dir) {
    return ck < 4 ? HCT + (size_t)(((b * 4 + ck) * 4 + h) * 2 + dir) * HG_SLOT : HLAT + (size_t)(((b * 128 + (ck - 4)) * 4 + h) * 2 + dir) * HG_SLOT;
}
template <int NCH>
DI void load_raw(const Ctx& F, int row0, int ucol, LAS unsigned char* RAW) {
    constexpr int CPR = NCH / 8;
    for (int i = F.tid; i < 64 * CPR; i += 512) { const int t = i / CPR, cch = i % CPR;
        *(LAS f16x8*)(RAW + (t * NCH + cch * 8) * 2) = *(const f16x8*)(F.U() + (size_t)(row0 + t) * NU + ucol + cch * 8); }
}
DI void load_vt(const Ctx& F, int row0, int h, LAS unsigned char* VT) {
    const int i = F.tid & 31, g8 = F.tid >> 5;
    const f16x8 a = *(const f16x8*)(F.U() + (size_t)(row0 + 2 * i) * NU + UI + h * 128 + 8 * g8);
    const f16x8 b = *(const f16x8*)(F.U() + (size_t)(row0 + 2 * i + 1) * NU + UI + h * 128 + 8 * g8);
#pragma unroll
    for (int j = 0; j < 8; ++j) { typedef _Float16 h2 __attribute__((ext_vector_type(2))); h2 p; p.x = a[j]; p.y = b[j];
        *(LAS h2*)(VT + swz64(8 * g8 + j, i >> 2) + (i & 3) * 4) = p; }
}

template <int T0, int SGN>
DI float hg_gates(const LAS f16* rf, float lb, float (&f)[32]) {
    float prod = 1.f;
#pragma unroll
    for (int i = 0; i < 32; ++i) { const int t = T0 + SGN * i; f[i] = lb + (1.f - lb) * sigmoid_f((float)rf[t * 128]); prod *= f[i]; }
    return prod;
}
template <int T0, int SGN>
DI void hg_a_write(const float (&f)[32], float R, LAS unsigned char* T, int k) {
    f16 v[32];
#pragma unroll
    for (int i = 0; i < 32; ++i) { v[i] = (f16)((1.f - f[i]) * R); R *= f[i]; }
#pragma unroll
    for (int j = 0; j < 4; ++j) { f16x8 o;
#pragma unroll
        for (int q = 0; q < 8; ++q) { const int t = (T0 < 32 ? 0 : 32) + 8 * j + q; const int i = SGN > 0 ? t - T0 : T0 - t; o[q] = v[i]; }
        const int ch = ((T0 < 32 ? 0 : 32) >> 3) + j;
        *(LAS f16x8*)(T + k * 128 + ((ch ^ ((k >> 1) & 7)) << 4)) = o; }
}
template <int T0, int SGN>
DI void hg_c_write(const float (&f)[32], float P, const LAS f16* rq, LAS unsigned char* TQ, LAS unsigned char* TK, int k) {
    const int cb = (k & 7) * 2, cx = (k >> 3) << 4;
#pragma unroll
    for (int i = 0; i < 32; ++i) { const int t = T0 + SGN * i; P *= f[i];
        const float qv = silu_f((float)rq[t * 128]);
        const int off = t * 256 + (cx ^ ((t & 15) << 4)) + cb;
        *(LAS unsigned short*)(TQ + off) = f2bf(qv * P);
        *(LAS unsigned short*)(TK + off) = f2bf((1.f - f[i]) * __builtin_amdgcn_rcpf(P)); }
}

typedef _Float16 f16x2 __attribute__((ext_vector_type(2)));
struct HgaPre { unsigned rf[16]; f16x8 va, vb; };
DI void hga_ids(int v, int& b, int& ck, int& h) { b = v / (132 * 4); ck = (v / 4) % 132; h = v & 3; }
DI int hga_row0(int b, int ck) { return ck < 4 ? MLAT + b * CTXL + 64 * ck : b * SEQ + 64 * (ck - 4); }
DI void hga_prefetch(const Ctx& F, int v, HgaPre& P) {
    int b, ck, h; hga_ids(v, b, ck, h);
    const int tid = F.tid, row0 = hga_row0(b, ck);
    const int kp = tid & 63, dir = (tid >> 6) & 1, qq = tid >> 7;
    const int T0 = dir == 0 ? 16 * qq : 63 - 16 * qq, SG = dir == 0 ? 1 : -1;
    const f16* pf = F.U() + (size_t)(row0 + T0) * NU + (dir ? UFB : UFF) + h * 128 + 2 * kp;
    const long st = (long)SG * NU;
#pragma unroll
    for (int i = 0; i < 16; ++i) P.rf[i] = *(const unsigned*)(pf + i * st);
    const int pi = tid & 31, g8 = tid >> 5;
    P.va = *(const f16x8*)(F.U() + (size_t)(row0 + 2 * pi) * NU + UI + h * 128 + 8 * g8);
    P.vb = *(const f16x8*)(F.U() + (size_t)(row0 + 2 * pi + 1) * NU + UI + h * 128 + 8 * g8);
}
DI void hg_a_phase(const Ctx& F, f16* HCT, f16* HLAT, float* DEC) {
    LAS unsigned char* KD = F.lds;
    LAS unsigned char* VT = F.lds + 32768;
    LAS float* PX = (LAS float*)(F.lds + 49152);
    const int tid = F.tid;
    int v = (F.c + 64) % F.G; if (v >= 2112) return;
    HgaPre P; hga_prefetch(F, v, P);
    for (; v < 2112; v += F.G) {
        int b, ck, h; hga_ids(v, b, ck, h);
        unsigned rf[16];
#pragma unroll
        for (int i = 0; i < 16; ++i) rf[i] = P.rf[i];
        const f16x8 va = P.va, vb = P.vb;
        if (v + F.G < 2112) hga_prefetch(F, v + F.G, P);
        { const int pi = tid & 31, g8 = tid >> 5;
#pragma unroll
          for (int j = 0; j < 8; ++j) { typedef _Float16 h2 __attribute__((ext_vector_type(2))); h2 pr; pr.x = va[j]; pr.y = vb[j];
              *(LAS h2*)(VT + swz64(8 * g8 + j, pi >> 2) + (pi & 3) * 4) = pr; } }
        {
            const int kp = tid & 63, dir = (tid >> 6) & 1, qq = tid >> 7, ch = h * 128 + 2 * kp;
            float lb[2];
#pragma unroll
            for (int e = 0; e < 2; ++e) { const float l0 = F.hgrn_lb[dir * 512 + ch + e], l1 = F.hgrn_lb[1024 + dir * 512 + ch + e]; lb[e] = __builtin_amdgcn_rcpf(1.f + __expf(l1 - l0)); }
            float f0[16], f1[16]; float p0 = 1.f, p1 = 1.f;
#pragma unroll
            for (int i = 0; i < 16; ++i) { const f16x2 r = __builtin_bit_cast(f16x2, rf[i]);
                f0[i] = lb[0] + (1.f - lb[0]) * sigmoid_f((float)r.x); f1[i] = lb[1] + (1.f - lb[1]) * sigmoid_f((float)r.y); p0 *= f0[i]; p1 *= f1[i]; }
            *(LAS f32x2*)(PX + (dir * 4 + qq) * 128 + 2 * kp) = (f32x2){p0, p1};
            __syncthreads();
            float c0 = 1.f, c1 = 1.f, a0 = p0, a1 = p1;
            for (int q2 = 0; q2 < 4; ++q2) if (q2 != qq) { const f32x2 pp = *(const LAS f32x2*)(PX + (dir * 4 + q2) * 128 + 2 * kp); a0 *= pp.x; a1 *= pp.y; if (q2 > qq) { c0 *= pp.x; c1 *= pp.y; } }
            if (qq == 0) *(f32x2*)(DEC + hg_sid(b, ck, h, dir) * 128 + 2 * kp) = (f32x2){a0, a1};
            f16 w0[16], w1[16];
#pragma unroll
            for (int i = 15; i >= 0; --i) { w0[i] = (f16)((1.f - f0[i]) * c0); w1[i] = (f16)((1.f - f1[i]) * c1); c0 *= f0[i]; c1 *= f1[i]; }
            const int tb = dir == 0 ? 16 * qq : 48 - 16 * qq;
            LAS unsigned char* T = KD + dir * 16384;
#pragma unroll
            for (int e = 0; e < 2; ++e)
#pragma unroll
                for (int hf = 0; hf < 2; ++hf) { f16x8 o;
#pragma unroll
                    for (int q = 0; q < 8; ++q) { const int j = 8 * hf + q; const int i = dir == 0 ? j : 15 - j; o[q] = e == 0 ? w0[i] : w1[i]; }
                    *(LAS f16x8*)(T + swz64(2 * kp + e, (tb >> 3) + hf)) = o; }
        }
        __syncthreads();
        {
            int t2 = tid; asm volatile("" : "+v"(t2));
            const int lane2 = t2 & 63, fr = lane2 & 15, fq = lane2 >> 4, w = __builtin_amdgcn_readfirstlane(t2 >> 6);
            const int dir = w & 1, q = w >> 1;
            const LAS unsigned char* T = KD + dir * 16384;
            f32x4 acc[2][8];
#pragma unroll
            for (int i = 0; i < 2; ++i)
#pragma unroll
                for (int j = 0; j < 8; ++j) acc[i][j] = (f32x4){0, 0, 0, 0};
#pragma unroll
            for (int kk = 0; kk < 2; ++kk) {
                f16x8 a[2];
#pragma unroll
                for (int i = 0; i < 2; ++i) a[i] = *(const LAS f16x8*)(T + swz64(16 * (2 * q + i) + fr, 4 * kk + fq));
#pragma unroll
                for (int vt = 0; vt < 8; ++vt) { const f16x8 bv = *(const LAS f16x8*)(VT + swz64(16 * vt + fr, 4 * kk + fq));
#pragma unroll
                    for (int i = 0; i < 2; ++i) acc[i][vt] = __builtin_amdgcn_mfma_f32_16x16x32_f16(a[i], bv, acc[i][vt], 0, 0, 0); }
            }
            f16* S = hg_slot(HCT, HLAT, b, ck, h, dir);
#pragma unroll
            for (int i = 0; i < 2; ++i)
#pragma unroll
                for (int vt = 0; vt < 8; ++vt) { f16x4 o; o.x = (f16)acc[i][vt].x; o.y = (f16)acc[i][vt].y; o.z = (f16)acc[i][vt].z; o.w = (f16)acc[i][vt].w;
                    *(f16x4*)(S + (size_t)(16 * vt + fr) * 128 + 16 * (2 * q + i) + 4 * fq) = o; }
        }
        __syncthreads();
    }
}

DI void hg_b(const Ctx& F, f16* HCT, f16* HLAT, const float* DEC) {
    const int idx = F.c * 512 + F.tid; if (idx >= 32 * 4096) return;
    const int e = idx & 4095, chain = idx >> 12, dir = chain & 1, h = (chain >> 1) & 3, b = chain >> 3;
    const int k0 = (e & 31) * 4;
    float run[4] = {0.f, 0.f, 0.f, 0.f};
    for (int s0 = 0; s0 < 132; s0 += 6) {
        f16x4 loc[6]; f32x4 d[6]; f16* p[6];
#pragma unroll
        for (int i = 0; i < 6; ++i) { const int st = s0 + i; const int ck = dir == 0 ? st : (st < 4 ? 3 - st : 135 - st);
            p[i] = hg_slot(HCT, HLAT, b, ck, h, dir) + (size_t)e * 4; loc[i] = *(const f16x4*)p[i]; d[i] = *(const f32x4*)(DEC + hg_sid(b, ck, h, dir) * 128 + k0); }
#pragma unroll
        for (int i = 0; i < 6; ++i) { f16x4 o; o.x = (f16)run[0]; o.y = (f16)run[1]; o.z = (f16)run[2]; o.w = (f16)run[3]; *(f16x4*)p[i] = o;
            run[0] = d[i].x * run[0] + (float)loc[i].x; run[1] = d[i].y * run[1] + (float)loc[i].y; run[2] = d[i].z * run[2] + (float)loc[i].z; run[3] = d[i].w * run[3] + (float)loc[i].w; }
    }
}

DI unsigned cvt_pk_bf16(float lo, float hi) { unsigned r; asm volatile("v_cvt_pk_bf16_f32 %0, %1, %2" : "=v"(r) : "v"(lo), "v"(hi)); return r; }
struct HgcPre { unsigned rf[16], rq[16]; f16x8 va, vb; f16x4 g[4]; };
DI void hgc_unit_ids(int u, int& b, int& c, int& h) { b = u >> 9; c = (u >> 2) & 127; h = u & 3; }
DI void hgc_prefetch(const Ctx& F, int u, HgcPre& P) {
    int b, c, h; hgc_unit_ids(u, b, c, h);
    const int tid = F.tid, row0 = b * SEQ + 64 * c;
    const int kp = tid & 63, dir = (tid >> 6) & 1, qq = tid >> 7;
    const int T0 = dir == 0 ? 16 * qq : 63 - 16 * qq, SG = dir == 0 ? 1 : -1;
    const f16* pf = F.U() + (size_t)(row0 + T0) * NU + (dir ? UFB : UFF) + h * 128 + 2 * kp;
    const f16* pq = F.U() + (size_t)(row0 + T0) * NU + UQ + h * 128 + 2 * kp;
    const long st = (long)SG * NU;
#pragma unroll
    for (int i = 0; i < 16; ++i) { P.rf[i] = *(const unsigned*)(pf + i * st); P.rq[i] = *(const unsigned*)(pq + i * st); }
    const int pi = tid & 31, g8 = tid >> 5;
    P.va = *(const f16x8*)(F.U() + (size_t)(row0 + 2 * pi) * NU + UI + h * 128 + 8 * g8);
    P.vb = *(const f16x8*)(F.U() + (size_t)(row0 + 2 * pi + 1) * NU + UI + h * 128 + 8 * g8);
    const int lane = tid & 63, fr = lane & 15, fq = lane >> 4, w = tid >> 6, lt = w & 3, vh = w >> 2;
    const f16* pg = F.U() + (size_t)(row0 + 16 * lt + fr) * NU + UG + h * 128 + 64 * vh + 4 * fq;
#pragma unroll
    for (int vt = 0; vt < 4; ++vt) P.g[vt] = *(const f16x4*)(pg + 16 * vt);
}
DI void hg_c_phase(const Ctx& F, f16* HCT, f16* HLAT) {
    LAS unsigned char* QD = F.lds;
    LAS unsigned char* KI = F.lds + 32768;
    LAS unsigned char* VT = F.lds + 65536;
    LAS unsigned char* SS = F.lds + 81920;
    LAS float* red = (LAS float*)(F.lds + 147456);
    LAS float* PX = red + 128;
    const int tid = F.tid;
    int u = F.c; if (u >= 2048) return;
    HgcPre P; hgc_prefetch(F, u, P);
    for (; u < 2048; u += F.G) {
        int b, c, h; hgc_unit_ids(u, b, c, h);
        const int row0 = b * SEQ + 64 * c;
        unsigned rf[16], rq[16];
#pragma unroll
        for (int i = 0; i < 16; ++i) { rf[i] = P.rf[i]; rq[i] = P.rq[i]; }
        const f16x8 va = P.va, vb = P.vb; f16x4 gz[4];
#pragma unroll
        for (int vt = 0; vt < 4; ++vt) gz[vt] = P.g[vt];
        if (u + F.G < 2048) hgc_prefetch(F, u + F.G, P);
        {
            const int wv = __builtin_amdgcn_readfirstlane(tid >> 6), lane = tid & 63;
#pragma unroll
            for (int dir = 0; dir < 2; ++dir) { const f16* S = hg_slot(HCT, HLAT, b, c + 4, h, dir);
#pragma unroll
                for (int p = 0; p < 4; ++p) { const int o = (wv * 4 + p) * 1024 + lane * 16, row = o >> 8, pch = (o >> 4) & 15, lch = pch ^ (row & 15);
                    __builtin_amdgcn_global_load_lds((const unsigned*)((const char*)S + row * 256 + lch * 16), (LAS unsigned*)(SS + dir * 32768 + (wv * 4 + p) * 1024), 16, 0, 0); } }
        }
        { const int pi = tid & 31, g8 = tid >> 5;
#pragma unroll
          for (int j = 0; j < 8; ++j) { typedef _Float16 h2 __attribute__((ext_vector_type(2))); h2 pr; pr.x = va[j]; pr.y = vb[j];
              *(LAS h2*)(VT + swz64(8 * g8 + j, pi >> 2) + (pi & 3) * 4) = pr; } }
        {
            const int kp = tid & 63, dir = (tid >> 6) & 1, qq = tid >> 7, ch = h * 128 + 2 * kp;
            const int T0 = dir == 0 ? 16 * qq : 63 - 16 * qq, SG = dir == 0 ? 1 : -1;
            float lb[2];
#pragma unroll
            for (int e = 0; e < 2; ++e) { const float l0 = F.hgrn_lb[dir * 512 + ch + e], l1 = F.hgrn_lb[1024 + dir * 512 + ch + e]; lb[e] = __builtin_amdgcn_rcpf(1.f + __expf(l1 - l0)); }
            float f0[16], f1[16]; float p0 = 1.f, p1 = 1.f;
#pragma unroll
            for (int i = 0; i < 16; ++i) { const f16x2 r = __builtin_bit_cast(f16x2, rf[i]);
                f0[i] = lb[0] + (1.f - lb[0]) * sigmoid_f((float)r.x); f1[i] = lb[1] + (1.f - lb[1]) * sigmoid_f((float)r.y); p0 *= f0[i]; p1 *= f1[i]; }
            *(LAS f32x2*)(PX + (dir * 4 + qq) * 128 + 2 * kp) = (f32x2){p0, p1};
            __syncthreads();
            float c0 = 1.f, c1 = 1.f;
            for (int q2 = 0; q2 < qq; ++q2) { const f32x2 pp = *(const LAS f32x2*)(PX + (dir * 4 + q2) * 128 + 2 * kp); c0 *= pp.x; c1 *= pp.y; }
            LAS unsigned char* TQ = QD + dir * 16384; LAS unsigned char* TK = KI + dir * 16384;
            const int cb = (kp & 3) * 4, cx = (kp >> 2) << 4;
#pragma unroll
            for (int i = 0; i < 16; ++i) { const int t = T0 + SG * i; c0 *= f0[i]; c1 *= f1[i];
                const f16x2 r = __builtin_bit_cast(f16x2, rq[i]);
                const int off = t * 256 + (cx ^ ((t & 15) << 4)) + cb;
                *(LAS unsigned*)(TQ + off) = cvt_pk_bf16(silu_f((float)r.x) * c0, silu_f((float)r.y) * c1);
                *(LAS unsigned*)(TK + off) = cvt_pk_bf16((1.f - f0[i]) * __builtin_amdgcn_rcpf(c0), (1.f - f1[i]) * __builtin_amdgcn_rcpf(c1)); }
        }
        __syncthreads();
        int t2 = tid; asm volatile("" : "+v"(t2));
        const int lane2 = t2 & 63, fr = lane2 & 15, fq = lane2 >> 4, w = __builtin_amdgcn_readfirstlane(t2 >> 6);
        const int lt = w & 3, vh = w >> 2, l = 16 * lt + fr;
        f32x4 oacc[4];
#pragma unroll
        for (int vt = 0; vt < 4; ++vt) oacc[vt] = (f32x4){0, 0, 0, 0};
        s16x8 qfr[2][4];
#pragma unroll
        for (int dir = 0; dir < 2; ++dir) {
            const LAS unsigned char* TQ = QD + dir * 16384; const LAS unsigned char* TK = KI + dir * 16384;
#pragma unroll
            for (int kk = 0; kk < 4; ++kk) qfr[dir][kk] = *(const LAS s16x8*)(TQ + swz(l, 4 * kk + fq));
            f32x4 att[4];
#pragma unroll
            for (int st = 0; st < 4; ++st) { att[st] = (f32x4){0, 0, 0, 0};
#pragma unroll
                for (int kk = 0; kk < 4; ++kk) att[st] = __builtin_amdgcn_mfma_f32_16x16x32_bf16(*(const LAS s16x8*)(TK + swz(16 * st + fr, 4 * kk + fq)), qfr[dir][kk], att[st], 0, 0, 0); }
#pragma unroll
            for (int k2 = 0; k2 < 2; ++k2) {
                f16x8 m;
#pragma unroll
                for (int hf = 0; hf < 2; ++hf)
#pragma unroll
                    for (int r = 0; r < 4; ++r) { const int s = 16 * (2 * k2 + hf) + 4 * fq + r; const bool keep = dir == 0 ? s <= l : s >= l; m[hf * 4 + r] = keep ? (f16)att[2 * k2 + hf][r] : (f16)0.f; }
#pragma unroll
                for (int vt = 0; vt < 4; ++vt) { const int v = 64 * vh + 16 * vt + fr;
                    const f16x4 x0 = *(const LAS f16x4*)(VT + swz64(v, 4 * k2 + (fq >> 1)) + 8 * (fq & 1));
                    const f16x4 x1 = *(const LAS f16x4*)(VT + swz64(v, 4 * k2 + 2 + (fq >> 1)) + 8 * (fq & 1));
                    f16x8 xf; xf[0] = x0[0]; xf[1] = x0[1]; xf[2] = x0[2]; xf[3] = x0[3]; xf[4] = x1[0]; xf[5] = x1[1]; xf[6] = x1[2]; xf[7] = x1[3];
                    oacc[vt] = __builtin_amdgcn_mfma_f32_16x16x32_f16(xf, m, oacc[vt], 0, 0, 0); }
            }
        }
        asm volatile("s_waitcnt vmcnt(0)" ::: "memory");
        __syncthreads();
#pragma unroll
        for (int dir = 0; dir < 2; ++dir)
#pragma unroll
            for (int kk = 0; kk < 4; ++kk) { f16x8 q16;
#pragma unroll
                for (int j = 0; j < 8; ++j) q16[j] = (f16)__builtin_bit_cast(float, ((unsigned)(unsigned short)qfr[dir][kk][j]) << 16);
#pragma unroll
                for (int vt = 0; vt < 4; ++vt) oacc[vt] = __builtin_amdgcn_mfma_f32_16x16x32_f16(*(const LAS f16x8*)(SS + dir * 32768 + swz(64 * vh + 16 * vt + fr, 4 * kk + fq)), q16, oacc[vt], 0, 0, 0); }
        float ss = 0.f;
#pragma unroll
        for (int vt = 0; vt < 4; ++vt) ss += oacc[vt].x * oacc[vt].x + oacc[vt].y * oacc[vt].y + oacc[vt].z * oacc[vt].z + oacc[vt].w * oacc[vt].w;
        ss += __shfl_xor(ss, 16); ss += __shfl_xor(ss, 32);
        if (fq == 0) red[vh * 64 + l] = ss;
        __syncthreads();
        const float rstd = rsqrtf((red[l] + red[64 + l]) * (1.f / 128.f) + EPS);
        f16* yrow = F.Y() + (size_t)(row0 + l) * DM + 512 + h * 128;
#pragma unroll
        for (int vt = 0; vt < 4; ++vt) { const int v = 64 * vh + 16 * vt + 4 * fq;
            const f32x4 nw = *(const f32x4*)(F.hgrn_nw + h * 128 + v);
            f16x4 o; o.x = (f16)(oacc[vt].x * rstd * nw.x * silu_f((float)gz[vt].x)); o.y = (f16)(oacc[vt].y * rstd * nw.y * silu_f((float)gz[vt].y));
            o.z = (f16)(oacc[vt].z * rstd * nw.z * silu_f((float)gz[vt].z)); o.w = (f16)(oacc[vt].w * rstd * nw.w * silu_f((float)gz[vt].w));
            *(f16x4*)(yrow + v) = o; }
        __syncthreads();
    }
}
}

__global__ void __launch_bounds__(512, 2) mk_fwd(Args args) {
    extern __shared__ __attribute__((aligned(16))) unsigned char lds_raw[];
    Ctx F;
    F.lds = (LAS unsigned char*)lds_raw;
    F.tid = threadIdx.x; F.lane = F.tid & 63; F.wave = __builtin_amdgcn_readfirstlane(F.tid >> 6); F.G = gridDim.x; F.c = blockIdx.x;
    unsigned char* ws = args.ws;
    F.x = args.in[0]; F.cvec = args.in[1]; F.ctx = args.in[2]; F.c_ctx = args.in[3]; F.ada_w = args.in[4]; F.ada_b = args.in[5]; F.norm_w = args.in[6]; F.w_in = args.in[7];
    F.conv_w = args.in[8]; F.conv_b = args.in[9]; F.dt_bias = args.in[10]; F.a_log = args.in[11]; F.ssd_d = args.in[12]; F.ssd_nw = args.in[13]; F.hgrn_lb = args.in[14]; F.hgrn_nw = args.in[15];
    F.w_out = args.in[16]; F.w_router = args.in[17]; F.w_gate = args.in[18]; F.w_up = args.in[19]; F.w_down = args.in[20];
    F.out = args.out;
    F.ws = ws;
    volatile LAS unsigned* misc = (volatile LAS unsigned*)(F.lds + LDS_MISC_OFF);
    if (F.tid < 16) misc[F.tid] = 0u;
    __syncthreads();
    XcdBarrier bar = xcd_barrier_post((unsigned*)(ws + WS_BAR), misc + 8);
    f16* SST = (f16*)(ws + WS_H); float* TOTS = (float*)(ws + WS_Y); float* DEC = (float*)(ws + WS_Y + 65536);
    f16* HCT = (f16*)(ws + WS_AFF); f16* HLAT = (f16*)F.out;
    const int hi = args.hi;
#define REFRESH() do { int _t = threadIdx.x; asm volatile("" : "+v"(_t)); F.tid = _t; F.lane = _t & 63; F.wave = __builtin_amdgcn_readfirstlane(_t >> 6); } while (0)
#define PHASE(k, last, ...) do { if ((k) < hi) { REFRESH(); __VA_ARGS__; if (!(last) && (k) + 1 < hi) xcd_barrier(bar); } } while (0)
    PHASE(PH_PREP, false, phase_prep(F));
    PHASE(PH_HROWS, false, phase_hrows(F));
    PHASE(PH_GEMM_IN, false, { gm::ProbIn p{F.H(), F.WIN(), F.U()}; gm::gemm_phase(F.lds, p, F.G, F.c, F.tid); });
    PHASE(PH_CONV, false, phase_conv(F));
    PHASE(PH_MA, false, {
        mx::ssd_a_phase(F, SST, TOTS);
        mx::hg_a_phase(F, HCT, HLAT, DEC); });
    PHASE(PH_MB, false, { mx::ssd_b(F, SST, TOTS); mx::hg_b(F, HCT, HLAT, DEC); });
    PHASE(PH_MC, false, {
        for (int u = F.c; u < 512; u += F.G) mx::ssd_c_unit(F, SST, u >> 7, (u >> 1) & 63, u & 1);
        mx::hg_c_phase(F, HCT, HLAT); });
    PHASE(PH_GEMM_OUT, false, { gm::ProbOut p{F.Y(), F.WOUT(), F.R()}; gm::gemm_phase(F.lds, p, F.G, F.c, F.tid); });
    PHASE(PH_POST, false, phase_post(F));
    PHASE(PH_TOPK, false, phase_topk(F));
    PHASE(PH_GEMM_GU, false, {
        LAS int* tab = (LAS int*)(F.lds + LDS_TAB_OFF);
        for (int i = 0; i < 8; ++i) { gm::Unit u; if (!gm::unit_at(i, F.G, F.c, gm::ProbGU::nM, gm::ProbGU::nN, u)) break;
            if (F.tid < 256) { const int b = (u.pm >> 2) & 3; tab[i * 256 + F.tid] = b * SEQ + F.IDX()[u.pm * 256 + F.tid]; } }
        __syncthreads();
        gm::ProbGU p{F.H2(), F.WGU(), F.ACT(), F.IDX(), tab}; gm::gemm_phase(F.lds, p, F.G, F.c, F.tid); });
    PHASE(PH_GEMM_DOWN, false, { gm::ProbDown p{F.ACT(), F.WD(), F.YM(), F.GATEV()}; gm::gemm_phase(F.lds, p, F.G, F.c, F.tid); });
    PHASE(PH_COMBINE, true, phase_combine(F));
#undef PHASE
}

extern "C" void kernel_launch(void* const* d_in, const int* in_sizes, int n_in, void* d_out, int out_size, void* d_ws, size_t ws_size, hipStream_t stream) {
    if (ws_size < WS_END || n_in < 21) { fprintf(stderr, "kernel_launch: bad workspace/inputs: ws %zu n_in %d\n", ws_size, n_in); return; }
    static bool attr_set = false;
    if (!attr_set) { (void)hipFuncSetAttribute((const void*)mk_fwd, hipFuncAttributeMaxDynamicSharedMemorySize, LDS_BYTES); attr_set = true; }
    Args a{}; for (int i = 0; i < 21; ++i) a.in[i] = (const float*)d_in[i]; a.out = (float*)d_out; a.ws = (unsigned char*)d_ws;
#if PROBE_PH >= 0
    (void)hipMemsetAsync((char*)d_ws + WS_BAR, 0, WS_CTL_BYTES, stream);
    a.hi = PROBE_PH; hipLaunchKernelGGL(mk_fwd, dim3(256), dim3(512), LDS_BYTES, stream, a);
#endif
    (void)hipMemsetAsync((char*)d_ws + WS_BAR, 0, WS_CTL_BYTES, stream);
    a.hi = PH_COUNT; hipLaunchKernelGGL(mk_fwd, dim3(256), dim3(512), LDS_BYTES, stream, a);
}
```

```cpp
#include <hip/hip_runtime.h>
#include <cstdio>
#include <cstdint>

#define DI __device__ __forceinline__
typedef _Float16 f16;
typedef _Float16 f16x8 __attribute__((ext_vector_type(8)));
typedef _Float16 f16x4 __attribute__((ext_vector_type(4)));
typedef float f32x4 __attribute__((ext_vector_type(4)));

constexpr int DM = 1024, NB = 4, SEQ = 8192, CTXL = 256;
constexpr int MLAT = NB * SEQ;
constexpr int MCTX = NB * CTXL;
constexpr int MTOT = MLAT + MCTX;
constexpr int INCOLS = 4112, NU = 4096;
constexpr int UZ = 0, UXBC = 512, UQ = 1536, UFF = 2048, UFB = 2560, UI = 3072, UG = 3584;
constexpr int NE = 16, FF = 1024, CAP = 1024;
constexpr float EPS = 1e-6f;

constexpr size_t MiB = 1u << 20;
constexpr size_t WS_MOD = 1 * MiB;
constexpr size_t WS_DT = 2 * MiB;
constexpr size_t WS_WDT = 5 * MiB;
constexpr size_t WS_AFF = 6 * MiB;
constexpr size_t WS_IDX = 8 * MiB;
constexpr size_t WS_GATEV = 8 * MiB + 256 * 1024;
constexpr size_t WS_SLOT = 9 * MiB;
constexpr size_t WS_WIN = 12 * MiB;
constexpr size_t WS_WOUT = 20 * MiB;
constexpr size_t WS_WGU = 22 * MiB;
constexpr size_t WS_WD = 86 * MiB;
constexpr size_t WS_H = 118 * MiB;
constexpr size_t WS_U = 184 * MiB;
constexpr size_t WS_Y = 448 * MiB;
constexpr size_t WS_END = 512 * MiB;
constexpr size_t WS_ACT = WS_U;
constexpr size_t WS_YM = WS_U + 128 * MiB;
constexpr size_t WS_R = WS_U;

DI float silu_f(float x) { return x * __builtin_amdgcn_rcpf(1.f + __expf(-x)); }
DI float sigmoid_f(float x) { return __builtin_amdgcn_rcpf(1.f + __expf(-x)); }
DI float softplus_f(float x) { return x > 20.f ? x : log1pf(__expf(x)); }
DI float wave_sum(float v) {
#pragma unroll
    for (int o = 1; o < 64; o <<= 1) v += __shfl_xor(v, o);
    return v;
}


DI float reduce16(const float (&v)[16]) {
    const int lane = threadIdx.x & 63;
    float w8[8], w4[4], w2[2];
    const bool b0 = lane & 1, b1 = lane & 2, b2 = lane & 4, b3 = lane & 8;
#pragma unroll
    for (int i = 0; i < 8; ++i) { const float keep = b0 ? v[2 * i + 1] : v[2 * i], send = b0 ? v[2 * i] : v[2 * i + 1]; w8[i] = keep + __shfl_xor(send, 1); }
#pragma unroll
    for (int i = 0; i < 4; ++i) { const float keep = b1 ? w8[2 * i + 1] : w8[2 * i], send = b1 ? w8[2 * i] : w8[2 * i + 1]; w4[i] = keep + __shfl_xor(send, 2); }
#pragma unroll
    for (int i = 0; i < 2; ++i) { const float keep = b2 ? w4[2 * i + 1] : w4[2 * i], send = b2 ? w4[2 * i] : w4[2 * i + 1]; w2[i] = keep + __shfl_xor(send, 4); }
    float r = (b3 ? w2[1] : w2[0]) + __shfl_xor(b3 ? w2[0] : w2[1], 8);
    r += __shfl_xor(r, 16); r += __shfl_xor(r, 32);
    return r;
}

DI void bar_lds() { asm volatile("s_waitcnt lgkmcnt(0)" ::: "memory"); __builtin_amdgcn_s_barrier(); asm volatile("" ::: "memory"); }
#define LAS __attribute__((address_space(3)))
typedef unsigned u32x4 __attribute__((ext_vector_type(4)));
namespace gm {
constexpr int BM = 256, BK = 64, HALF = 128, HTB = HALF * BK * 2, STAGE_BYTES = 8 * HTB, NXCD = 8, WGM = 8, KD = 1024, NT = KD / BK;
DI int lds_byte(int r, int c) { const int st = (r >> 4) * 2 + (c >> 5), rr = r & 15, cc = c & 31, ob = rr * 64 + cc * 2; return st * 1024 + (ob ^ (((ob >> 9) & 1) << 5)); }
DI void stage_rc(int b, int& R, int& C) { const int st = b / 1024, sb = b % 1024, swz = sb ^ (((sb >> 9) & 1) << 5); R = (st >> 1) * 16 + swz / 64; C = (st & 1) * 32 + (swz % 64) / 2; }
DI int perm32(int rho) { const int n = rho >> 4, i = rho & 15; return 8 * (i >> 2) + 4 * n + (i & 3); }
struct Unit { int pm, pn; };
DI bool unit_at(int i, int G, int c, int nM, int nN, Unit& u) {
    const int nwg = nM * nN; const long L = (long)i * G + c; if (L >= nwg) return false;
    int wgid = (int)L; { const int q = nwg / NXCD, r = nwg % NXCD, xcd = wgid % NXCD, off = wgid / NXCD; wgid = (xcd < r ? xcd * (q + 1) : r * (q + 1) + (xcd - r) * q) + off; }
    const int nig = WGM * nN, gid = wgid / nig, fm = gid * WGM, gsz = (nM - fm) < WGM ? (nM - fm) : WGM;
    u.pm = fm + ((wgid % nig) % gsz); u.pn = (wgid % nig) / gsz; return true;
}
typedef f32x4 Acc[2][2][4][2];
DI unsigned pack2(float a, float b) { typedef _Float16 h2 __attribute__((ext_vector_type(2))); h2 v; v.x = (f16)a; v.y = (f16)b; return __builtin_bit_cast(unsigned, v); }

template <class P>
DI void gemm_phase(LAS unsigned char* lds, const P& p, int G, int c, int tid) {
    const int wid = __builtin_amdgcn_readfirstlane(tid >> 6), lane = tid & 63, wr = wid >> 2, wc = wid & 3, fr = lane & 15, fq = lane >> 4;
    constexpr int K = KD, nt = NT;
    int Rr[2], Cc[2]; unsigned voffB[2];
#pragma unroll
    for (int i = 0; i < 2; ++i) { stage_rc(tid * 16 + i * 8192, Rr[i], Cc[i]); const int Rb = P::PERM ? ((Rr[i] & ~31) + perm32(Rr[i] & 31)) : Rr[i]; voffB[i] = (unsigned)(Rb * K + Cc[i]) * 2u; }
    const size_t kstep = (size_t)(BK * 2);
    const size_t hstep = (size_t)HALF * K * 2;
    const unsigned ldsw = (unsigned)wid * 1024u;
    const int aoff = lds_byte(wr * 64 + fr, fq * 8), boff = lds_byte(wc * 32 + fr, fq * 8);
#define G_SA(b, h) (((b) * 2 + (h)) * HTB)
#define G_SB(b, h) ((4 + (b) * 2 + (h)) * HTB)
#define G_STAGEB(bufoff, gbase) do { _Pragma("unroll") for (int _i = 0; _i < 2; ++_i) \
        __builtin_amdgcn_global_load_lds((const unsigned*)((const char*)(gbase) + voffB[_i]), (LAS unsigned*)(lds + (bufoff) + ldsw + _i * 8192), 16, 0, 0); } while (0)
#define G_STAGEA(bufoff, offs, h, koff) do { _Pragma("unroll") for (int _i = 0; _i < 2; ++_i) \
        __builtin_amdgcn_global_load_lds((const unsigned*)(gA + (offs)[h][_i] + (koff)), (LAS unsigned*)(lds + (bufoff) + ldsw + _i * 8192), 16, 0, 0); } while (0)
#define G_LDA(dst, b, h) do { _Pragma("unroll") for (int m = 0; m < 4; ++m) _Pragma("unroll") for (int k = 0; k < 2; ++k) dst[m][k] = *(const LAS f16x8*)(lds + G_SA(b, h) + aoff + m * 2048 + k * 1024); } while (0)
#define G_LDB(dst, b, h) do { _Pragma("unroll") for (int n = 0; n < 2; ++n) _Pragma("unroll") for (int k = 0; k < 2; ++k) dst[n][k] = *(const LAS f16x8*)(lds + G_SB(b, h) + boff + n * 2048 + k * 1024); } while (0)
#define G_MMA(ai, bj, At, Bt) do { __builtin_amdgcn_s_setprio(1); _Pragma("unroll") for (int m = 0; m < 4; ++m) _Pragma("unroll") for (int n = 0; n < 2; ++n) _Pragma("unroll") for (int k = 0; k < 2; ++k) \
        acc[ai][bj][m][n] = __builtin_amdgcn_mfma_f32_16x16x32_f16(Bt[n][k], At[m][k], acc[ai][bj][m][n], 0, 0, 0); __builtin_amdgcn_s_setprio(0); } while (0)
#define G_WAIT_V(n) asm volatile("s_waitcnt vmcnt(" #n ")" ::: "memory")
#define G_WAIT_L(n) asm volatile("s_waitcnt lgkmcnt(" #n ")" ::: "memory")
#define G_BAR __builtin_amdgcn_s_barrier()
#define G_SCHED __builtin_amdgcn_sched_barrier(0)
    Unit cur, nxt; int ui = 0;
    if (!unit_at(0, G, c, P::nM, P::nN, cur)) return;
    Acc acc;
#pragma unroll
    for (int a = 0; a < 2; ++a)
#pragma unroll
        for (int b = 0; b < 2; ++b)
#pragma unroll
            for (int m = 0; m < 4; ++m)
#pragma unroll
                for (int n = 0; n < 2; ++n) acc[a][b][m][n] = (f32x4){0.f, 0.f, 0.f, 0.f};
    f16x8 At[4][2], B0[2][2], B1[2][2];
    const char* gA = (const char*)p.A;
    unsigned offC[2][2], offN[2][2];
#pragma unroll
    for (int h = 0; h < 2; ++h)
#pragma unroll
        for (int i = 0; i < 2; ++i) offC[h][i] = p.arow(0, cur, 128 * h + Rr[i]) * (unsigned)(K * 2) + (unsigned)Cc[i] * 2u;
    const char* cB = p.bptr(cur);
    G_STAGEB(G_SB(0, 0), cB); G_STAGEA(G_SA(0, 0), offC, 0, 0); G_STAGEB(G_SB(0, 1), cB + hstep); G_STAGEA(G_SA(0, 1), offC, 1, 0);
    if (wr == 1) G_BAR;
    G_WAIT_V(4); G_BAR;
    G_STAGEB(G_SB(1, 0), cB + kstep); G_STAGEA(G_SA(1, 0), offC, 0, kstep); G_STAGEB(G_SB(1, 1), cB + hstep + kstep);
    G_WAIT_V(6); G_BAR;
    for (;;) {
        const bool has_next = unit_at(ui + 1, G, c, P::nM, P::nN, nxt);
        const char* nB = has_next ? p.bptr(nxt) : cB;
#pragma unroll
        for (int h = 0; h < 2; ++h)
#pragma unroll
            for (int i = 0; i < 2; ++i) offN[h][i] = has_next ? p.arow(ui + 1, nxt, 128 * h + Rr[i]) * (unsigned)(K * 2) + (unsigned)Cc[i] * 2u : offC[h][i];
        for (int t = 0; t < nt; t += 2) {
            const bool last = (t == nt - 2);
            const size_t k1 = (size_t)(t + 1) * kstep;
            const size_t k2 = last ? 0 : (size_t)(t + 2) * kstep, k3 = k2 + kstep;
            const char* b2 = last ? nB : cB + (size_t)(t + 2) * kstep; const char* b3 = b2 + kstep;
            unsigned o2[2][2];
#pragma unroll
            for (int h = 0; h < 2; ++h)
#pragma unroll
                for (int i = 0; i < 2; ++i) o2[h][i] = last ? offN[h][i] : offC[h][i];
            G_LDB(B0, 0, 0); G_SCHED; G_LDA(At, 0, 0); G_STAGEA(G_SA(1, 1), offC, 1, k1);
            G_WAIT_L(8); G_BAR; G_WAIT_L(0); G_MMA(0, 0, At, B0); G_BAR; G_SCHED;
            G_LDB(B1, 0, 1); G_STAGEB(G_SB(0, 0), b2);
            G_BAR; G_WAIT_L(0); G_MMA(0, 1, At, B1); G_BAR;
            G_LDA(At, 0, 1); G_STAGEA(G_SA(0, 0), o2, 0, k2);
            G_BAR; G_WAIT_L(0); G_MMA(1, 0, At, B0); G_BAR; G_SCHED;
            G_STAGEB(G_SB(0, 1), b2 + hstep);
            G_WAIT_V(6); G_BAR; G_MMA(1, 1, At, B1); G_BAR;
            G_LDB(B0, 1, 0); G_SCHED; G_LDA(At, 1, 0); G_STAGEA(G_SA(0, 1), o2, 1, k2);
            G_WAIT_L(8); G_BAR; G_WAIT_L(0); G_MMA(0, 0, At, B0); G_BAR; G_SCHED;
            G_LDB(B1, 1, 1); G_STAGEB(G_SB(1, 0), b3);
            G_BAR; G_WAIT_L(0); G_MMA(0, 1, At, B1); G_BAR;
            G_LDA(At, 1, 1); G_STAGEA(G_SA(1, 0), o2, 0, k3);
            G_BAR; G_WAIT_L(0); G_MMA(1, 0, At, B0); G_BAR; G_SCHED;
            G_STAGEB(G_SB(1, 1), b3 + hstep);
            G_WAIT_V(6); G_BAR; G_MMA(1, 1, At, B1); G_BAR;
        }
        p.epi(acc, cur, wr, wc, fr, fq);
        if (!has_next) break;
#pragma unroll
        for (int a = 0; a < 2; ++a)
#pragma unroll
            for (int b = 0; b < 2; ++b)
#pragma unroll
                for (int m = 0; m < 4; ++m)
#pragma unroll
                    for (int n = 0; n < 2; ++n) acc[a][b][m][n] = (f32x4){0.f, 0.f, 0.f, 0.f};
        cur = nxt; cB = nB; ++ui;
#pragma unroll
        for (int h = 0; h < 2; ++h)
#pragma unroll
            for (int i = 0; i < 2; ++i) offC[h][i] = offN[h][i];
    }
    G_WAIT_V(0);
    if (wr == 0) G_BAR;
    G_BAR;
#undef G_SA
#undef G_SB
#undef G_STAGEA
#undef G_STAGEB
#undef G_LDA
#undef G_LDB
#undef G_MMA
#undef G_WAIT_V
#undef G_WAIT_L
#undef G_BAR
#undef G_SCHED
}

struct ProbIn {
    static constexpr int nM = MTOT / 256, nN = NU / 256; static constexpr bool PERM = true;
    const f16* A; const f16* BT; f16* U;
    DI unsigned arow(int, const Unit& u, int r) const { return (unsigned)(u.pm * 256 + r); }
    DI const char* bptr(const Unit& u) const { return (const char*)(BT + (size_t)u.pn * 256 * KD); }
    DI void epi(const Acc& acc, const Unit& u, int wr, int wc, int fr, int fq) const {
        const int row0 = u.pm * BM + wr * 64 + fr, col0 = u.pn * BM + wc * 32 + 8 * fq;
#pragma unroll
        for (int ai = 0; ai < 2; ++ai)
#pragma unroll
            for (int m = 0; m < 4; ++m) { f16* rowp = U + (size_t)(row0 + ai * HALF + m * 16) * NU + col0;
#pragma unroll
                for (int bj = 0; bj < 2; ++bj) { const f32x4 v0 = acc[ai][bj][m][0], v1 = acc[ai][bj][m][1];
                    u32x4 w; w.x = pack2(v0[0], v0[1]); w.y = pack2(v0[2], v0[3]); w.z = pack2(v1[0], v1[1]); w.w = pack2(v1[2], v1[3]);
                    *(u32x4*)(rowp + bj * HALF) = w; } }
    }
};
struct ProbOut {
    static constexpr int nM = MLAT / 256, nN = DM / 256; static constexpr bool PERM = true;
    const f16* A; const f16* BT; f16* R;
    DI unsigned arow(int, const Unit& u, int r) const { return (unsigned)(u.pm * 256 + r); }
    DI const char* bptr(const Unit& u) const { return (const char*)(BT + (size_t)u.pn * 256 * KD); }
    DI void epi(const Acc& acc, const Unit& u, int wr, int wc, int fr, int fq) const {
        const int row0 = u.pm * BM + wr * 64 + fr, col0 = u.pn * BM + wc * 32 + 8 * fq;
#pragma unroll
        for (int ai = 0; ai < 2; ++ai)
#pragma unroll
            for (int m = 0; m < 4; ++m) { f16* rowp = R + (size_t)(row0 + ai * HALF + m * 16) * DM + col0;
#pragma unroll
                for (int bj = 0; bj < 2; ++bj) { const f32x4 v0 = acc[ai][bj][m][0], v1 = acc[ai][bj][m][1];
                    u32x4 w; w.x = pack2(v0[0], v0[1]); w.y = pack2(v0[2], v0[3]); w.z = pack2(v1[0], v1[1]); w.w = pack2(v1[2], v1[3]);
                    *(u32x4*)(rowp + bj * HALF) = w; } }
    }
};
struct ProbGU {
    static constexpr int nM = (NE * NB * CAP) / 256, nN = 2048 / 256; static constexpr bool PERM = true;
    const f16* A; const f16* BT; f16* ACT; const int* IDX; const LAS int* tab;
    DI unsigned arow(int ui, const Unit& u, int r) const { return (unsigned)tab[ui * 256 + r]; }
    DI const char* bptr(const Unit& u) const { return (const char*)(BT + ((size_t)(u.pm >> 4) * 2048 + (size_t)u.pn * 256) * KD); }
    DI void epi(const Acc& acc, const Unit& u, int wr, int wc, int fr, int fq) const {
        const int row0 = u.pm * BM + wr * 64 + fr, col0 = u.pn * 128 + wc * 32 + 8 * fq;
#pragma unroll
        for (int ai = 0; ai < 2; ++ai)
#pragma unroll
            for (int m = 0; m < 4; ++m) { f16* rowp = ACT + (size_t)(row0 + ai * HALF + m * 16) * FF + col0;
                const f32x4 g0 = acc[ai][0][m][0], g1 = acc[ai][0][m][1], u0 = acc[ai][1][m][0], u1 = acc[ai][1][m][1];
                u32x4 w; w.x = pack2(silu_f(g0[0]) * u0[0], silu_f(g0[1]) * u0[1]); w.y = pack2(silu_f(g0[2]) * u0[2], silu_f(g0[3]) * u0[3]);
                w.z = pack2(silu_f(g1[0]) * u1[0], silu_f(g1[1]) * u1[1]); w.w = pack2(silu_f(g1[2]) * u1[2], silu_f(g1[3]) * u1[3]);
                *(u32x4*)rowp = w; }
    }
};
struct ProbDown {
    static constexpr int nM = (NE * NB * CAP) / 256, nN = DM / 256; static constexpr bool PERM = true;
    const f16* A; const f16* BT; f16* YM; const float* GV;
    DI unsigned arow(int, const Unit& u, int r) const { return (unsigned)(u.pm * 256 + r); }
    DI const char* bptr(const Unit& u) const { return (const char*)(BT + ((size_t)(u.pm >> 4) * 1024 + (size_t)u.pn * 256) * KD); }
    DI void epi(const Acc& acc, const Unit& u, int wr, int wc, int fr, int fq) const {
        const int row0 = u.pm * BM + wr * 64 + fr, col0 = u.pn * BM + wc * 32 + 8 * fq;
#pragma unroll
        for (int ai = 0; ai < 2; ++ai)
#pragma unroll
            for (int m = 0; m < 4; ++m) { const int row = row0 + ai * HALF + m * 16; const float g = GV[row]; f16* rowp = YM + (size_t)row * DM + col0;
#pragma unroll
                for (int bj = 0; bj < 2; ++bj) { const f32x4 v0 = acc[ai][bj][m][0] * g, v1 = acc[ai][bj][m][1] * g;
                    u32x4 w; w.x = pack2(v0[0], v0[1]); w.y = pack2(v0[2], v0[3]); w.z = pack2(v1[0], v1[1]); w.w = pack2(v1[2], v1[3]);
                    *(u32x4*)(rowp + bj * HALF) = w; } }
    }
};
}

#define XB_TMO      128
#define XB_XCNT(j)  (256  + 64 * (j))
#define XB_XSUB(j)  (1280 + 64 * (j))
#define XB_XGEN(j)  (2304 + 64 * (j))
#define XB_TOP      3328
#define XB_TOPGEN   3392
#define XCD_BAR_WORDS 3456
#define XB_SPIN_CAP (1u << 22)
DI unsigned xb_ld(unsigned* p)              { return __hip_atomic_load(p, __ATOMIC_RELAXED, __HIP_MEMORY_SCOPE_AGENT); }
DI unsigned xb_add(unsigned* p, unsigned v) { return __hip_atomic_fetch_add(p, v, __ATOMIC_RELAXED, __HIP_MEMORY_SCOPE_AGENT); }
DI unsigned xb_xcc_id() { return (unsigned)__builtin_amdgcn_s_getreg((3 << 11) | 20) & 0xFu; }
#define XB_SPIN(cond, bar) do { unsigned _sp = 0; while (cond) { __builtin_amdgcn_s_sleep(1); \
    if ((++_sp & 255u) == 0u) { if (xb_ld(&(bar)[XB_TMO])) break; if (_sp > XB_SPIN_CAP) { atomicAdd(&(bar)[XB_TMO], 1u); break; } } } } while (0)
struct XcdBarrier { unsigned* bar; unsigned x; volatile LAS unsigned* st; };
DI XcdBarrier xcd_barrier_post(unsigned* bar, volatile LAS unsigned* st) {
    XcdBarrier b; b.bar = bar; b.x = xb_xcc_id(); b.st = st;
    if (threadIdx.x == 0) (void)xb_add(&bar[XB_XCNT(b.x)], 1u);
    return b;
}
DI void xcd_barrier_complete(unsigned* bar, unsigned x, unsigned& nloc, unsigned& nx) {
    const unsigned G = gridDim.x * gridDim.y * gridDim.z;
    unsigned sum, cnt, mine, sp = 0u;
    for (;;) {
        sum = 0u; cnt = 0u; mine = 0u;
#pragma unroll
        for (unsigned j = 0; j < 16; ++j) { const unsigned c = xb_ld(&bar[XB_XCNT(j)]); sum += c; cnt += (c > 0u) ? 1u : 0u; mine = (j == x) ? c : mine; }
        if (sum == G) break;
        __builtin_amdgcn_s_sleep(1);
        if ((++sp & 255u) == 0u) { if (xb_ld(&bar[XB_TMO])) break; if (sp > XB_SPIN_CAP) { atomicAdd(&bar[XB_TMO], 1u); break; } }
    }
    nloc = mine > 0u ? mine : 1u; nx = cnt > 0u ? cnt : 1u;
}
DI void xcd_barrier(const XcdBarrier& b) {
    asm volatile("s_waitcnt vmcnt(0)" ::: "memory");
    __syncthreads();
    if (threadIdx.x == 0) {
        unsigned* bar = b.bar;
        __builtin_amdgcn_s_waitcnt(0);
        unsigned nloc = b.st[0], nx = b.st[1];
        if (nloc == 0u) { xcd_barrier_complete(bar, b.x, nloc, nx); b.st[0] = nloc; b.st[1] = nx; }
        const unsigned old = xb_add(&bar[XB_XSUB(b.x)], 1u);
        const unsigned gen = old / nloc;
        if (old + 1u == (gen + 1u) * nloc) {
            __builtin_amdgcn_fence(__ATOMIC_RELEASE, "agent");
            asm volatile("s_waitcnt vmcnt(0)" ::: "memory");
            const unsigned og = xb_add(&bar[XB_TOP], 1u);
            const unsigned tg = og / nx;
            if (og + 1u == (tg + 1u) * nx) xb_add(&bar[XB_TOPGEN], 1u);
            else XB_SPIN(xb_ld(&bar[XB_TOPGEN]) == tg, bar);
            __builtin_amdgcn_fence(__ATOMIC_ACQUIRE, "agent");
            xb_add(&bar[XB_XGEN(b.x)], 1u);
            asm volatile("s_waitcnt vmcnt(0)" ::: "memory");
        } else {
            XB_SPIN(xb_ld(&bar[XB_XGEN(b.x)]) == gen, bar);
            __builtin_amdgcn_fence(__ATOMIC_ACQUIRE, "agent");
            asm volatile("s_waitcnt vmcnt(0)" ::: "memory");
        }
    }
    __syncthreads();
}

constexpr int LDS_TAB_OFF = 131072;
constexpr int LDS_MISC_OFF = 163840 - 256;
constexpr int LDS_BYTES = 163840;
constexpr size_t WS_BAR = 0;
constexpr size_t WS_CTL_BYTES = 65536;
struct Args { const float* in[21]; float* out; unsigned char* ws; int hi; int pad; };
enum { PH_PREP = 0, PH_HROWS, PH_GEMM_IN, PH_CONV, PH_MA, PH_MB, PH_MC, PH_GEMM_OUT, PH_POST, PH_TOPK, PH_GEMM_GU, PH_GEMM_DOWN, PH_COMBINE, PH_COUNT };

struct Ctx {
    LAS unsigned char* lds; int tid, lane, wave, G, c;
    const float *x, *cvec, *ctx, *c_ctx, *ada_w, *ada_b, *norm_w, *w_in, *conv_w, *conv_b, *dt_bias, *a_log, *ssd_d, *ssd_nw, *hgrn_lb, *hgrn_nw, *w_out, *w_router, *w_gate, *w_up, *w_down;
    float* out; unsigned char* ws;
    DI float* MOD() const { return (float*)(ws + WS_MOD); }   DI float* DT() const { return (float*)(ws + WS_DT); }   DI float* WDT() const { return (float*)(ws + WS_WDT); }
    DI float* AFF() const { return (float*)(ws + WS_AFF); }   DI float* GATEV() const { return (float*)(ws + WS_GATEV); }   DI f16* R() const { return (f16*)(ws + WS_R); }
    DI f16* XLAT() const { return (f16*)(ws + WS_Y); }   DI int* IDX() const { return (int*)(ws + WS_IDX); }   DI int* SLOT() const { return (int*)(ws + WS_SLOT); }
    DI f16* WIN() const { return (f16*)(ws + WS_WIN); }   DI f16* WOUT() const { return (f16*)(ws + WS_WOUT); }   DI f16* WGU() const { return (f16*)(ws + WS_WGU); }   DI f16* WD() const { return (f16*)(ws + WS_WD); }
    DI f16* H() const { return (f16*)(ws + WS_H); }   DI f16* H2() const { return (f16*)(ws + WS_H); }   DI f16* U() const { return (f16*)(ws + WS_U); }   DI f16* Y() const { return (f16*)(ws + WS_Y); }
    DI f16* ACT() const { return (f16*)(ws + WS_ACT); }   DI f16* YM() const { return (f16*)(ws + WS_YM); }
};

struct TrItem { const float* src; int ld, col0, k0; f16* dst; int ldd; };
DI void tr_load(const TrItem& t, int lane, f32x4 (&v)[8]) {
#pragma unroll
    for (int i = 0; i < 8; ++i) v[i] = *(const f32x4*)(t.src + (size_t)(t.k0 + 8 * i + (lane >> 3)) * t.ld + t.col0 + 4 * (lane & 7));
}
DI void tr_store(const TrItem& t, int lane, const f32x4 (&v)[8], LAS float* scr) {
#pragma unroll
    for (int i = 0; i < 8; ++i) { LAS float* p = scr + (8 * i + (lane >> 3)) * 33 + 4 * (lane & 7); p[0] = v[i].x; p[1] = v[i].y; p[2] = v[i].z; p[3] = v[i].w; }
    asm volatile("s_waitcnt lgkmcnt(0)" ::: "memory");
    const int cc = lane & 7;
#pragma unroll
    for (int j = 0; j < 4; ++j) { const int n = (lane >> 3) + 8 * j; const LAS float* s = scr + (8 * cc) * 33 + n;
        u32x4 o; o.x = gm::pack2(s[0 * 33], s[1 * 33]); o.y = gm::pack2(s[2 * 33], s[3 * 33]); o.z = gm::pack2(s[4 * 33], s[5 * 33]); o.w = gm::pack2(s[6 * 33], s[7 * 33]);
        *(u32x4*)(t.dst + (size_t)n * t.ldd + t.k0 + 8 * cc) = o; }
    asm volatile("s_waitcnt lgkmcnt(0)" ::: "memory");
}
DI void tr_item(const float* src, int ld, int col0, int k0, f16* dst_row0, int ldd, LAS float* scr, int lane) {
    const TrItem t{src, ld, col0, k0, dst_row0, ldd}; f32x4 v[8]; tr_load(t, lane, v); tr_store(t, lane, v, scr);
}
DI void phase_prep(const Ctx& F) {
    {
        LAS float* sv = (LAS float*)F.lds;
        LAS float* red = sv + 5 * DM;
        for (int i = F.tid; i < 5 * DM; i += 512) { const int r = i >> 10, k = i & 1023; sv[i] = silu_f(r < 4 ? F.cvec[r * DM + k] : F.c_ctx[k]); }
        __syncthreads();
        const int col = F.tid % 24, kg = F.tid / 24, j = F.c * 24 + col;
        if (kg < 21) {
            float a[5] = {0, 0, 0, 0, 0};
            for (int k = kg; k < DM; k += 21) { const float w = F.ada_w[(size_t)k * 6144 + j];
#pragma unroll
                for (int r = 0; r < 5; ++r) a[r] += sv[r * DM + k] * w; }
#pragma unroll
            for (int r = 0; r < 5; ++r) red[(kg * 24 + col) * 5 + r] = a[r];
        }
        __syncthreads();
        if (F.tid < 120) { const int cl = F.tid % 24, r = F.tid / 24; float s = 0.f; for (int g = 0; g < 21; ++g) s += red[(g * 24 + cl) * 5 + r]; const int jj = F.c * 24 + cl; F.MOD()[r * 6144 + jj] = s + F.ada_b[jj]; }
        __syncthreads();
    }
    for (int i = F.c * 512 + F.tid; i < 16 * DM; i += F.G * 512) { const int j = i >> 10, k = i & 1023; F.WDT()[i] = F.w_in[(size_t)k * INCOLS + 1536 + j]; }
    LAS float* scr = (LAS float*)(F.lds + F.wave * 8704);
    const int gw = F.c * 8 + F.wave, NGW = F.G * 8;
    constexpr int I_IN = 16 * 128, I_OUT = 16 * 32;
    for (int it = gw; it < I_IN + I_OUT; it += NGW) {
        int r = it;
        if (r < I_IN) { const int kb = r / 128, nb = r % 128, n0 = nb * 32; tr_item(F.w_in, INCOLS, n0 < 1536 ? n0 : n0 + 16, kb * 64, F.WIN() + (size_t)n0 * DM, DM, scr, F.lane); continue; } r -= I_IN;
        { const int kb = r / 32, nb = r % 32; tr_item(F.w_out, DM, nb * 32, kb * 64, F.WOUT() + (size_t)nb * 32 * DM, DM, scr, F.lane); }
    }
}
constexpr int MOE_ITEMS = 16 * 16 * 64 + 16 * 16 * 32, MOE_IDLE_WG0 = 64, MOE_SPLIT = 12288;
DI TrItem moe_item(const Ctx& F, int r) {
    constexpr int I_GU = 16 * 16 * 64;
    if (r < I_GU) { const int e = r / 1024, q = r % 1024, kb = q / 64, nb = q % 64, r0 = nb * 32, blk = r0 >> 7, within = r0 & 127, isu = blk & 1, f0 = (blk >> 1) * 128 + within;
        return TrItem{(isu ? F.w_up : F.w_gate) + (size_t)e * DM * FF, FF, f0, kb * 64, F.WGU() + ((size_t)e * 2048 + r0) * DM, DM}; }
    r -= I_GU;
    const int e = r / 512, q = r % 512, kb = q / 32, nb = q % 32;
    return TrItem{F.w_down + (size_t)e * FF * DM, DM, nb * 32, kb * 64, F.WD() + ((size_t)e * DM + nb * 32) * FF, FF};
}
DI void moe_convert(const Ctx& F, int it0, int it1) {
    if (F.c < MOE_IDLE_WG0) return;
    LAS float* scr = (LAS float*)(F.lds + F.wave * 8704);
    const int gw = (F.c - MOE_IDLE_WG0) * 8 + F.wave, NGW = (F.G - MOE_IDLE_WG0) * 8;
    for (int it = it0 + gw; it < it1; it += 2 * NGW) {
        const TrItem t0 = moe_item(F, it); f32x4 v0[8], v1[8]; tr_load(t0, F.lane, v0);
        const bool two = it + NGW < it1;
        const TrItem t1 = moe_item(F, two ? it + NGW : it);
        if (two) tr_load(t1, F.lane, v1);
        tr_store(t0, F.lane, v0, scr);
        if (two) tr_store(t1, F.lane, v1, scr);
    }
}

DI void phase_hrows(const Ctx& F) {
    LAS float* wdt = (LAS float*)F.lds;
    for (int i = F.tid; i < 16 * DM / 4; i += 512) *(LAS f32x4*)(wdt + 4 * i) = *(const f32x4*)(F.WDT() + 4 * i);
    LAS float* NW0 = wdt + 16 * DM; LAS float* SH1 = NW0 + DM; LAS float* SC1 = SH1 + 5 * DM;
    for (int i = F.tid; i < DM; i += 512) NW0[i] = F.norm_w[i];
    for (int i = F.tid; i < 5 * DM; i += 512) { const int r = i >> 10, k = i & 1023; SH1[i] = F.MOD()[r * 6144 + k]; SC1[i] = F.MOD()[r * 6144 + 1024 + k]; }
    asm volatile("s_waitcnt vmcnt(0)" ::: "memory");
    __syncthreads();
    const int gw = F.c * 8 + F.wave, NGW = F.G * 8, lane = F.lane;
#define HR_LOAD(XX, rw) do { if ((rw) < MTOT) { const float* xr = (rw) < MLAT ? F.x + (size_t)(rw) * DM : F.ctx + (size_t)((rw) - MLAT) * DM; \
        _Pragma("unroll") for (int j = 0; j < 4; ++j) XX[j] = *(const f32x4*)(xr + 4 * lane + 256 * j); } } while (0)
#define HR_ROW(XX, row) do { \
        const int r = (row) < MLAT ? (row) / SEQ : 4; \
        f32x4 v[4]; float ss = 0.f; \
        _Pragma("unroll") for (int j = 0; j < 4; ++j) { v[j] = XX[j]; ss += v[j].x * v[j].x + v[j].y * v[j].y + v[j].z * v[j].z + v[j].w * v[j].w; } \
        HR_LOAD(XX, (row) + 2 * NGW); \
        const float rstd = rsqrtf(wave_sum(ss) * (1.f / DM) + EPS); \
        _Pragma("unroll") for (int j = 0; j < 4; ++j) { const int k = 4 * lane + 256 * j; \
            const f32x4 nw = *(const LAS f32x4*)(NW0 + k), sc = *(const LAS f32x4*)(SC1 + r * DM + k), sh = *(const LAS f32x4*)(SH1 + r * DM + k); \
            v[j] = v[j] * rstd * nw * (1.f + sc) + sh; \
            f16x4 o; o.x = (f16)v[j].x; o.y = (f16)v[j].y; o.z = (f16)v[j].z; o.w = (f16)v[j].w; \
            *(f16x4*)(F.H() + (size_t)(row) * DM + k) = o; } \
        float pd[16]; \
        _Pragma("unroll") for (int d = 0; d < 16; ++d) { float p = 0.f; \
            _Pragma("unroll") for (int j = 0; j < 4; ++j) { const f32x4 w = *(const LAS f32x4*)(wdt + d * DM + 4 * lane + 256 * j); p += v[j].x * w.x + v[j].y * w.y + v[j].z * w.z + v[j].w * w.w; } \
            pd[d] = p; if ((d & 3) == 3) __builtin_amdgcn_sched_barrier(0); } \
        const float tot = reduce16(pd); \
        if (lane < 16) F.DT()[(size_t)(row) * 16 + lane] = tot; } while (0)
    {
        f32x4 xA[4], xB[4];
        HR_LOAD(xA, gw); HR_LOAD(xB, gw + NGW);
        for (int row = gw; row < MTOT; row += 2 * NGW) { HR_ROW(xA, row); if (row + NGW < MTOT) HR_ROW(xB, row + NGW); }
    }
#undef HR_LOAD
#undef HR_ROW
    __syncthreads();
}

DI void phase_conv(const Ctx& F) {
    const int tid = F.tid, cg = tid & 15, tg = tid >> 4, s0 = 8 * tg;
    for (int u = F.c; u < (MTOT / 256) * 8; u += F.G) {
        const int rb = u >> 3, cb8 = u & 7, row0 = rb * 256, cc = cb8 * 128 + cg * 8;
        int seglo, seghi;
        if (rb < MLAT / 256) { seglo = s0 & ~63; seghi = seglo + 64; } else { seglo = 0; seghi = 256; }
        f16* base = F.U() + (size_t)row0 * NU + UXBC + cc;
        f16x8 raw[12];
#pragma unroll
        for (int i = 0; i < 12; ++i) { const int s = s0 - 2 + i; const bool ok = s >= seglo && s < seghi;
            if (ok) raw[i] = *(const f16x8*)(base + (size_t)s * NU); else raw[i] = (f16x8){0, 0, 0, 0, 0, 0, 0, 0}; }
        float w[5][8], bb[8];
        { const f32x4 b0 = *(const f32x4*)(F.conv_b + cc), b1 = *(const f32x4*)(F.conv_b + cc + 4);
#pragma unroll
          for (int j = 0; j < 4; ++j) { bb[j] = b0[j]; bb[4 + j] = b1[j]; } }
#pragma unroll
        for (int tp = 0; tp < 5; ++tp) { const f32x4 w0 = *(const f32x4*)(F.conv_w + tp * 1024 + cc), w1 = *(const f32x4*)(F.conv_w + tp * 1024 + cc + 4);
#pragma unroll
            for (int j = 0; j < 4; ++j) { w[tp][j] = w0[j]; w[tp][4 + j] = w1[j]; } }
        f16x8 o[8];
#pragma unroll
        for (int t = 0; t < 8; ++t)
#pragma unroll
            for (int j = 0; j < 8; ++j) { float a = bb[j];
#pragma unroll
                for (int tp = 0; tp < 5; ++tp) a += w[tp][j] * (float)raw[t + tp][j];
                o[t][j] = (f16)silu_f(a); }
        asm volatile("s_waitcnt vmcnt(0)" ::: "memory");
        __syncthreads();
#pragma unroll
        for (int t = 0; t < 8; ++t) *(f16x8*)(base + (size_t)(s0 + t) * NU) = o[t];
    }
}

DI void phase_post(const Ctx& F) {
    LAS f16* wr16 = (LAS f16*)F.lds;
    for (int i = F.tid; i < DM * 16; i += 512) wr16[(i & 15) * DM + (i >> 4)] = (f16)F.w_router[i];
    LAS float* NW1 = (LAS float*)(F.lds + 32768); LAS float* NW2 = NW1 + DM; LAS float* G1 = NW2 + DM; LAS float* SH2 = G1 + 4 * DM; LAS float* SC2 = SH2 + 4 * DM;
    for (int i = F.tid; i < DM; i += 512) { NW1[i] = F.norm_w[1024 + i]; NW2[i] = F.norm_w[2048 + i]; }
    for (int i = F.tid; i < 4 * DM; i += 512) { const int b = i >> 10, k = i & 1023; G1[i] = F.MOD()[b * 6144 + 2048 + k]; SH2[i] = F.MOD()[b * 6144 + 3072 + k]; SC2[i] = F.MOD()[b * 6144 + 4096 + k]; }
    asm volatile("s_waitcnt vmcnt(0)" ::: "memory");
    __syncthreads();
    const int lane = F.lane, gw = F.c * 8 + F.wave, NGW = F.G * 8;
#define POST_LOAD(RR, XX, rw) do { if ((rw) < MLAT) { _Pragma("unroll") for (int j = 0; j < 4; ++j) { RR[j] = *(const f16x4*)(F.R() + (size_t)(rw) * DM + 4 * lane + 256 * j); XX[j] = *(const f32x4*)(F.x + (size_t)(rw) * DM + 4 * lane + 256 * j); } } } while (0)
#define POST_ROW(RR, XX, row) do { \
        const int b = (row) / SEQ; \
        int lo = 4 * lane; asm volatile("" : "+v"(lo)); \
        f32x4 r[4], xl[4]; float ss = 0.f; \
        _Pragma("unroll") for (int j = 0; j < 4; ++j) { const f16x4 rh = RR[j]; r[j] = (f32x4){(float)rh.x, (float)rh.y, (float)rh.z, (float)rh.w}; xl[j] = XX[j]; ss += r[j].x * r[j].x + r[j].y * r[j].y + r[j].z * r[j].z + r[j].w * r[j].w; } \
        POST_LOAD(RR, XX, (row) + 2 * NGW); \
        const float rstd = rsqrtf(wave_sum(ss) * (1.f / DM) + EPS); \
        float s2 = 0.f; \
        _Pragma("unroll") for (int j = 0; j < 4; ++j) { const int k = lo + 256 * j; \
            const f32x4 nw = *(const LAS f32x4*)(NW1 + k), gt = *(const LAS f32x4*)(G1 + b * DM + k); \
            xl[j] = xl[j] + gt * (r[j] * rstd * nw); \
            { f16x4 o; o.x = (f16)xl[j].x; o.y = (f16)xl[j].y; o.z = (f16)xl[j].z; o.w = (f16)xl[j].w; *(f16x4*)(F.XLAT() + (size_t)(row) * DM + k) = o; } \
            s2 += xl[j].x * xl[j].x + xl[j].y * xl[j].y + xl[j].z * xl[j].z + xl[j].w * xl[j].w; } \
        const float rstd2 = rsqrtf(wave_sum(s2) * (1.f / DM) + EPS); \
        _Pragma("unroll") for (int j = 0; j < 4; ++j) { const int k = lo + 256 * j; \
            const f32x4 nw = *(const LAS f32x4*)(NW2 + k), sh = *(const LAS f32x4*)(SH2 + b * DM + k), sc = *(const LAS f32x4*)(SC2 + b * DM + k); \
            const f32x4 hv = xl[j] * rstd2 * nw * (1.f + sc) + sh; \
            f16x4 o; o.x = (f16)hv.x; o.y = (f16)hv.y; o.z = (f16)hv.z; o.w = (f16)hv.w; \
            *(f16x4*)(F.H2() + (size_t)(row) * DM + k) = o; } } while (0)
    {
        f16x4 rA[4], rB[4]; f32x4 xA[4], xB[4];
        POST_LOAD(rA, xA, gw); POST_LOAD(rB, xB, gw + NGW);
        for (int row = gw; row < MLAT; row += 2 * NGW) { POST_ROW(rA, xA, row); if (row + NGW < MLAT) POST_ROW(rB, xB, row + NGW); }
    }
#undef POST_LOAD
#undef POST_ROW
    asm volatile("s_waitcnt vmcnt(0)" ::: "memory");
    {
        const int fr = lane & 15, fq = lane >> 4;
        const f16* arow = F.H2() + (size_t)(gw + fr * NGW) * DM + 8 * fq;
        f32x4 acc = (f32x4){0, 0, 0, 0};
#pragma unroll 8
        for (int kk = 0; kk < 32; ++kk)
            acc = __builtin_amdgcn_mfma_f32_16x16x32_f16(*(const f16x8*)(arow + 32 * kk), *(const LAS f16x8*)(wr16 + fr * DM + 32 * kk + 8 * fq), acc, 0, 0, 0);
#pragma unroll
        for (int r = 0; r < 4; ++r) {
            float mx = acc[r];
#pragma unroll
            for (int o = 1; o < 16; o <<= 1) mx = fmaxf(mx, __shfl_xor(mx, o));
            const float ex = __expf(acc[r] - mx);
            float den = ex;
#pragma unroll
            for (int o = 1; o < 16; o <<= 1) den += __shfl_xor(den, o);
            const int row = gw + (4 * fq + r) * NGW, b = row / SEQ, t = row % SEQ;
            F.AFF()[((size_t)b * 16 + fr) * SEQ + t] = ex * __builtin_amdgcn_rcpf(den);
        }
    }
    __syncthreads();
}

DI void phase_topk(const Ctx& F) {
    if (F.c >= 64) return;
    LAS unsigned* vals = (LAS unsigned*)F.lds;
    LAS unsigned* hist = vals + SEQ;
    LAS unsigned* sm = hist + 256;
    const int be = F.c, tid = F.tid;
    const float* a = F.AFF() + (size_t)be * SEQ;
    for (int i = tid; i < SEQ; i += 512) vals[i] = __float_as_uint(a[i]);
    if (tid == 0) { sm[0] = 0u; sm[1] = CAP; }
    __syncthreads();
    unsigned mask = 0u;
    for (int pass = 0; pass < 4; ++pass) {
        const int shift = 24 - 8 * pass;
        if (tid < 256) hist[tid] = 0u;
        __syncthreads();
        const unsigned prefix = sm[0];
        for (int i = tid; i < SEQ; i += 512) { const unsigned v = vals[i]; if ((v & mask) == prefix) atomicAdd((unsigned*)&hist[(v >> shift) & 255u], 1u); }
        __syncthreads();
        {
            const unsigned kcur = sm[1];
            unsigned hv = 0u, suf = 0u;
            if (tid < 256) { hv = hist[255 - tid]; suf = hv;
                for (int o = 1; o < 64; o <<= 1) { const unsigned tt = __shfl_up(suf, o); if ((tid & 63) >= o) suf += tt; }
                if ((tid & 63) == 63) sm[18 + (tid >> 6)] = suf; }
            __syncthreads();
            if (tid < 256) { for (int i = 0; i < (tid >> 6); ++i) suf += sm[18 + i];
                if (suf >= kcur && suf - hv < kcur) { sm[1] = kcur - (suf - hv); sm[0] = prefix | ((unsigned)(255 - tid) << shift); } }
        }
        mask |= 255u << shift;
        __syncthreads();
    }
    const unsigned T = sm[0], keq = sm[1];
    unsigned cg = 0, ce = 0;
    for (int j = 0; j < 16; ++j) { const unsigned v = vals[tid * 16 + j]; cg += v > T; ce += v == T; }
    const int lane = tid & 63, w = tid >> 6;
    unsigned ig = cg, ie = ce;
    for (int o = 1; o < 64; o <<= 1) { const unsigned tg = __shfl_up(ig, o), te = __shfl_up(ie, o); if (lane >= o) { ig += tg; ie += te; } }
    if (lane == 63) { sm[2 + w] = ig; sm[10 + w] = ie; }
    __syncthreads();
    unsigned og = 0, oe = 0;
    for (int i = 0; i < w; ++i) { og += sm[2 + i]; oe += sm[10 + i]; }
    unsigned pg = og + ig - cg, pe = oe + ie - ce;
    const int rowbase = ((be & 15) * 4 + (be >> 4)) * CAP;
    for (int j = 0; j < 16; ++j) {
        const int t = tid * 16 + j; const unsigned v = vals[t];
        int slot = -1;
        if (v > T) { slot = (int)(pg + (pe < keq ? pe : keq)); pg++; }
        else if (v == T) { if (pe < keq) slot = (int)(pg + pe); pe++; }
        F.SLOT()[(size_t)be * SEQ + t] = slot;
        if (slot >= 0) { F.IDX()[rowbase + slot] = t; F.GATEV()[rowbase + slot] = __uint_as_float(v); }
    }
    __syncthreads();
}

DI void phase_combine(const Ctx& F) {
    LAS float* NW3 = (LAS float*)F.lds; LAS float* G2 = NW3 + DM;
    for (int i = F.tid; i < DM; i += 512) NW3[i] = F.norm_w[3072 + i];
    for (int i = F.tid; i < 4 * DM; i += 512) G2[i] = F.MOD()[(i >> 10) * 6144 + 5120 + (i & 1023)];
    asm volatile("s_waitcnt vmcnt(0)" ::: "memory");
    __syncthreads();
    const int lane = F.lane, gw = F.c * 8 + F.wave, NGW = F.G * 8;
    if (gw >= MLAT) return;
#define CB_LOADSX(S, X, rw) do { const int _r = (rw) < MLAT ? (rw) : gw; const int _b = _r / SEQ, _t = _r % SEQ; \
        S = F.SLOT()[((size_t)_b * 16 + (lane & 15)) * SEQ + _t]; \
        _Pragma("unroll") for (int j = 0; j < 4; ++j) X[j] = *(const f16x4*)(F.XLAT() + (size_t)_r * DM + 4 * lane + 256 * j); } while (0)
#define CB_LOADY(Y, S, M, rw) do { const int _r = (rw) < MLAT ? (rw) : gw; const int _b = _r / SEQ; unsigned _m = (M); \
        _Pragma("unroll") for (int q = 0; q < 4; ++q) { const bool _has = _m != 0u; const int _e = _has ? __builtin_ctz(_m) : 0; _m &= _m - 1u; \
            const int _s = __shfl(S, _e); const size_t _ro = _has ? (size_t)((_e * 4 + _b) * CAP + _s) : 0; \
            _Pragma("unroll") for (int j = 0; j < 4; ++j) Y[q][j] = *(const f16x4*)(F.YM() + _ro * DM + 4 * lane + 256 * j); } } while (0)
    int s0, s1, s2; f16x4 x0[4], x1[4], x2[4]; f16x4 y0[4][4], y1[4][4];
    CB_LOADSX(s0, x0, gw); CB_LOADSX(s1, x1, gw + NGW);
    unsigned m0 = (unsigned)(__ballot(s0 >= 0) & 0xffffull), m1;
    CB_LOADY(y0, s0, m0, gw);
    for (int row = gw; row < MLAT; row += NGW) {
        CB_LOADSX(s2, x2, row + 2 * NGW);
        m1 = (unsigned)(__ballot(s1 >= 0) & 0xffffull);
        CB_LOADY(y1, s1, m1, row + NGW);
        const int b = row / SEQ;
        f32x4 acc[4];
#pragma unroll
        for (int j = 0; j < 4; ++j) acc[j] = (f32x4){0, 0, 0, 0};
        { unsigned m = m0;
#pragma unroll
          for (int q = 0; q < 4; ++q) { const float on = m != 0u ? 1.f : 0.f; m &= m - 1u;
#pragma unroll
              for (int j = 0; j < 4; ++j) { acc[j].x += on * (float)y0[q][j].x; acc[j].y += on * (float)y0[q][j].y; acc[j].z += on * (float)y0[q][j].z; acc[j].w += on * (float)y0[q][j].w; } }
          while (m) {
              const int e = __builtin_ctz(m); m &= m - 1u; const int s = __shfl(s0, e);
              const f16* yr = F.YM() + (size_t)((e * 4 + b) * CAP + s) * DM + 4 * lane;
#pragma unroll
              for (int j = 0; j < 4; ++j) { const f16x4 v = *(const f16x4*)(yr + 256 * j); acc[j].x += (float)v.x; acc[j].y += (float)v.y; acc[j].z += (float)v.z; acc[j].w += (float)v.w; } } }
        float ss = 0.f;
#pragma unroll
        for (int j = 0; j < 4; ++j) ss += acc[j].x * acc[j].x + acc[j].y * acc[j].y + acc[j].z * acc[j].z + acc[j].w * acc[j].w;
        const float rstd = rsqrtf(wave_sum(ss) * (1.f / DM) + EPS);
#pragma unroll
        for (int j = 0; j < 4; ++j) {
            const int k = 4 * lane + 256 * j;
            const f32x4 nw = *(const LAS f32x4*)(NW3 + k), gt = *(const LAS f32x4*)(G2 + b * DM + k);
            const f32x4 xl = (f32x4){(float)x0[j].x, (float)x0[j].y, (float)x0[j].z, (float)x0[j].w};
            *(f32x4*)(F.out + (size_t)row * DM + k) = xl + gt * (acc[j] * rstd * nw);
        }
        s0 = s1; s1 = s2; m0 = m1;
#pragma unroll
        for (int j = 0; j < 4; ++j) { x0[j] = x1[j]; x1[j] = x2[j]; }
#pragma unroll
        for (int q = 0; q < 4; ++q)
#pragma unroll
            for (int j = 0; j < 4; ++j) y0[q][j] = y1[q][j];
    }
#undef CB_LOADSX
#undef CB_LOADY
}

#ifndef PROBE_PH
#define PROBE_PH -1
#endif

namespace mx {
DI int swz(int row, int chunk) { return row * 256 + ((chunk ^ (row & 15)) << 4); }
template <bool TR>
DI void load_tile(const f16* U, int row0, int s0, int ucol, LAS unsigned char* T, int rbase, int chunk) {
    f16x8 raw[8];
#pragma unroll
    for (int t = 0; t < 8; ++t) raw[t] = *(const f16x8*)(U + (size_t)(row0 + s0 + t) * NU + ucol);
    if (!TR) {
#pragma unroll
        for (int t = 0; t < 8; ++t) *(LAS f16x8*)(T + swz(rbase + t, chunk)) = raw[t];
    } else {
#pragma unroll
        for (int j = 0; j < 8; ++j) { f16x8 v;
#pragma unroll
            for (int t = 0; t < 8; ++t) v[t] = raw[t][j];
            *(LAS f16x8*)(T + swz(rbase + j, chunk)) = v; }
    }
}
DI void scan128(float a0, float a1, float& c0, float& c1, float& tot) {
    float p = a0 + a1;
#pragma unroll
    for (int o = 1; o < 64; o <<= 1) { const float t = __shfl_up(p, o); if ((int)(threadIdx.x & 63) >= o) p += t; }
    c1 = p; c0 = p - a1; tot = __shfl(p, 63);
}
constexpr size_t SSD_SLOT = 8192;
DI size_t ssd_sid(int b, int ck, int h, int dir) { return (size_t)(((b * 66 + ck) * 8 + h) * 2 + dir); }

struct SsaPre { f16x8 raw[8]; float d0, d1; };
DI void ssa_ids(int u, int& b, int& ck, int& h) { b = u / (66 * 8); ck = (u / 8) % 66; h = u & 7; }
DI int ssa_row0(int b, int ck) { return ck < 2 ? MLAT + b * CTXL + 128 * ck : b * SEQ + 128 * (ck - 2); }
DI void ssa_prefetch(const Ctx& F, int u, SsaPre& P) {
    int b, ck, h; ssa_ids(u, b, ck, h);
    const int tid = F.tid, row0 = ssa_row0(b, ck), g = h >> 2;
    if (tid < 384) {
        const int tr = tid & 15, g8 = tid >> 4;
        const int ucol = g8 < 8 ? UXBC + h * 64 + 8 * g8 : UXBC + 512 + g * 128 + 8 * (g8 - 8);
#pragma unroll
        for (int t = 0; t < 8; ++t) P.raw[t] = *(const f16x8*)(F.U() + (size_t)(row0 + 8 * tr + t) * NU + ucol);
    } else {
        const int s = tid - 384;
        P.d0 = F.DT()[(size_t)(row0 + s) * 16 + h]; P.d1 = F.DT()[(size_t)(row0 + s) * 16 + 8 + h];
    }
}
DI void ssd_a_phase(const Ctx& F, f16* ST, float* TOTS) {
    const int tid = F.tid, lane = F.lane;
    LAS unsigned char* XT = F.lds;
    LAS unsigned char* BT = F.lds + 64 * 256;
    LAS float* dtA = (LAS float*)(F.lds + 192 * 256);
    LAS float* laA = dtA + 256;
    LAS f16* w16 = (LAS f16*)(laA + 256);
    int u = F.c; if (u >= 2112) return;
    const int hq = u & 7;
    const float dtb0 = F.dt_bias[hq], dtb1 = F.dt_bias[8 + hq], an0 = -__expf(F.a_log[hq]), an1 = -__expf(F.a_log[8 + hq]);
    SsaPre P; ssa_prefetch(F, u, P);
    for (; u < 2112; u += F.G) {
        int b, ck, h; ssa_ids(u, b, ck, h);
        if (tid < 384) {
            const int tr = tid & 15, g8 = tid >> 4;
            LAS unsigned char* T = g8 < 8 ? XT : BT; const int rbase = g8 < 8 ? 8 * g8 : 8 * (g8 - 8);
#pragma unroll
            for (int j = 0; j < 8; ++j) { f16x8 v;
#pragma unroll
                for (int t = 0; t < 8; ++t) v[t] = P.raw[t][j];
                *(LAS f16x8*)(T + swz(rbase + j, tr)) = v; }
        } else {
            const int s = tid - 384;
            const float da = softplus_f(P.d0 + dtb0), db = softplus_f(P.d1 + dtb1);
            dtA[s] = da; laA[s] = da * an0; dtA[128 + s] = db; laA[128 + s] = db * an1;
        }
        if (u + F.G < 2112) ssa_prefetch(F, u + F.G, P);
        __syncthreads();
        if (F.wave < 2) {
            const int dir = F.wave; const float a0 = laA[dir * 128 + 2 * lane], a1 = laA[dir * 128 + 2 * lane + 1];
            float c0, c1, tot; scan128(a0, a1, c0, c1, tot);
            const float e0 = dir == 0 ? tot - c0 : c0 - a0, e1 = dir == 0 ? tot - c1 : c1 - a1;
            w16[dir * 128 + 2 * lane] = (f16)(dtA[dir * 128 + 2 * lane] * __expf(e0));
            w16[dir * 128 + 2 * lane + 1] = (f16)(dtA[dir * 128 + 2 * lane + 1] * __expf(e1));
            if (lane == 0) TOTS[ssd_sid(b, ck, h, dir)] = __expf(tot);
        }
        __syncthreads();
        {
            int t2 = tid; asm volatile("" : "+v"(t2));
            const int lane2 = t2 & 63, fr = lane2 & 15, fq = lane2 >> 4, wv = __builtin_amdgcn_readfirstlane(t2 >> 6);
            const int dir = wv & 1, ntp = wv >> 1;
            f32x4 acc[2][4];
#pragma unroll
            for (int i = 0; i < 2; ++i)
#pragma unroll
                for (int j = 0; j < 4; ++j) acc[i][j] = (f32x4){0, 0, 0, 0};
#pragma unroll
            for (int kk = 0; kk < 4; ++kk) {
                const f16x8 wv8 = *(const LAS f16x8*)(w16 + dir * 128 + 32 * kk + 8 * fq);
                f16x8 a[2], bf[4];
#pragma unroll
                for (int nt = 0; nt < 2; ++nt) a[nt] = *(const LAS f16x8*)(BT + swz(16 * (2 * ntp + nt) + fr, 4 * kk + fq)) * wv8;
#pragma unroll
                for (int pt = 0; pt < 4; ++pt) bf[pt] = *(const LAS f16x8*)(XT + swz(16 * pt + fr, 4 * kk + fq));
#pragma unroll
                for (int nt = 0; nt < 2; ++nt)
#pragma unroll
                    for (int pt = 0; pt < 4; ++pt) acc[nt][pt] = __builtin_amdgcn_mfma_f32_16x16x32_f16(a[nt], bf[pt], acc[nt][pt], 0, 0, 0);
            }
            f16* S = ST + ssd_sid(b, ck, h, dir) * SSD_SLOT;
#pragma unroll
            for (int nt = 0; nt < 2; ++nt)
#pragma unroll
                for (int pt = 0; pt < 4; ++pt) { f16x4 o; o.x = (f16)acc[nt][pt].x; o.y = (f16)acc[nt][pt].y; o.z = (f16)acc[nt][pt].z; o.w = (f16)acc[nt][pt].w;
                    *(f16x4*)(S + (size_t)(16 * pt + fr) * 128 + 16 * (2 * ntp + nt) + 4 * fq) = o; }
        }
        __syncthreads();
    }
}

DI void ssd_b(const Ctx& F, f16* ST, const float* TOTS) {
    const int idx = F.c * 512 + F.tid; if (idx >= 64 * 2048) return;
    const int e = idx & 2047, chain = idx >> 11, dir = chain & 1, h = (chain >> 1) & 7, b = chain >> 4;
    float run[4] = {0.f, 0.f, 0.f, 0.f};
    for (int s0 = 0; s0 < 66; s0 += 6) {
        f16x4 loc[6]; float d[6]; f16* p[6];
#pragma unroll
        for (int i = 0; i < 6; ++i) { const int st = s0 + i; const int ck = dir == 0 ? st : (st < 2 ? 1 - st : 67 - st);
            const size_t sid = ssd_sid(b, ck, h, dir); p[i] = ST + sid * SSD_SLOT + (size_t)e * 4; loc[i] = *(const f16x4*)p[i]; d[i] = TOTS[sid]; }
#pragma unroll
        for (int i = 0; i < 6; ++i) { f16x4 o; o.x = (f16)run[0]; o.y = (f16)run[1]; o.z = (f16)run[2]; o.w = (f16)run[3]; *(f16x4*)p[i] = o;
            run[0] = d[i] * run[0] + (float)loc[i].x; run[1] = d[i] * run[1] + (float)loc[i].y; run[2] = d[i] * run[2] + (float)loc[i].z; run[3] = d[i] * run[3] + (float)loc[i].w; }
    }
}

DI void ssd_c_unit(const Ctx& F, const f16* ST, int b, int c, int g) {
    const int tid = F.tid, lane = F.lane;
    const int row0 = b * SEQ + 128 * c;
    LAS unsigned char* CT = F.lds;
    LAS unsigned char* BM = F.lds + 128 * 256;
    LAS unsigned char* XT = F.lds + 256 * 256;
    LAS float* dtA = (LAS float*)(F.lds + 131072);
    LAS float* csA = dtA + 1024;
    {
        const int tr = tid & 15, g8 = tid >> 4;
        load_tile<true>(F.U(), row0, 8 * tr, UXBC + g * 256 + 8 * g8, XT, 8 * g8, tr);
    }
    {
        const int g8 = tid & 31, tr = tid >> 5;
        load_tile<false>(F.U(), row0, 8 * tr, UXBC + 512 + (g8 >> 4) * 256 + g * 128 + 8 * (g8 & 15), g8 < 16 ? BM : CT, 8 * tr, g8 & 15);
    }
#pragma unroll
    for (int q = 0; q < 2; ++q) { const int idx = tid + 512 * q, s = idx & 127, hd = idx >> 7, hh = hd >> 1, dir = hd & 1, h = g * 4 + hh;
        const float d = softplus_f(F.DT()[(size_t)(row0 + s) * 16 + dir * 8 + h] + F.dt_bias[dir * 8 + h]);
        dtA[hd * 128 + s] = d; csA[hd * 128 + s] = -d * __expf(F.a_log[dir * 8 + h]); }
    __syncthreads();
    {
        const int wv = F.wave;
        const float a0 = csA[wv * 128 + 2 * lane], a1 = csA[wv * 128 + 2 * lane + 1];
        float c0, c1, tot; scan128(a0, a1, c0, c1, tot);
        if (wv & 1) { c0 = tot - c0 + a0; c1 = tot - c1 + a1; }
        csA[wv * 128 + 2 * lane] = c0; csA[wv * 128 + 2 * lane + 1] = c1;
    }
    __syncthreads();
    int t2 = tid; asm volatile("" : "+v"(t2));
    const int lane2 = t2 & 63, fr = lane2 & 15, fq = lane2 >> 4, w = __builtin_amdgcn_readfirstlane(t2 >> 6);
    const int l0 = 16 * w + fr;
    f16x8 cfr[4];
#pragma unroll
    for (int kk = 0; kk < 4; ++kk) cfr[kk] = *(const LAS f16x8*)(CT + swz(l0, 4 * kk + fq));
    f32x4 gacc[8];
#pragma unroll
    for (int st = 0; st < 8; ++st) { gacc[st] = (f32x4){0, 0, 0, 0};
#pragma unroll
        for (int kk = 0; kk < 4; ++kk) gacc[st] = __builtin_amdgcn_mfma_f32_16x16x32_f16(*(const LAS f16x8*)(BM + swz(16 * st + fr, 4 * kk + fq)), cfr[kk], gacc[st], 0, 0, 0); }
    float dsk4 = F.ssd_d[g * 4 + (lane2 & 3)]; asm volatile("s_waitcnt vmcnt(0)" : "+v"(dsk4) :: "memory");
    __syncthreads();
#define SSD_RING_ISSUE(q) do { const f16* _S = ST + ssd_sid(b, c + 2, g * 4 + ((q) >> 1), (q) & 1) * SSD_SLOT; \
        _Pragma("unroll") for (int _p = 0; _p < 2; ++_p) { const int _o = (w * 2 + _p) * 1024 + lane2 * 16, _row = _o >> 8, _pch = (_o >> 4) & 15, _lch = _pch ^ (_row & 15); \
            __builtin_amdgcn_global_load_lds((const unsigned*)((const char*)_S + _row * 256 + _lch * 16), (LAS unsigned*)(CT + ((q) & 3) * 16384 + (w * 2 + _p) * 1024), 16, 0, 0); } } while (0)
    SSD_RING_ISSUE(0); SSD_RING_ISSUE(1); SSD_RING_ISSUE(2); SSD_RING_ISSUE(3);
    f16* yrow = F.Y() + (size_t)(row0 + l0) * DM + g * 256;
#pragma unroll 1
    for (int hh = 0; hh < 4; ++hh) {
        const int h = g * 4 + hh;
        int l = l0; asm volatile("" : "+v"(l));
        const LAS float* dtf = dtA + (2 * hh) * 128, *dtb = dtA + (2 * hh + 1) * 128, *csf = csA + (2 * hh) * 128, *rcb = csA + (2 * hh + 1) * 128;
        const float csf_l = csf[l], rcb_l = rcb[l], dsum_l = dtf[l] + dtb[l], dskip = __shfl(dsk4, hh);
        f32x4 yacc[4];
#pragma unroll
        for (int pt = 0; pt < 4; ++pt) yacc[pt] = (f32x4){0, 0, 0, 0};
#pragma unroll
        for (int kk = 0; kk < 4; ++kk) {
            f16x8 m;
#pragma unroll
            for (int hf = 0; hf < 2; ++hf) { const int st = 2 * kk + hf, sb = 16 * st + 4 * fq;
                const f32x4 cf = *(const LAS f32x4*)(csf + sb), rb = *(const LAS f32x4*)(rcb + sb), df = *(const LAS f32x4*)(dtf + sb), db = *(const LAS f32x4*)(dtb + sb);
#pragma unroll
                for (int r = 0; r < 4; ++r) { const int s = sb + r;
                    const float arg = s < l ? csf_l - cf[r] : (s > l ? rcb_l - rb[r] : 0.f);
                    const float dsel = s < l ? df[r] : (s > l ? db[r] : dsum_l);
                    float val = gacc[st][r] * __expf(arg) * dsel; if (s == l) val += dskip;
                    m[hf * 4 + r] = (f16)val; } }
            __builtin_amdgcn_sched_barrier(0);
#pragma unroll
            for (int pt = 0; pt < 4; ++pt) { const int p = 64 * hh + 16 * pt + fr;
                const f16x4 x0 = *(const LAS f16x4*)(XT + swz(p, 4 * kk + (fq >> 1)) + 8 * (fq & 1));
                const f16x4 x1 = *(const LAS f16x4*)(XT + swz(p, 4 * kk + 2 + (fq >> 1)) + 8 * (fq & 1));
                f16x8 xf; xf[0] = x0[0]; xf[1] = x0[1]; xf[2] = x0[2]; xf[3] = x0[3]; xf[4] = x1[0]; xf[5] = x1[1]; xf[6] = x1[2]; xf[7] = x1[3];
                yacc[pt] = __builtin_amdgcn_mfma_f32_16x16x32_f16(xf, m, yacc[pt], 0, 0, 0); }
            __builtin_amdgcn_sched_barrier(0);
        }
        if (hh == 0 || hh == 3) asm volatile("s_waitcnt vmcnt(4)" ::: "memory"); else asm volatile("s_waitcnt vmcnt(8)" ::: "memory");
        bar_lds();
#pragma unroll
        for (int dir = 0; dir < 2; ++dir) {
            const LAS unsigned char* SL = CT + ((2 * hh + dir) & 3) * 16384;
            f32x4 off[4];
#pragma unroll
            for (int pt = 0; pt < 4; ++pt) off[pt] = (f32x4){0, 0, 0, 0};
#pragma unroll
            for (int kk = 0; kk < 4; ++kk)
#pragma unroll
                for (int pt = 0; pt < 4; ++pt) off[pt] = __builtin_amdgcn_mfma_f32_16x16x32_f16(*(const LAS f16x8*)(SL + swz(16 * pt + fr, 4 * kk + fq)), cfr[kk], off[pt], 0, 0, 0);
            const float e = __expf(dir == 0 ? csf_l : rcb_l);
#pragma unroll
            for (int pt = 0; pt < 4; ++pt) yacc[pt] += off[pt] * e;
        }
#pragma unroll
        for (int pt = 0; pt < 4; ++pt) { f16x4 o; o.x = (f16)yacc[pt].x; o.y = (f16)yacc[pt].y; o.z = (f16)yacc[pt].z; o.w = (f16)yacc[pt].w;
            *(f16x4*)(yrow + 64 * hh + 16 * pt + 4 * fq) = o; }
        bar_lds();
        if (hh < 2) { SSD_RING_ISSUE(2 * hh + 4); SSD_RING_ISSUE(2 * hh + 5); }
    }
#undef SSD_RING_ISSUE
    asm volatile("s_waitcnt vmcnt(0)" ::: "memory");
    const size_t urow = (size_t)(row0 + l0) * NU + UZ + g * 256;
    f16x4 yv[16], zv[16];
#pragma unroll
    for (int i = 0; i < 16; ++i) { yv[i] = *(const f16x4*)(yrow + 16 * i + 4 * fq); zv[i] = *(const f16x4*)(F.U() + urow + 16 * i + 4 * fq); }
    float ss = 0.f; f32x4 gv[16];
#pragma unroll
    for (int i = 0; i < 16; ++i) { gv[i].x = (float)yv[i].x * silu_f((float)zv[i].x); gv[i].y = (float)yv[i].y * silu_f((float)zv[i].y); gv[i].z = (float)yv[i].z * silu_f((float)zv[i].z); gv[i].w = (float)yv[i].w * silu_f((float)zv[i].w);
        ss += gv[i].x * gv[i].x + gv[i].y * gv[i].y + gv[i].z * gv[i].z + gv[i].w * gv[i].w; }
    ss += __shfl_xor(ss, 16); ss += __shfl_xor(ss, 32);
    const float rstd = rsqrtf(ss * (1.f / 256.f) + EPS);
#pragma unroll
    for (int i = 0; i < 16; ++i) { const int ch = 16 * i + 4 * fq; const f32x4 nw = *(const f32x4*)(F.ssd_nw + g * 256 + ch);
        f16x4 o; o.x = (f16)(gv[i].x * rstd * nw.x); o.y = (f16)(gv[i].y * rstd * nw.y); o.z = (f16)(gv[i].z * rstd * nw.z); o.w = (f16)(gv[i].w * rstd * nw.w);
        *(f16x4*)(yrow + ch) = o; }
    __syncthreads();
}
}

namespace mx {
typedef short s16x8 __attribute__((ext_vector_type(8)));
typedef float f32x2 __attribute__((ext_vector_type(2)));
DI int swz64(int row, int chunk) { return row * 128 + ((chunk ^ ((row >> 1) & 7)) << 4); }
DI unsigned short f2bf(float f) { unsigned u = __builtin_bit_cast(unsigned, f); return (unsigned short)((u + 0x7fffu + ((u >> 16) & 1u)) >> 16); }
constexpr size_t HG_SLOT = 16384;
DI size_t hg_sid(int b, int ck, int h, int dir) { return (size_t)(((b * 132 + ck) * 4 + h) * 2 + dir); }
DI f16* hg_slot(f16* HCT, f16* HLAT, int b, int ck, int h, int dir) {
    return ck < 4 ? HCT + (size_t)(((b * 4 + ck) * 4 + h) * 2 + dir) * HG_SLOT : HLAT + (size_t)(((b * 128 + (ck - 4)) * 4 + h) * 2 + dir) * HG_SLOT;
}
template <int NCH>
DI void load_raw(const Ctx& F, int row0, int ucol, LAS unsigned char* RAW) {
    constexpr int CPR = NCH / 8;
    for (int i = F.tid; i < 64 * CPR; i += 512) { const int t = i / CPR, cch = i % CPR;
        *(LAS f16x8*)(RAW + (t * NCH + cch * 8) * 2) = *(const f16x8*)(F.U() + (size_t)(row0 + t) * NU + ucol + cch * 8); }
}
DI void load_vt(const Ctx& F, int row0, int h, LAS unsigned char* VT) {
    const int i = F.tid & 31, g8 = F.tid >> 5;
    const f16x8 a = *(const f16x8*)(F.U() + (size_t)(row0 + 2 * i) * NU + UI + h * 128 + 8 * g8);
    const f16x8 b = *(const f16x8*)(F.U() + (size_t)(row0 + 2 * i + 1) * NU + UI + h * 128 + 8 * g8);
#pragma unroll
    for (int j = 0; j < 8; ++j) { typedef _Float16 h2 __attribute__((ext_vector_type(2))); h2 p; p.x = a[j]; p.y = b[j];
        *(LAS h2*)(VT + swz64(8 * g8 + j, i >> 2) + (i & 3) * 4) = p; }
}

template <int T0, int SGN>
DI float hg_gates(const LAS f16* rf, float lb, float (&f)[32]) {
    float prod = 1.f;
#pragma unroll
    for (int i = 0; i < 32; ++i) { const int t = T0 + SGN * i; f[i] = lb + (1.f - lb) * sigmoid_f((float)rf[t * 128]); prod *= f[i]; }
    return prod;
}
template <int T0, int SGN>
DI void hg_a_write(const float (&f)[32], float R, LAS unsigned char* T, int k) {
    f16 v[32];
#pragma unroll
    for (int i = 0; i < 32; ++i) { v[i] = (f16)((1.f - f[i]) * R); R *= f[i]; }
#pragma unroll
    for (int j = 0; j < 4; ++j) { f16x8 o;
#pragma unroll
        for (int q = 0; q < 8; ++q) { const int t = (T0 < 32 ? 0 : 32) + 8 * j + q; const int i = SGN > 0 ? t - T0 : T0 - t; o[q] = v[i]; }
        const int ch = ((T0 < 32 ? 0 : 32) >> 3) + j;
        *(LAS f16x8*)(T + k * 128 + ((ch ^ ((k >> 1) & 7)) << 4)) = o; }
}
template <int T0, int SGN>
DI void hg_c_write(const float (&f)[32], float P, const LAS f16* rq, LAS unsigned char* TQ, LAS unsigned char* TK, int k) {
    const int cb = (k & 7) * 2, cx = (k >> 3) << 4;
#pragma unroll
    for (int i = 0; i < 32; ++i) { const int t = T0 + SGN * i; P *= f[i];
        const float qv = silu_f((float)rq[t * 128]);
        const int off = t * 256 + (cx ^ ((t & 15) << 4)) + cb;
        *(LAS unsigned short*)(TQ + off) = f2bf(qv * P);
        *(LAS unsigned short*)(TK + off) = f2bf((1.f - f[i]) * __builtin_amdgcn_rcpf(P)); }
}

typedef _Float16 f16x2 __attribute__((ext_vector_type(2)));
struct HgaPre { unsigned rf[16]; f16x8 va, vb; };
DI void hga_ids(int v, int& b, int& ck, int& h) { b = v / (132 * 4); ck = (v / 4) % 132; h = v & 3; }
DI int hga_row0(int b, int ck) { return ck < 4 ? MLAT + b * CTXL + 64 * ck : b * SEQ + 64 * (ck - 4); }
DI void hga_prefetch(const Ctx& F, int v, HgaPre& P) {
    int b, ck, h; hga_ids(v, b, ck, h);
    const int tid = F.tid, row0 = hga_row0(b, ck);
    const int kp = tid & 63, dir = (tid >> 6) & 1, qq = tid >> 7;
    const int T0 = dir == 0 ? 16 * qq : 63 - 16 * qq, SG = dir == 0 ? 1 : -1;
    const f16* pf = F.U() + (size_t)(row0 + T0) * NU + (dir ? UFB : UFF) + h * 128 + 2 * kp;
    const long st = (long)SG * NU;
#pragma unroll
    for (int i = 0; i < 16; ++i) P.rf[i] = *(const unsigned*)(pf + i * st);
    const int pi = tid & 31, g8 = tid >> 5;
    P.va = *(const f16x8*)(F.U() + (size_t)(row0 + 2 * pi) * NU + UI + h * 128 + 8 * g8);
    P.vb = *(const f16x8*)(F.U() + (size_t)(row0 + 2 * pi + 1) * NU + UI + h * 128 + 8 * g8);
}
DI void hg_a_phase(const Ctx& F, f16* HCT, f16* HLAT, float* DEC) {
    LAS unsigned char* KD = F.lds;
    LAS unsigned char* VT = F.lds + 32768;
    LAS float* PX = (LAS float*)(F.lds + 49152);
    const int tid = F.tid;
    int v = (F.c + 64) % F.G; if (v >= 2112) return;
    float lbw[2];
    { const int kp = tid & 63, dir = (tid >> 6) & 1, ch = (v & 3) * 128 + 2 * kp;
#pragma unroll
      for (int e = 0; e < 2; ++e) { const float l0 = F.hgrn_lb[dir * 512 + ch + e], l1 = F.hgrn_lb[1024 + dir * 512 + ch + e]; lbw[e] = __builtin_amdgcn_rcpf(1.f + __expf(l1 - l0)); } }
    HgaPre P; hga_prefetch(F, v, P);
    for (; v < 2112; v += F.G) {
        int b, ck, h; hga_ids(v, b, ck, h);
        unsigned rf[16];
#pragma unroll
        for (int i = 0; i < 16; ++i) rf[i] = P.rf[i];
        const f16x8 va = P.va, vb = P.vb;
        if (v + F.G < 2112) hga_prefetch(F, v + F.G, P);
        { const int pi = tid & 31, g8 = tid >> 5;
#pragma unroll
          for (int j = 0; j < 8; ++j) { typedef _Float16 h2 __attribute__((ext_vector_type(2))); h2 pr; pr.x = va[j]; pr.y = vb[j];
              *(LAS h2*)(VT + swz64(8 * g8 + j, pi >> 2) + (pi & 3) * 4) = pr; } }
        {
            const int kp = tid & 63, dir = (tid >> 6) & 1, qq = tid >> 7;
            const float lb[2] = {lbw[0], lbw[1]};
            float f0[16], f1[16]; float p0 = 1.f, p1 = 1.f;
#pragma unroll
            for (int i = 0; i < 16; ++i) { const f16x2 r = __builtin_bit_cast(f16x2, rf[i]);
                f0[i] = lb[0] + (1.f - lb[0]) * sigmoid_f((float)r.x); f1[i] = lb[1] + (1.f - lb[1]) * sigmoid_f((float)r.y); p0 *= f0[i]; p1 *= f1[i]; }
            *(LAS f32x2*)(PX + (dir * 4 + qq) * 128 + 2 * kp) = (f32x2){p0, p1};
            __syncthreads();
            float c0 = 1.f, c1 = 1.f, a0 = p0, a1 = p1;
            for (int q2 = 0; q2 < 4; ++q2) if (q2 != qq) { const f32x2 pp = *(const LAS f32x2*)(PX + (dir * 4 + q2) * 128 + 2 * kp); a0 *= pp.x; a1 *= pp.y; if (q2 > qq) { c0 *= pp.x; c1 *= pp.y; } }
            if (qq == 0) *(f32x2*)(DEC + hg_sid(b, ck, h, dir) * 128 + 2 * kp) = (f32x2){a0, a1};
            f16 w0[16], w1[16];
#pragma unroll
            for (int i = 15; i >= 0; --i) { w0[i] = (f16)((1.f - f0[i]) * c0); w1[i] = (f16)((1.f - f1[i]) * c1); c0 *= f0[i]; c1 *= f1[i]; }
            const int tb = dir == 0 ? 16 * qq : 48 - 16 * qq;
            LAS unsigned char* T = KD + dir * 16384;
#pragma unroll
            for (int e = 0; e < 2; ++e)
#pragma unroll
                for (int hf = 0; hf < 2; ++hf) { f16x8 o;
#pragma unroll
                    for (int q = 0; q < 8; ++q) { const int j = 8 * hf + q; const int i = dir == 0 ? j : 15 - j; o[q] = e == 0 ? w0[i] : w1[i]; }
                    *(LAS f16x8*)(T + swz64(2 * kp + e, (tb >> 3) + hf)) = o; }
        }
        __syncthreads();
        {
            int t2 = tid; asm volatile("" : "+v"(t2));
            const int lane2 = t2 & 63, fr = lane2 & 15, fq = lane2 >> 4, w = __builtin_amdgcn_readfirstlane(t2 >> 6);
            const int dir = w & 1, q = w >> 1;
            const LAS unsigned char* T = KD + dir * 16384;
            f32x4 acc[2][8];
#pragma unroll
            for (int i = 0; i < 2; ++i)
#pragma unroll
                for (int j = 0; j < 8; ++j) acc[i][j] = (f32x4){0, 0, 0, 0};
#pragma unroll
            for (int kk = 0; kk < 2; ++kk) {
                f16x8 a[2];
#pragma unroll
                for (int i = 0; i < 2; ++i) a[i] = *(const LAS f16x8*)(T + swz64(16 * (2 * q + i) + fr, 4 * kk + fq));
#pragma unroll
                for (int vt = 0; vt < 8; ++vt) { const f16x8 bv = *(const LAS f16x8*)(VT + swz64(16 * vt + fr, 4 * kk + fq));
#pragma unroll
                    for (int i = 0; i < 2; ++i) acc[i][vt] = __builtin_amdgcn_mfma_f32_16x16x32_f16(a[i], bv, acc[i][vt], 0, 0, 0); }
            }
            f16* S = hg_slot(HCT, HLAT, b, ck, h, dir);
#pragma unroll
            for (int i = 0; i < 2; ++i)
#pragma unroll
                for (int vt = 0; vt < 8; ++vt) { f16x4 o; o.x = (f16)acc[i][vt].x; o.y = (f16)acc[i][vt].y; o.z = (f16)acc[i][vt].z; o.w = (f16)acc[i][vt].w;
                    *(f16x4*)(S + (size_t)(16 * vt + fr) * 128 + 16 * (2 * q + i) + 4 * fq) = o; }
        }
        __syncthreads();
    }
}

DI void hg_b(const Ctx& F, f16* HCT, f16* HLAT, const float* DEC) {
    const int idx = F.c * 512 + F.tid; if (idx >= 32 * 4096) return;
    const int e = idx & 4095, chain = idx >> 12, dir = chain & 1, h = (chain >> 1) & 3, b = chain >> 3;
    const int k0 = (e & 31) * 4;
    float run[4] = {0.f, 0.f, 0.f, 0.f};
    for (int s0 = 0; s0 < 132; s0 += 6) {
        f16x4 loc[6]; f32x4 d[6]; f16* p[6];
#pragma unroll
        for (int i = 0; i < 6; ++i) { const int st = s0 + i; const int ck = dir == 0 ? st : (st < 4 ? 3 - st : 135 - st);
            p[i] = hg_slot(HCT, HLAT, b, ck, h, dir) + (size_t)e * 4; loc[i] = *(const f16x4*)p[i]; d[i] = *(const f32x4*)(DEC + hg_sid(b, ck, h, dir) * 128 + k0); }
#pragma unroll
        for (int i = 0; i < 6; ++i) { f16x4 o; o.x = (f16)run[0]; o.y = (f16)run[1]; o.z = (f16)run[2]; o.w = (f16)run[3]; *(f16x4*)p[i] = o;
            run[0] = d[i].x * run[0] + (float)loc[i].x; run[1] = d[i].y * run[1] + (float)loc[i].y; run[2] = d[i].z * run[2] + (float)loc[i].z; run[3] = d[i].w * run[3] + (float)loc[i].w; }
    }
}

DI unsigned cvt_pk_bf16(float lo, float hi) { unsigned r; asm volatile("v_cvt_pk_bf16_f32 %0, %1, %2" : "=v"(r) : "v"(lo), "v"(hi)); return r; }
struct HgcPre { unsigned rf[16], rq[16]; f16x8 va, vb; f16x4 g[4]; };
DI void hgc_unit_ids(int u, int& b, int& c, int& h) { b = u >> 9; c = (u >> 2) & 127; h = u & 3; }
DI void hgc_prefetch(const Ctx& F, int u, HgcPre& P) {
    int b, c, h; hgc_unit_ids(u, b, c, h);
    const int tid = F.tid, row0 = b * SEQ + 64 * c;
    const int kp = tid & 63, dir = (tid >> 6) & 1, qq = tid >> 7;
    const int T0 = dir == 0 ? 16 * qq : 63 - 16 * qq, SG = dir == 0 ? 1 : -1;
    const f16* pf = F.U() + (size_t)(row0 + T0) * NU + (dir ? UFB : UFF) + h * 128 + 2 * kp;
    const f16* pq = F.U() + (size_t)(row0 + T0) * NU + UQ + h * 128 + 2 * kp;
    const long st = (long)SG * NU;
#pragma unroll
    for (int i = 0; i < 16; ++i) { P.rf[i] = *(const unsigned*)(pf + i * st); P.rq[i] = *(const unsigned*)(pq + i * st); }
    const int pi = tid & 31, g8 = tid >> 5;
    P.va = *(const f16x8*)(F.U() + (size_t)(row0 + 2 * pi) * NU + UI + h * 128 + 8 * g8);
    P.vb = *(const f16x8*)(F.U() + (size_t)(row0 + 2 * pi + 1) * NU + UI + h * 128 + 8 * g8);
    const int lane = tid & 63, fr = lane & 15, fq = lane >> 4, w = tid >> 6, lt = w & 3, vh = w >> 2;
    const f16* pg = F.U() + (size_t)(row0 + 16 * lt + fr) * NU + UG + h * 128 + 64 * vh + 4 * fq;
#pragma unroll
    for (int vt = 0; vt < 4; ++vt) P.g[vt] = *(const f16x4*)(pg + 16 * vt);
}
DI void hg_c_phase(const Ctx& F, f16* HCT, f16* HLAT) {
    LAS unsigned char* QD = F.lds;
    LAS unsigned char* KI = F.lds + 32768;
    LAS unsigned char* VT = F.lds + 65536;
    LAS unsigned char* SS = F.lds + 81920;
    LAS float* red = (LAS float*)(F.lds + 147456);
    LAS float* PX = red + 128;
    const int tid = F.tid;
    int u = F.c; if (u >= 2048) return;
    float lbw[2];
    { const int kp = tid & 63, dir = (tid >> 6) & 1, ch = (u & 3) * 128 + 2 * kp;
#pragma unroll
      for (int e = 0; e < 2; ++e) { const float l0 = F.hgrn_lb[dir * 512 + ch + e], l1 = F.hgrn_lb[1024 + dir * 512 + ch + e]; lbw[e] = __builtin_amdgcn_rcpf(1.f + __expf(l1 - l0)); } }
    LAS float* NW = PX + 1024;
    if (tid < 128) NW[tid] = F.hgrn_nw[(u & 3) * 128 + tid];
    asm volatile("s_waitcnt vmcnt(0)" ::: "memory");
    __syncthreads();
    HgcPre P; hgc_prefetch(F, u, P);
    for (; u < 2048; u += F.G) {
        int b, c, h; hgc_unit_ids(u, b, c, h);
        const int row0 = b * SEQ + 64 * c;
        unsigned rf[16], rq[16];
#pragma unroll
        for (int i = 0; i < 16; ++i) { rf[i] = P.rf[i]; rq[i] = P.rq[i]; }
        const f16x8 va = P.va, vb = P.vb; f16x4 gz[4];
#pragma unroll
        for (int vt = 0; vt < 4; ++vt) gz[vt] = P.g[vt];
        if (u + F.G < 2048) hgc_prefetch(F, u + F.G, P);
        {
            const int wv = __builtin_amdgcn_readfirstlane(tid >> 6), lane = tid & 63;
#pragma unroll
            for (int dir = 0; dir < 2; ++dir) { const f16* S = hg_slot(HCT, HLAT, b, c + 4, h, dir);
#pragma unroll
                for (int p = 0; p < 4; ++p) { const int o = (wv * 4 + p) * 1024 + lane * 16, row = o >> 8, pch = (o >> 4) & 15, lch = pch ^ (row & 15);
                    __builtin_amdgcn_global_load_lds((const unsigned*)((const char*)S + row * 256 + lch * 16), (LAS unsigned*)(SS + dir * 32768 + (wv * 4 + p) * 1024), 16, 0, 0); } }
        }
        { const int pi = tid & 31, g8 = tid >> 5;
#pragma unroll
          for (int j = 0; j < 8; ++j) { typedef _Float16 h2 __attribute__((ext_vector_type(2))); h2 pr; pr.x = va[j]; pr.y = vb[j];
              *(LAS h2*)(VT + swz64(8 * g8 + j, pi >> 2) + (pi & 3) * 4) = pr; } }
        {
            const int kp = tid & 63, dir = (tid >> 6) & 1, qq = tid >> 7;
            const int T0 = dir == 0 ? 16 * qq : 63 - 16 * qq, SG = dir == 0 ? 1 : -1;
            const float lb[2] = {lbw[0], lbw[1]};
            float f0[16], f1[16]; float p0 = 1.f, p1 = 1.f;
#pragma unroll
            for (int i = 0; i < 16; ++i) { const f16x2 r = __builtin_bit_cast(f16x2, rf[i]);
                f0[i] = lb[0] + (1.f - lb[0]) * sigmoid_f((float)r.x); f1[i] = lb[1] + (1.f - lb[1]) * sigmoid_f((float)r.y); p0 *= f0[i]; p1 *= f1[i]; }
            *(LAS f32x2*)(PX + (dir * 4 + qq) * 128 + 2 * kp) = (f32x2){p0, p1};
            bar_lds();
            float c0 = 1.f, c1 = 1.f;
            for (int q2 = 0; q2 < qq; ++q2) { const f32x2 pp = *(const LAS f32x2*)(PX + (dir * 4 + q2) * 128 + 2 * kp); c0 *= pp.x; c1 *= pp.y; }
            LAS unsigned char* TQ = QD + dir * 16384; LAS unsigned char* TK = KI + dir * 16384;
            const int cb = (kp & 3) * 4, cx = (kp >> 2) << 4;
#pragma unroll
            for (int i = 0; i < 16; ++i) { const int t = T0 + SG * i; c0 *= f0[i]; c1 *= f1[i];
                const f16x2 r = __builtin_bit_cast(f16x2, rq[i]);
                const int off = t * 256 + (cx ^ ((t & 15) << 4)) + cb;
                *(LAS unsigned*)(TQ + off) = cvt_pk_bf16(silu_f((float)r.x) * c0, silu_f((float)r.y) * c1);
                *(LAS unsigned*)(TK + off) = cvt_pk_bf16((1.f - f0[i]) * __builtin_amdgcn_rcpf(c0), (1.f - f1[i]) * __builtin_amdgcn_rcpf(c1)); }
        }
        bar_lds();
        int t2 = tid; asm volatile("" : "+v"(t2));
        const int lane2 = t2 & 63, fr = lane2 & 15, fq = lane2 >> 4, w = __builtin_amdgcn_readfirstlane(t2 >> 6);
        const int lt = w & 3, vh = w >> 2, l = 16 * lt + fr;
        f32x4 oacc[4];
#pragma unroll
        for (int vt = 0; vt < 4; ++vt) oacc[vt] = (f32x4){0, 0, 0, 0};
        s16x8 qfr[2][4];
#pragma unroll
        for (int dir = 0; dir < 2; ++dir) {
            const LAS unsigned char* TQ = QD + dir * 16384; const LAS unsigned char* TK = KI + dir * 16384;
#pragma unroll
            for (int kk = 0; kk < 4; ++kk) qfr[dir][kk] = *(const LAS s16x8*)(TQ + swz(l, 4 * kk + fq));
            f32x4 att[4];
#pragma unroll
            for (int st = 0; st < 4; ++st) { att[st] = (f32x4){0, 0, 0, 0};
#pragma unroll
                for (int kk = 0; kk < 4; ++kk) att[st] = __builtin_amdgcn_mfma_f32_16x16x32_bf16(*(const LAS s16x8*)(TK + swz(16 * st + fr, 4 * kk + fq)), qfr[dir][kk], att[st], 0, 0, 0); }
#pragma unroll
            for (int k2 = 0; k2 < 2; ++k2) {
                f16x8 m;
#pragma unroll
                for (int hf = 0; hf < 2; ++hf)
#pragma unroll
                    for (int r = 0; r < 4; ++r) { const int s = 16 * (2 * k2 + hf) + 4 * fq + r; const bool keep = dir == 0 ? s <= l : s >= l; m[hf * 4 + r] = keep ? (f16)att[2 * k2 + hf][r] : (f16)0.f; }
#pragma unroll
                for (int vt = 0; vt < 4; ++vt) { const int v = 64 * vh + 16 * vt + fr;
                    const f16x4 x0 = *(const LAS f16x4*)(VT + swz64(v, 4 * k2 + (fq >> 1)) + 8 * (fq & 1));
                    const f16x4 x1 = *(const LAS f16x4*)(VT + swz64(v, 4 * k2 + 2 + (fq >> 1)) + 8 * (fq & 1));
                    f16x8 xf; xf[0] = x0[0]; xf[1] = x0[1]; xf[2] = x0[2]; xf[3] = x0[3]; xf[4] = x1[0]; xf[5] = x1[1]; xf[6] = x1[2]; xf[7] = x1[3];
                    oacc[vt] = __builtin_amdgcn_mfma_f32_16x16x32_f16(xf, m, oacc[vt], 0, 0, 0); }
            }
        }
        asm volatile("s_waitcnt vmcnt(0)" ::: "memory");
        __syncthreads();
#pragma unroll
        for (int dir = 0; dir < 2; ++dir)
#pragma unroll
            for (int kk = 0; kk < 4; ++kk) { f16x8 q16;
#pragma unroll
                for (int j = 0; j < 8; ++j) q16[j] = (f16)__builtin_bit_cast(float, ((unsigned)(unsigned short)qfr[dir][kk][j]) << 16);
#pragma unroll
                for (int vt = 0; vt < 4; ++vt) oacc[vt] = __builtin_amdgcn_mfma_f32_16x16x32_f16(*(const LAS f16x8*)(SS + dir * 32768 + swz(64 * vh + 16 * vt + fr, 4 * kk + fq)), q16, oacc[vt], 0, 0, 0); }
        float ss = 0.f;
#pragma unroll
        for (int vt = 0; vt < 4; ++vt) ss += oacc[vt].x * oacc[vt].x + oacc[vt].y * oacc[vt].y + oacc[vt].z * oacc[vt].z + oacc[vt].w * oacc[vt].w;
        ss += __shfl_xor(ss, 16); ss += __shfl_xor(ss, 32);
        if (fq == 0) red[vh * 64 + l] = ss;
        __syncthreads();
        const float rstd = rsqrtf((red[l] + red[64 + l]) * (1.f / 128.f) + EPS);
        f16* yrow = F.Y() + (size_t)(row0 + l) * DM + 512 + h * 128;
#pragma unroll
        for (int vt = 0; vt < 4; ++vt) { const int v = 64 * vh + 16 * vt + 4 * fq;
            const f32x4 nw = *(const LAS f32x4*)(NW + v);
            f16x4 o; o.x = (f16)(oacc[vt].x * rstd * nw.x * silu_f((float)gz[vt].x)); o.y = (f16)(oacc[vt].y * rstd * nw.y * silu_f((float)gz[vt].y));
            o.z = (f16)(oacc[vt].z * rstd * nw.z * silu_f((float)gz[vt].z)); o.w = (f16)(oacc[vt].w * rstd * nw.w * silu_f((float)gz[vt].w));
            *(f16x4*)(yrow + v) = o; }
        __syncthreads();
    }
}
}

__global__ void __launch_bounds__(512, 2) mk_fwd(Args args) {
    extern __shared__ __attribute__((aligned(16))) unsigned char lds_raw[];
    Ctx F;
    F.lds = (LAS unsigned char*)lds_raw;
    F.tid = threadIdx.x; F.lane = F.tid & 63; F.wave = __builtin_amdgcn_readfirstlane(F.tid >> 6); F.G = gridDim.x; F.c = blockIdx.x;
    unsigned char* ws = args.ws;
    F.x = args.in[0]; F.cvec = args.in[1]; F.ctx = args.in[2]; F.c_ctx = args.in[3]; F.ada_w = args.in[4]; F.ada_b = args.in[5]; F.norm_w = args.in[6]; F.w_in = args.in[7];
    F.conv_w = args.in[8]; F.conv_b = args.in[9]; F.dt_bias = args.in[10]; F.a_log = args.in[11]; F.ssd_d = args.in[12]; F.ssd_nw = args.in[13]; F.hgrn_lb = args.in[14]; F.hgrn_nw = args.in[15];
    F.w_out = args.in[16]; F.w_router = args.in[17]; F.w_gate = args.in[18]; F.w_up = args.in[19]; F.w_down = args.in[20];
    F.out = args.out;
    F.ws = ws;
    volatile LAS unsigned* misc = (volatile LAS unsigned*)(F.lds + LDS_MISC_OFF);
    if (F.tid < 16) misc[F.tid] = 0u;
    __syncthreads();
    XcdBarrier bar = xcd_barrier_post((unsigned*)(ws + WS_BAR), misc + 8);
    f16* SST = (f16*)(ws + WS_H); float* TOTS = (float*)(ws + WS_Y); float* DEC = (float*)(ws + WS_Y + 65536);
    f16* HCT = (f16*)(ws + WS_AFF); f16* HLAT = (f16*)F.out;
    const int hi = args.hi;
#define REFRESH() do { int _t = threadIdx.x; asm volatile("" : "+v"(_t)); F.tid = _t; F.lane = _t & 63; F.wave = __builtin_amdgcn_readfirstlane(_t >> 6); } while (0)
#define PHASE(k, last, ...) do { if ((k) < hi) { REFRESH(); __VA_ARGS__; if (!(last) && (k) + 1 < hi) xcd_barrier(bar); } } while (0)
    PHASE(PH_PREP, false, phase_prep(F));
    PHASE(PH_HROWS, false, phase_hrows(F));
    PHASE(PH_GEMM_IN, false, { gm::ProbIn p{F.H(), F.WIN(), F.U()}; gm::gemm_phase(F.lds, p, F.G, F.c, F.tid); moe_convert(F, 0, MOE_SPLIT); });
    PHASE(PH_CONV, false, phase_conv(F));
    PHASE(PH_MA, false, {
        mx::ssd_a_phase(F, SST, TOTS);
        mx::hg_a_phase(F, HCT, HLAT, DEC); });
    PHASE(PH_MB, false, { mx::ssd_b(F, SST, TOTS); mx::hg_b(F, HCT, HLAT, DEC); });
    PHASE(PH_MC, false, {
        for (int u = F.c; u < 512; u += F.G) mx::ssd_c_unit(F, SST, u >> 7, (u >> 1) & 63, u & 1);
        mx::hg_c_phase(F, HCT, HLAT); });
    PHASE(PH_GEMM_OUT, false, { gm::ProbOut p{F.Y(), F.WOUT(), F.R()}; gm::gemm_phase(F.lds, p, F.G, F.c, F.tid); });
    PHASE(PH_POST, false, phase_post(F));
    PHASE(PH_TOPK, false, { phase_topk(F); moe_convert(F, MOE_SPLIT, MOE_ITEMS); });
    PHASE(PH_GEMM_GU, false, {
        LAS int* tab = (LAS int*)(F.lds + LDS_TAB_OFF);
        for (int i = 0; i < 8; ++i) { gm::Unit u; if (!gm::unit_at(i, F.G, F.c, gm::ProbGU::nM, gm::ProbGU::nN, u)) break;
            if (F.tid < 256) { const int b = (u.pm >> 2) & 3; tab[i * 256 + F.tid] = b * SEQ + F.IDX()[u.pm * 256 + F.tid]; } }
        __syncthreads();
        gm::ProbGU p{F.H2(), F.WGU(), F.ACT(), F.IDX(), tab}; gm::gemm_phase(F.lds, p, F.G, F.c, F.tid); });
    PHASE(PH_GEMM_DOWN, false, { gm::ProbDown p{F.ACT(), F.WD(), F.YM(), F.GATEV()}; gm::gemm_phase(F.lds, p, F.G, F.c, F.tid); });
    PHASE(PH_COMBINE, true, phase_combine(F));
#undef PHASE
}

extern "C" void kernel_launch(void* const* d_in, const int* in_sizes, int n_in, void* d_out, int out_size, void* d_ws, size_t ws_size, hipStream_t stream) {
    if (ws_size < WS_END || n_in < 21) { fprintf(stderr, "kernel_launch: bad workspace/inputs: ws %zu n_in %d\n", ws_size, n_in); return; }
    static bool attr_set = false;
    if (!attr_set) { (void)hipFuncSetAttribute((const void*)mk_fwd, hipFuncAttributeMaxDynamicSharedMemorySize, LDS_BYTES); attr_set = true; }
    Args a{}; for (int i = 0; i < 21; ++i) a.in[i] = (const float*)d_in[i]; a.out = (float*)d_out; a.ws = (unsigned char*)d_ws;
#if PROBE_PH >= 0
    (void)hipMemsetAsync((char*)d_ws + WS_BAR, 0, WS_CTL_BYTES, stream);
    a.hi = PROBE_PH; hipLaunchKernelGGL(mk_fwd, dim3(256), dim3(512), LDS_BYTES, stream, a);
#endif
    (void)hipMemsetAsync((char*)d_ws + WS_BAR, 0, WS_CTL_BYTES, stream);
    a.hi = PH_COUNT; hipLaunchKernelGGL(mk_fwd, dim3(256), dim3(512), LDS_BYTES, stream, a);
}
```

```cpp
#include <hip/hip_runtime.h>
#include <cstdio>
#include <cstdint>

#define DI __device__ __forceinline__
typedef _Float16 f16;
typedef _Float16 f16x8 __attribute__((ext_vector_type(8)));
typedef _Float16 f16x4 __attribute__((ext_vector_type(4)));
typedef float f32x4 __attribute__((ext_vector_type(4)));

constexpr int DM = 1024, NB = 4, SEQ = 8192, CTXL = 256;
constexpr int MLAT = NB * SEQ;
constexpr int MCTX = NB * CTXL;
constexpr int MTOT = MLAT + MCTX;
constexpr int INCOLS = 4112, NU = 4096;
constexpr int UZ = 0, UXBC = 512, UQ = 1536, UFF = 2048, UFB = 2560, UI = 3072, UG = 3584;
constexpr int NE = 16, FF = 1024, CAP = 1024;
constexpr float EPS = 1e-6f;

constexpr size_t MiB = 1u << 20;
constexpr size_t WS_MOD = 1 * MiB;
constexpr size_t WS_DT = 2 * MiB;
constexpr size_t WS_WDT = 5 * MiB;
constexpr size_t WS_AFF = 6 * MiB;
constexpr size_t WS_IDX = 8 * MiB;
constexpr size_t WS_GATEV = 8 * MiB + 256 * 1024;
constexpr size_t WS_SLOT = 9 * MiB;
constexpr size_t WS_WIN = 12 * MiB;
constexpr size_t WS_WOUT = 20 * MiB;
constexpr size_t WS_WGU = 22 * MiB;
constexpr size_t WS_WD = 86 * MiB;
constexpr size_t WS_H = 118 * MiB;
constexpr size_t WS_U = 184 * MiB;
constexpr size_t WS_Y = 448 * MiB;
constexpr size_t WS_END = 512 * MiB;
constexpr size_t WS_ACT = WS_U;
constexpr size_t WS_YM = WS_U + 128 * MiB;
constexpr size_t WS_R = WS_U;

DI float silu_f(float x) { return x * __builtin_amdgcn_rcpf(1.f + __expf(-x)); }
DI float sigmoid_f(float x) { return __builtin_amdgcn_rcpf(1.f + __expf(-x)); }
DI float softplus_f(float x) { return x > 20.f ? x : log1pf(__expf(x)); }
DI float wave_sum(float v) {
#pragma unroll
    for (int o = 1; o < 64; o <<= 1) v += __shfl_xor(v, o);
    return v;
}


DI float reduce16(const float (&v)[16]) {
    const int lane = threadIdx.x & 63;
    float w8[8], w4[4], w2[2];
    const bool b0 = lane & 1, b1 = lane & 2, b2 = lane & 4, b3 = lane & 8;
#pragma unroll
    for (int i = 0; i < 8; ++i) { const float keep = b0 ? v[2 * i + 1] : v[2 * i], send = b0 ? v[2 * i] : v[2 * i + 1]; w8[i] = keep + __shfl_xor(send, 1); }
#pragma unroll
    for (int i = 0; i < 4; ++i) { const float keep = b1 ? w8[2 * i + 1] : w8[2 * i], send = b1 ? w8[2 * i] : w8[2 * i + 1]; w4[i] = keep + __shfl_xor(send, 2); }
#pragma unroll
    for (int i = 0; i < 2; ++i) { const float keep = b2 ? w4[2 * i + 1] : w4[2 * i], send = b2 ? w4[2 * i] : w4[2 * i + 1]; w2[i] = keep + __shfl_xor(send, 4); }
    float r = (b3 ? w2[1] : w2[0]) + __shfl_xor(b3 ? w2[0] : w2[1], 8);
    r += __shfl_xor(r, 16); r += __shfl_xor(r, 32);
    return r;
}

DI void bar_lds() { asm volatile("s_waitcnt lgkmcnt(0)" ::: "memory"); __builtin_amdgcn_s_barrier(); asm volatile("" ::: "memory"); }
#define LAS __attribute__((address_space(3)))
typedef unsigned u32x4 __attribute__((ext_vector_type(4)));
namespace gm {
constexpr int BM = 256, BK = 64, HALF = 128, HTB = HALF * BK * 2, STAGE_BYTES = 8 * HTB, NXCD = 8, WGM = 8, KD = 1024, NT = KD / BK;
DI int lds_byte(int r, int c) { const int st = (r >> 4) * 2 + (c >> 5), rr = r & 15, cc = c & 31, ob = rr * 64 + cc * 2; return st * 1024 + (ob ^ (((ob >> 9) & 1) << 5)); }
DI void stage_rc(int b, int& R, int& C) { const int st = b / 1024, sb = b % 1024, swz = sb ^ (((sb >> 9) & 1) << 5); R = (st >> 1) * 16 + swz / 64; C = (st & 1) * 32 + (swz % 64) / 2; }
DI int perm32(int rho) { const int n = rho >> 4, i = rho & 15; return 8 * (i >> 2) + 4 * n + (i & 3); }
struct Unit { int pm, pn; };
DI bool unit_at(int i, int G, int c, int nM, int nN, Unit& u) {
    const int nwg = nM * nN; const long L = (long)i * G + c; if (L >= nwg) return false;
    int wgid = (int)L; { const int q = nwg / NXCD, r = nwg % NXCD, xcd = wgid % NXCD, off = wgid / NXCD; wgid = (xcd < r ? xcd * (q + 1) : r * (q + 1) + (xcd - r) * q) + off; }
    const int nig = WGM * nN, gid = wgid / nig, fm = gid * WGM, gsz = (nM - fm) < WGM ? (nM - fm) : WGM;
    u.pm = fm + ((wgid % nig) % gsz); u.pn = (wgid % nig) / gsz; return true;
}
typedef f32x4 Acc[2][2][4][2];
DI unsigned pack2(float a, float b) { typedef _Float16 h2 __attribute__((ext_vector_type(2))); h2 v; v.x = (f16)a; v.y = (f16)b; return __builtin_bit_cast(unsigned, v); }

#ifndef GEMM_SP2
#define GEMM_SP2 0
#define GEMM_ALIGN 1
#endif
template <class P, bool SP2 = GEMM_SP2, bool ALIGN = GEMM_ALIGN>
DI void gemm_phase(LAS unsigned char* lds, const P& p, int G, int c, int tid) {
    const int wid = __builtin_amdgcn_readfirstlane(tid >> 6), lane = tid & 63, wr = wid >> 2, wc = wid & 3, fr = lane & 15, fq = lane >> 4;
    constexpr int K = KD, nt = NT;
    int Rr[2], Cc[2]; unsigned voffB[2];
#pragma unroll
    for (int i = 0; i < 2; ++i) { stage_rc(tid * 16 + i * 8192, Rr[i], Cc[i]); const int Rb = P::PERM ? ((Rr[i] & ~31) + perm32(Rr[i] & 31)) : Rr[i]; voffB[i] = (unsigned)(Rb * K + Cc[i]) * 2u; }
    const size_t kstep = (size_t)(BK * 2);
    const size_t hstep = (size_t)HALF * K * 2;
    const unsigned ldsw = (unsigned)wid * 1024u;
    const int aoff = lds_byte(wr * 64 + fr, fq * 8), boff = lds_byte(wc * 32 + fr, fq * 8);
#define G_SA(b, h) (((b) * 2 + (h)) * HTB)
#define G_SB(b, h) ((4 + (b) * 2 + (h)) * HTB)
#define G_STAGEB(bufoff, gbase) do { _Pragma("unroll") for (int _i = 0; _i < 2; ++_i) \
        __builtin_amdgcn_global_load_lds((const unsigned*)((const char*)(gbase) + voffB[_i]), (LAS unsigned*)(lds + (bufoff) + ldsw + _i * 8192), 16, 0, 0); } while (0)
#define G_STAGEA(bufoff, offs, h, koff) do { _Pragma("unroll") for (int _i = 0; _i < 2; ++_i) \
        __builtin_amdgcn_global_load_lds((const unsigned*)(gA + (offs)[h][_i] + (koff)), (LAS unsigned*)(lds + (bufoff) + ldsw + _i * 8192), 16, 0, 0); } while (0)
#define G_LDA(dst, b, h) do { _Pragma("unroll") for (int m = 0; m < 4; ++m) _Pragma("unroll") for (int k = 0; k < 2; ++k) dst[m][k] = *(const LAS f16x8*)(lds + G_SA(b, h) + aoff + m * 2048 + k * 1024); } while (0)
#define G_LDB(dst, b, h) do { _Pragma("unroll") for (int n = 0; n < 2; ++n) _Pragma("unroll") for (int k = 0; k < 2; ++k) dst[n][k] = *(const LAS f16x8*)(lds + G_SB(b, h) + boff + n * 2048 + k * 1024); } while (0)
#define G_MMA(ai, bj, At, Bt) do { __builtin_amdgcn_s_setprio(1); _Pragma("unroll") for (int m = 0; m < 4; ++m) _Pragma("unroll") for (int n = 0; n < 2; ++n) _Pragma("unroll") for (int k = 0; k < 2; ++k) \
        acc[ai][bj][m][n] = __builtin_amdgcn_mfma_f32_16x16x32_f16(Bt[n][k], At[m][k], acc[ai][bj][m][n], 0, 0, 0); __builtin_amdgcn_s_setprio(0); } while (0)
#define G_WAIT_V(n) asm volatile("s_waitcnt vmcnt(" #n ")" ::: "memory")
#define G_WAIT_L(n) asm volatile("s_waitcnt lgkmcnt(" #n ")" ::: "memory")
#define G_BAR __builtin_amdgcn_s_barrier()
#define G_SCHED __builtin_amdgcn_sched_barrier(0)
    Unit cur, nxt; int ui = 0;
    if (!unit_at(0, G, c, P::nM, P::nN, cur)) return;
    Acc acc;
#pragma unroll
    for (int a = 0; a < 2; ++a)
#pragma unroll
        for (int b = 0; b < 2; ++b)
#pragma unroll
            for (int m = 0; m < 4; ++m)
#pragma unroll
                for (int n = 0; n < 2; ++n) acc[a][b][m][n] = (f32x4){0.f, 0.f, 0.f, 0.f};
    f16x8 At[4][2], B0[2][2], B1[2][2];
    const char* gA = (const char*)p.A;
    unsigned offC[2][2], offN[2][2];
#pragma unroll
    for (int h = 0; h < 2; ++h)
#pragma unroll
        for (int i = 0; i < 2; ++i) offC[h][i] = p.arow(0, cur, 128 * h + Rr[i]) * (unsigned)(K * 2) + (unsigned)Cc[i] * 2u;
    const char* cB = p.bptr(cur);
    if constexpr (SP2) {
        G_STAGEB(G_SB(0, 0), cB); G_STAGEB(G_SB(0, 1), cB + hstep); G_STAGEA(G_SA(0, 0), offC, 0, 0); G_STAGEA(G_SA(0, 1), offC, 1, 0);
        if (wr == 1) G_BAR;
        G_WAIT_V(2); G_BAR;
        G_STAGEB(G_SB(1, 0), cB + kstep); G_STAGEA(G_SA(1, 0), offC, 0, kstep); G_STAGEB(G_SB(1, 1), cB + hstep + kstep);
        G_WAIT_V(6); G_BAR;
    } else {
    G_STAGEB(G_SB(0, 0), cB); G_STAGEA(G_SA(0, 0), offC, 0, 0); G_STAGEB(G_SB(0, 1), cB + hstep); G_STAGEA(G_SA(0, 1), offC, 1, 0);
    if (wr == 1) G_BAR;
    G_WAIT_V(4); G_BAR;
    G_STAGEB(G_SB(1, 0), cB + kstep); G_STAGEA(G_SA(1, 0), offC, 0, kstep); G_STAGEB(G_SB(1, 1), cB + hstep + kstep);
    G_WAIT_V(6); G_BAR;
    }
    for (;;) {
        const bool has_next = unit_at(ui + 1, G, c, P::nM, P::nN, nxt);
        const char* nB = has_next ? p.bptr(nxt) : cB;
#pragma unroll
        for (int h = 0; h < 2; ++h)
#pragma unroll
            for (int i = 0; i < 2; ++i) offN[h][i] = has_next ? p.arow(ui + 1, nxt, 128 * h + Rr[i]) * (unsigned)(K * 2) + (unsigned)Cc[i] * 2u : offC[h][i];
        for (int t = 0; t < nt; t += 2) {
            const bool last = (t == nt - 2);
            const size_t k1 = (size_t)(t + 1) * kstep;
            const size_t k2 = last ? 0 : (size_t)(t + 2) * kstep, k3 = k2 + kstep;
            const char* b2 = last ? nB : cB + (size_t)(t + 2) * kstep; const char* b3 = b2 + kstep;
            unsigned o2[2][2];
#pragma unroll
            for (int h = 0; h < 2; ++h)
#pragma unroll
                for (int i = 0; i < 2; ++i) o2[h][i] = last ? offN[h][i] : offC[h][i];
            if constexpr (SP2) {
            G_LDB(B0, 0, 0); G_LDB(B1, 0, 1); G_SCHED; G_LDA(At, 0, 0); G_STAGEA(G_SA(1, 1), offC, 1, k1);
            G_WAIT_V(8); G_WAIT_L(0); G_BAR; G_MMA(0, 0, At, B0); G_MMA(0, 1, At, B1); G_BAR; G_SCHED;
            G_LDA(At, 0, 1); G_STAGEB(G_SB(0, 0), b2); G_STAGEB(G_SB(0, 1), b2 + hstep); G_STAGEA(G_SA(0, 0), o2, 0, k2);
            G_WAIT_V(8); G_WAIT_L(0); G_BAR; G_MMA(1, 0, At, B0); G_MMA(1, 1, At, B1); G_BAR; G_SCHED;
            G_LDB(B0, 1, 0); G_LDB(B1, 1, 1); G_SCHED; G_LDA(At, 1, 0); G_STAGEA(G_SA(0, 1), o2, 1, k2);
            G_WAIT_V(8); G_WAIT_L(0); G_BAR; G_MMA(0, 0, At, B0); G_MMA(0, 1, At, B1); G_BAR; G_SCHED;
            G_LDA(At, 1, 1); G_STAGEB(G_SB(1, 0), b3); G_STAGEB(G_SB(1, 1), b3 + hstep); G_STAGEA(G_SA(1, 0), o2, 0, k3);
            G_WAIT_V(8); G_WAIT_L(0); G_BAR; G_MMA(1, 0, At, B0); G_MMA(1, 1, At, B1); G_BAR; G_SCHED;
            } else {
            G_LDB(B0, 0, 0); G_SCHED; G_LDA(At, 0, 0); G_STAGEA(G_SA(1, 1), offC, 1, k1);
            G_WAIT_L(8); G_BAR; G_WAIT_L(0); G_MMA(0, 0, At, B0); G_BAR; G_SCHED;
            G_LDB(B1, 0, 1); G_STAGEB(G_SB(0, 0), b2);
            G_BAR; G_WAIT_L(0); G_MMA(0, 1, At, B1); G_BAR;
            G_LDA(At, 0, 1); G_STAGEA(G_SA(0, 0), o2, 0, k2);
            G_BAR; G_WAIT_L(0); G_MMA(1, 0, At, B0); G_BAR; G_SCHED;
            G_STAGEB(G_SB(0, 1), b2 + hstep);
            G_WAIT_V(6); G_BAR; G_MMA(1, 1, At, B1); G_BAR;
            G_LDB(B0, 1, 0); G_SCHED; G_LDA(At, 1, 0); G_STAGEA(G_SA(0, 1), o2, 1, k2);
            G_WAIT_L(8); G_BAR; G_WAIT_L(0); G_MMA(0, 0, At, B0); G_BAR; G_SCHED;
            G_LDB(B1, 1, 1); G_STAGEB(G_SB(1, 0), b3);
            G_BAR; G_WAIT_L(0); G_MMA(0, 1, At, B1); G_BAR;
            G_LDA(At, 1, 1); G_STAGEA(G_SA(1, 0), o2, 0, k3);
            G_BAR; G_WAIT_L(0); G_MMA(1, 0, At, B0); G_BAR; G_SCHED;
            G_STAGEB(G_SB(1, 1), b3 + hstep);
            G_WAIT_V(6); G_BAR; G_MMA(1, 1, At, B1); G_BAR;
            }
        }
        if constexpr (ALIGN) { if (wr == 0) G_BAR; }
        p.epi(acc, cur, wr, wc, fr, fq);
        if (!has_next) break;
#pragma unroll
        for (int a = 0; a < 2; ++a)
#pragma unroll
            for (int b = 0; b < 2; ++b)
#pragma unroll
                for (int m = 0; m < 4; ++m)
#pragma unroll
                    for (int n = 0; n < 2; ++n) acc[a][b][m][n] = (f32x4){0.f, 0.f, 0.f, 0.f};
        cur = nxt; cB = nB; ++ui;
#pragma unroll
        for (int h = 0; h < 2; ++h)
#pragma unroll
            for (int i = 0; i < 2; ++i) offC[h][i] = offN[h][i];
        if constexpr (ALIGN) { if (wr == 1) G_BAR; }
    }
    G_WAIT_V(0);
    if constexpr (!ALIGN) { if (wr == 0) G_BAR; }
    G_BAR;
#undef G_SA
#undef G_SB
#undef G_STAGEA
#undef G_STAGEB
#undef G_LDA
#undef G_LDB
#undef G_MMA
#undef G_WAIT_V
#undef G_WAIT_L
#undef G_BAR
#undef G_SCHED
}

struct ProbIn {
    static constexpr int nM = MTOT / 256, nN = NU / 256; static constexpr bool PERM = true;
    const f16* A; const f16* BT; f16* U;
    DI unsigned arow(int, const Unit& u, int r) const { return (unsigned)(u.pm * 256 + r); }
    DI const char* bptr(const Unit& u) const { return (const char*)(BT + (size_t)u.pn * 256 * KD); }
    DI void epi(const Acc& acc, const Unit& u, int wr, int wc, int fr, int fq) const {
        const int row0 = u.pm * BM + wr * 64 + fr, col0 = u.pn * BM + wc * 32 + 8 * fq;
#pragma unroll
        for (int ai = 0; ai < 2; ++ai)
#pragma unroll
            for (int m = 0; m < 4; ++m) { f16* rowp = U + (size_t)(row0 + ai * HALF + m * 16) * NU + col0;
#pragma unroll
                for (int bj = 0; bj < 2; ++bj) { const f32x4 v0 = acc[ai][bj][m][0], v1 = acc[ai][bj][m][1];
                    u32x4 w; w.x = pack2(v0[0], v0[1]); w.y = pack2(v0[2], v0[3]); w.z = pack2(v1[0], v1[1]); w.w = pack2(v1[2], v1[3]);
                    *(u32x4*)(rowp + bj * HALF) = w; } }
    }
};
struct ProbOut {
    static constexpr int nM = MLAT / 256, nN = DM / 256; static constexpr bool PERM = true;
    const f16* A; const f16* BT; f16* R;
    DI unsigned arow(int, const Unit& u, int r) const { return (unsigned)(u.pm * 256 + r); }
    DI const char* bptr(const Unit& u) const { return (const char*)(BT + (size_t)u.pn * 256 * KD); }
    DI void epi(const Acc& acc, const Unit& u, int wr, int wc, int fr, int fq) const {
        const int row0 = u.pm * BM + wr * 64 + fr, col0 = u.pn * BM + wc * 32 + 8 * fq;
#pragma unroll
        for (int ai = 0; ai < 2; ++ai)
#pragma unroll
            for (int m = 0; m < 4; ++m) { f16* rowp = R + (size_t)(row0 + ai * HALF + m * 16) * DM + col0;
#pragma unroll
                for (int bj = 0; bj < 2; ++bj) { const f32x4 v0 = acc[ai][bj][m][0], v1 = acc[ai][bj][m][1];
                    u32x4 w; w.x = pack2(v0[0], v0[1]); w.y = pack2(v0[2], v0[3]); w.z = pack2(v1[0], v1[1]); w.w = pack2(v1[2], v1[3]);
                    *(u32x4*)(rowp + bj * HALF) = w; } }
    }
};
struct ProbGU {
    static constexpr int nM = (NE * NB * CAP) / 256, nN = 2048 / 256; static constexpr bool PERM = true;
    const f16* A; const f16* BT; f16* ACT; const int* IDX; const LAS int* tab;
    DI unsigned arow(int ui, const Unit& u, int r) const { return (unsigned)tab[ui * 256 + r]; }
    DI const char* bptr(const Unit& u) const { return (const char*)(BT + ((size_t)(u.pm >> 4) * 2048 + (size_t)u.pn * 256) * KD); }
    DI void epi(const Acc& acc, const Unit& u, int wr, int wc, int fr, int fq) const {
        const int row0 = u.pm * BM + wr * 64 + fr, col0 = u.pn * 128 + wc * 32 + 8 * fq;
#pragma unroll
        for (int ai = 0; ai < 2; ++ai)
#pragma unroll
            for (int m = 0; m < 4; ++m) { f16* rowp = ACT + (size_t)(row0 + ai * HALF + m * 16) * FF + col0;
                const f32x4 g0 = acc[ai][0][m][0], g1 = acc[ai][0][m][1], u0 = acc[ai][1][m][0], u1 = acc[ai][1][m][1];
                u32x4 w; w.x = pack2(silu_f(g0[0]) * u0[0], silu_f(g0[1]) * u0[1]); w.y = pack2(silu_f(g0[2]) * u0[2], silu_f(g0[3]) * u0[3]);
                w.z = pack2(silu_f(g1[0]) * u1[0], silu_f(g1[1]) * u1[1]); w.w = pack2(silu_f(g1[2]) * u1[2], silu_f(g1[3]) * u1[3]);
                *(u32x4*)rowp = w; }
    }
};
struct ProbDown {
    static constexpr int nM = (NE * NB * CAP) / 256, nN = DM / 256; static constexpr bool PERM = true;
    const f16* A; const f16* BT; f16* YM; const LAS float* gtab; mutable int ord;
    DI unsigned arow(int, const Unit& u, int r) const { return (unsigned)(u.pm * 256 + r); }
    DI const char* bptr(const Unit& u) const { return (const char*)(BT + ((size_t)(u.pm >> 4) * 1024 + (size_t)u.pn * 256) * KD); }
    DI void epi(const Acc& acc, const Unit& u, int wr, int wc, int fr, int fq) const {
        const int row0 = u.pm * BM + wr * 64 + fr, col0 = u.pn * BM + wc * 32 + 8 * fq;
#pragma unroll
        for (int ai = 0; ai < 2; ++ai)
#pragma unroll
            for (int m = 0; m < 4; ++m) { const int row = row0 + ai * HALF + m * 16; const float g = gtab[ord * 256 + (row & 255)]; f16* rowp = YM + (size_t)row * DM + col0;
#pragma unroll
                for (int bj = 0; bj < 2; ++bj) { const f32x4 v0 = acc[ai][bj][m][0] * g, v1 = acc[ai][bj][m][1] * g;
                    u32x4 w; w.x = pack2(v0[0], v0[1]); w.y = pack2(v0[2], v0[3]); w.z = pack2(v1[0], v1[1]); w.w = pack2(v1[2], v1[3]);
                    *(u32x4*)(rowp + bj * HALF) = w; } }
        ++ord;
    }
};
}

#define XB_TMO      128
#define XB_XCNT(j)  (256  + 64 * (j))
#define XB_XSUB(j)  (1280 + 64 * (j))
#define XB_XGEN(j)  (2304 + 64 * (j))
#define XB_TOP      3328
#define XB_TOPGEN   3392
#define XCD_BAR_WORDS 3456
#define XB_SPIN_CAP (1u << 22)
DI unsigned xb_ld(unsigned* p)              { return __hip_atomic_load(p, __ATOMIC_RELAXED, __HIP_MEMORY_SCOPE_AGENT); }
DI unsigned xb_add(unsigned* p, unsigned v) { return __hip_atomic_fetch_add(p, v, __ATOMIC_RELAXED, __HIP_MEMORY_SCOPE_AGENT); }
DI unsigned xb_xcc_id() { return (unsigned)__builtin_amdgcn_s_getreg((3 << 11) | 20) & 0xFu; }
#define XB_SPIN(cond, bar) do { unsigned _sp = 0; while (cond) { __builtin_amdgcn_s_sleep(1); \
    if ((++_sp & 255u) == 0u) { if (xb_ld(&(bar)[XB_TMO])) break; if (_sp > XB_SPIN_CAP) { atomicAdd(&(bar)[XB_TMO], 1u); break; } } } } while (0)
struct XcdBarrier { unsigned* bar; unsigned x; volatile LAS unsigned* st; };
DI XcdBarrier xcd_barrier_post(unsigned* bar, volatile LAS unsigned* st) {
    XcdBarrier b; b.bar = bar; b.x = xb_xcc_id(); b.st = st;
    if (threadIdx.x == 0) (void)xb_add(&bar[XB_XCNT(b.x)], 1u);
    return b;
}
DI void xcd_barrier_complete(unsigned* bar, unsigned x, unsigned& nloc, unsigned& nx) {
    const unsigned G = gridDim.x * gridDim.y * gridDim.z;
    unsigned sum, cnt, mine, sp = 0u;
    for (;;) {
        sum = 0u; cnt = 0u; mine = 0u;
#pragma unroll
        for (unsigned j = 0; j < 16; ++j) { const unsigned c = xb_ld(&bar[XB_XCNT(j)]); sum += c; cnt += (c > 0u) ? 1u : 0u; mine = (j == x) ? c : mine; }
        if (sum == G) break;
        __builtin_amdgcn_s_sleep(1);
        if ((++sp & 255u) == 0u) { if (xb_ld(&bar[XB_TMO])) break; if (sp > XB_SPIN_CAP) { atomicAdd(&bar[XB_TMO], 1u); break; } }
    }
    nloc = mine > 0u ? mine : 1u; nx = cnt > 0u ? cnt : 1u;
}
DI void xcd_barrier(const XcdBarrier& b) {
    asm volatile("s_waitcnt vmcnt(0)" ::: "memory");
    __syncthreads();
    if (threadIdx.x == 0) {
        unsigned* bar = b.bar;
        __builtin_amdgcn_s_waitcnt(0);
        unsigned nloc = b.st[0], nx = b.st[1];
        if (nloc == 0u) { xcd_barrier_complete(bar, b.x, nloc, nx); b.st[0] = nloc; b.st[1] = nx; }
        const unsigned old = xb_add(&bar[XB_XSUB(b.x)], 1u);
        const unsigned gen = old / nloc;
        if (old + 1u == (gen + 1u) * nloc) {
            __builtin_amdgcn_fence(__ATOMIC_RELEASE, "agent");
            asm volatile("s_waitcnt vmcnt(0)" ::: "memory");
            const unsigned og = xb_add(&bar[XB_TOP], 1u);
            const unsigned tg = og / nx;
            if (og + 1u == (tg + 1u) * nx) xb_add(&bar[XB_TOPGEN], 1u);
            else XB_SPIN(xb_ld(&bar[XB_TOPGEN]) == tg, bar);
            __builtin_amdgcn_fence(__ATOMIC_ACQUIRE, "agent");
            xb_add(&bar[XB_XGEN(b.x)], 1u);
            asm volatile("s_waitcnt vmcnt(0)" ::: "memory");
        } else {
            XB_SPIN(xb_ld(&bar[XB_XGEN(b.x)]) == gen, bar);
            __builtin_amdgcn_fence(__ATOMIC_ACQUIRE, "agent");
            asm volatile("s_waitcnt vmcnt(0)" ::: "memory");
        }
    }
    __syncthreads();
}

constexpr int LDS_TAB_OFF = 131072;
constexpr int LDS_MISC_OFF = 163840 - 256;
constexpr int LDS_BYTES = 163840;
constexpr size_t WS_BAR = 0;
constexpr size_t WS_CTL_BYTES = 65536;
struct Args { const float* in[21]; float* out; unsigned char* ws; int hi; int pad; };
enum { PH_PREP = 0, PH_HROWS, PH_GEMM_IN, PH_CONV, PH_MA, PH_MB, PH_MC, PH_GEMM_OUT, PH_POST, PH_TOPK, PH_GEMM_GU, PH_GEMM_DOWN, PH_COMBINE, PH_COUNT };

struct Ctx {
    LAS unsigned char* lds; int tid, lane, wave, G, c;
    const float *x, *cvec, *ctx, *c_ctx, *ada_w, *ada_b, *norm_w, *w_in, *conv_w, *conv_b, *dt_bias, *a_log, *ssd_d, *ssd_nw, *hgrn_lb, *hgrn_nw, *w_out, *w_router, *w_gate, *w_up, *w_down;
    float* out; unsigned char* ws;
    DI float* MOD() const { return (float*)(ws + WS_MOD); }   DI float* DT() const { return (float*)(ws + WS_DT); }   DI float* WDT() const { return (float*)(ws + WS_WDT); }
    DI float* AFF() const { return (float*)(ws + WS_AFF); }   DI float* GATEV() const { return (float*)(ws + WS_GATEV); }   DI f16* R() const { return (f16*)(ws + WS_R); }
    DI f16* XLAT() const { return (f16*)(ws + WS_Y); }   DI int* IDX() const { return (int*)(ws + WS_IDX); }   DI int* SLOT() const { return (int*)(ws + WS_SLOT); }
    DI f16* WIN() const { return (f16*)(ws + WS_WIN); }   DI f16* WOUT() const { return (f16*)(ws + WS_WOUT); }   DI f16* WGU() const { return (f16*)(ws + WS_WGU); }   DI f16* WD() const { return (f16*)(ws + WS_WD); }
    DI f16* H() const { return (f16*)(ws + WS_H); }   DI f16* H2() const { return (f16*)(ws + WS_H); }   DI f16* U() const { return (f16*)(ws + WS_U); }   DI f16* Y() const { return (f16*)(ws + WS_Y); }
    DI f16* ACT() const { return (f16*)(ws + WS_ACT); }   DI f16* YM() const { return (f16*)(ws + WS_YM); }
};

struct TrItem { const float* src; int ld, col0, k0; f16* dst; int ldd; };
DI void tr_load(const TrItem& t, int lane, f32x4 (&v)[8]) {
#pragma unroll
    for (int i = 0; i < 8; ++i) v[i] = *(const f32x4*)(t.src + (size_t)(t.k0 + 8 * i + (lane >> 3)) * t.ld + t.col0 + 4 * (lane & 7));
}
DI void tr_store(const TrItem& t, int lane, const f32x4 (&v)[8], LAS float* scr) {
#pragma unroll
    for (int i = 0; i < 8; ++i) { LAS float* p = scr + (8 * i + (lane >> 3)) * 33 + 4 * (lane & 7); p[0] = v[i].x; p[1] = v[i].y; p[2] = v[i].z; p[3] = v[i].w; }
    asm volatile("s_waitcnt lgkmcnt(0)" ::: "memory");
    const int cc = lane & 7;
#pragma unroll
    for (int j = 0; j < 4; ++j) { const int n = (lane >> 3) + 8 * j; const LAS float* s = scr + (8 * cc) * 33 + n;
        u32x4 o; o.x = gm::pack2(s[0 * 33], s[1 * 33]); o.y = gm::pack2(s[2 * 33], s[3 * 33]); o.z = gm::pack2(s[4 * 33], s[5 * 33]); o.w = gm::pack2(s[6 * 33], s[7 * 33]);
        *(u32x4*)(t.dst + (size_t)n * t.ldd + t.k0 + 8 * cc) = o; }
    asm volatile("s_waitcnt lgkmcnt(0)" ::: "memory");
}
DI void tr_item(const float* src, int ld, int col0, int k0, f16* dst_row0, int ldd, LAS float* scr, int lane) {
    const TrItem t{src, ld, col0, k0, dst_row0, ldd}; f32x4 v[8]; tr_load(t, lane, v); tr_store(t, lane, v, scr);
}
DI void phase_prep(const Ctx& F) {
    {
        LAS float* sv = (LAS float*)F.lds;
        LAS float* red = sv + 5 * DM;
        for (int i = F.tid; i < 5 * DM; i += 512) { const int r = i >> 10, k = i & 1023; sv[i] = silu_f(r < 4 ? F.cvec[r * DM + k] : F.c_ctx[k]); }
        __syncthreads();
        const int col = F.tid % 24, kg = F.tid / 24, j = F.c * 24 + col;
        if (kg < 21) {
            float a[5] = {0, 0, 0, 0, 0};
            for (int k = kg; k < DM; k += 21) { const float w = F.ada_w[(size_t)k * 6144 + j];
#pragma unroll
                for (int r = 0; r < 5; ++r) a[r] += sv[r * DM + k] * w; }
#pragma unroll
            for (int r = 0; r < 5; ++r) red[(kg * 24 + col) * 5 + r] = a[r];
        }
        __syncthreads();
        if (F.tid < 120) { const int cl = F.tid % 24, r = F.tid / 24; float s = 0.f; for (int g = 0; g < 21; ++g) s += red[(g * 24 + cl) * 5 + r]; const int jj = F.c * 24 + cl; F.MOD()[r * 6144 + jj] = s + F.ada_b[jj]; }
        __syncthreads();
    }
    for (int i = F.c * 512 + F.tid; i < 16 * DM; i += F.G * 512) { const int j = i >> 10, k = i & 1023; F.WDT()[i] = F.w_in[(size_t)k * INCOLS + 1536 + j]; }
    LAS float* scr = (LAS float*)(F.lds + F.wave * 8704);
    const int gw = F.c * 8 + F.wave, NGW = F.G * 8;
    constexpr int I_IN = 16 * 128, I_OUT = 16 * 32;
    for (int it = gw; it < I_IN + I_OUT; it += NGW) {
        int r = it;
        if (r < I_IN) { const int kb = r / 128, nb = r % 128, n0 = nb * 32; tr_item(F.w_in, INCOLS, n0 < 1536 ? n0 : n0 + 16, kb * 64, F.WIN() + (size_t)n0 * DM, DM, scr, F.lane); continue; } r -= I_IN;
        { const int kb = r / 32, nb = r % 32; tr_item(F.w_out, DM, nb * 32, kb * 64, F.WOUT() + (size_t)nb * 32 * DM, DM, scr, F.lane); }
    }
}
constexpr int MOE_ITEMS = 16 * 16 * 64 + 16 * 16 * 32, MOE_IDLE_WG0 = 64, MOE_SPLIT = 16384;
DI TrItem moe_item(const Ctx& F, int r) {
    constexpr int I_GU = 16 * 16 * 64;
    if (r < I_GU) { const int e = r / 1024, q = r % 1024, kb = q / 64, nb = q % 64, r0 = nb * 32, blk = r0 >> 7, within = r0 & 127, isu = blk & 1, f0 = (blk >> 1) * 128 + within;
        return TrItem{(isu ? F.w_up : F.w_gate) + (size_t)e * DM * FF, FF, f0, kb * 64, F.WGU() + ((size_t)e * 2048 + r0) * DM, DM}; }
    r -= I_GU;
    const int e = r / 512, q = r % 512, kb = q / 32, nb = q % 32;
    return TrItem{F.w_down + (size_t)e * FF * DM, DM, nb * 32, kb * 64, F.WD() + ((size_t)e * DM + nb * 32) * FF, FF};
}
DI void moe_convert(const Ctx& F, int it0, int it1) {
    if (F.c < MOE_IDLE_WG0) return;
    LAS float* scr = (LAS float*)(F.lds + F.wave * 8704);
    const int gw = (F.c - MOE_IDLE_WG0) * 8 + F.wave, NGW = (F.G - MOE_IDLE_WG0) * 8;
    for (int it = it0 + gw; it < it1; it += 2 * NGW) {
        const TrItem t0 = moe_item(F, it); f32x4 v0[8], v1[8]; tr_load(t0, F.lane, v0);
        const bool two = it + NGW < it1;
        const TrItem t1 = moe_item(F, two ? it + NGW : it);
        if (two) tr_load(t1, F.lane, v1);
        tr_store(t0, F.lane, v0, scr);
        if (two) tr_store(t1, F.lane, v1, scr);
    }
}

DI void phase_hrows(const Ctx& F) {
    LAS float* wdt = (LAS float*)F.lds;
    for (int i = F.tid; i < 16 * DM / 4; i += 512) *(LAS f32x4*)(wdt + 4 * i) = *(const f32x4*)(F.WDT() + 4 * i);
    LAS float* NW0 = wdt + 16 * DM; LAS float* SH1 = NW0 + DM; LAS float* SC1 = SH1 + 5 * DM;
    for (int i = F.tid; i < DM; i += 512) NW0[i] = F.norm_w[i];
    for (int i = F.tid; i < 5 * DM; i += 512) { const int r = i >> 10, k = i & 1023; SH1[i] = F.MOD()[r * 6144 + k]; SC1[i] = F.MOD()[r * 6144 + 1024 + k]; }
    asm volatile("s_waitcnt vmcnt(0)" ::: "memory");
    __syncthreads();
    const int gw = F.c * 8 + F.wave, NGW = F.G * 8, lane = F.lane;
#define HR_LOAD(XX, rw) do { if ((rw) < MTOT) { const float* xr = (rw) < MLAT ? F.x + (size_t)(rw) * DM : F.ctx + (size_t)((rw) - MLAT) * DM; \
        _Pragma("unroll") for (int j = 0; j < 4; ++j) XX[j] = *(const f32x4*)(xr + 4 * lane + 256 * j); } } while (0)
#define HR_NORM(V, XX, row) do { \
        const int r = (row) < MLAT ? (row) / SEQ : 4; float ss = 0.f; \
        _Pragma("unroll") for (int j = 0; j < 4; ++j) { V[j] = XX[j]; ss += V[j].x * V[j].x + V[j].y * V[j].y + V[j].z * V[j].z + V[j].w * V[j].w; } \
        const float rstd = rsqrtf(wave_sum(ss) * (1.f / DM) + EPS); \
        _Pragma("unroll") for (int j = 0; j < 4; ++j) { const int k = 4 * lane + 256 * j; \
            const f32x4 nw = *(const LAS f32x4*)(NW0 + k), sc = *(const LAS f32x4*)(SC1 + r * DM + k), sh = *(const LAS f32x4*)(SH1 + r * DM + k); \
            V[j] = V[j] * rstd * nw * (1.f + sc) + sh; \
            f16x4 o; o.x = (f16)V[j].x; o.y = (f16)V[j].y; o.z = (f16)V[j].z; o.w = (f16)V[j].w; \
            *(f16x4*)(F.H() + (size_t)(row) * DM + k) = o; } } while (0)
    {
        f32x4 xA[4], xB[4];
        HR_LOAD(xA, gw); HR_LOAD(xB, gw + NGW);
        for (int row = gw; row < MTOT; row += 2 * NGW) {
            const int rowb = row + NGW < MTOT ? row + NGW : row;
            f32x4 va[4], vb[4];
            HR_NORM(va, xA, row);
            if (row + NGW < MTOT) { HR_NORM(vb, xB, rowb); } else { _Pragma("unroll") for (int j = 0; j < 4; ++j) vb[j] = va[j]; }
            HR_LOAD(xA, row + 2 * NGW); HR_LOAD(xB, row + 3 * NGW);
            float pa[16], pb[16];
#pragma unroll
            for (int d = 0; d < 16; ++d) { float p = 0.f, q = 0.f;
#pragma unroll
                for (int j = 0; j < 4; ++j) { const f32x4 w = *(const LAS f32x4*)(wdt + d * DM + 4 * lane + 256 * j);
                    p += va[j].x * w.x + va[j].y * w.y + va[j].z * w.z + va[j].w * w.w; q += vb[j].x * w.x + vb[j].y * w.y + vb[j].z * w.z + vb[j].w * w.w; }
                pa[d] = p; pb[d] = q; if ((d & 3) == 3) __builtin_amdgcn_sched_barrier(0); }
            const float ta = reduce16(pa), tb = reduce16(pb);
            if (lane < 16) { F.DT()[(size_t)row * 16 + lane] = ta; F.DT()[(size_t)rowb * 16 + lane] = tb; }
        }
    }
#undef HR_NORM
#undef HR_LOAD
    __syncthreads();
}

DI void phase_conv(const Ctx& F) {
    const int tid = F.tid, cg = tid & 15, tg = tid >> 4, s0 = 8 * tg;
    constexpr int NUNIT = (MTOT / 256) * 8;
#define CV_LOAD(RAW, u) do { const int _rb = (u) >> 3, _cc = ((u) & 7) * 128 + cg * 8; const int _lo = _rb < MLAT / 256 ? (s0 & ~63) : 0, _hi = _rb < MLAT / 256 ? _lo + 64 : 256; \
        const f16* _base = F.U() + (size_t)_rb * 256 * NU + UXBC + _cc; \
        _Pragma("unroll") for (int i = 0; i < 12; ++i) { const int s = s0 - 2 + i; const bool ok = s >= _lo && s < _hi; \
            if (ok) RAW[i] = *(const f16x8*)(_base + (size_t)s * NU); else RAW[i] = (f16x8){0, 0, 0, 0, 0, 0, 0, 0}; } } while (0)
    int u = F.c; if (u >= NUNIT) return;
    f16x8 nraw[12]; CV_LOAD(nraw, u);
    for (; u < NUNIT; u += F.G) {
        const int rb = u >> 3, cb8 = u & 7, row0 = rb * 256, cc = cb8 * 128 + cg * 8;
        f16* base = F.U() + (size_t)row0 * NU + UXBC + cc;
        f16x8 raw[12];
#pragma unroll
        for (int i = 0; i < 12; ++i) raw[i] = nraw[i];
        float w[5][8], bb[8];
        { const f32x4 b0 = *(const f32x4*)(F.conv_b + cc), b1 = *(const f32x4*)(F.conv_b + cc + 4);
#pragma unroll
          for (int j = 0; j < 4; ++j) { bb[j] = b0[j]; bb[4 + j] = b1[j]; } }
#pragma unroll
        for (int tp = 0; tp < 5; ++tp) { const f32x4 w0 = *(const f32x4*)(F.conv_w + tp * 1024 + cc), w1 = *(const f32x4*)(F.conv_w + tp * 1024 + cc + 4);
#pragma unroll
            for (int j = 0; j < 4; ++j) { w[tp][j] = w0[j]; w[tp][4 + j] = w1[j]; } }
        if (u + F.G < NUNIT) CV_LOAD(nraw, u + F.G);
        f16x8 o[8];
#pragma unroll
        for (int t = 0; t < 8; ++t)
#pragma unroll
            for (int j = 0; j < 8; ++j) { float a = bb[j];
#pragma unroll
                for (int tp = 0; tp < 5; ++tp) a += w[tp][j] * (float)raw[t + tp][j];
                o[t][j] = (f16)silu_f(a); }
        __syncthreads();
#pragma unroll
        for (int t = 0; t < 8; ++t) *(f16x8*)(base + (size_t)(s0 + t) * NU) = o[t];
    }
#undef CV_LOAD
}

DI void phase_post(const Ctx& F) {
    LAS f16* wr16 = (LAS f16*)F.lds;
    for (int i = F.tid; i < DM * 16; i += 512) wr16[(i & 15) * DM + (i >> 4)] = (f16)F.w_router[i];
    LAS float* NW1 = (LAS float*)(F.lds + 32768); LAS float* NW2 = NW1 + DM; LAS float* G1 = NW2 + DM; LAS float* SH2 = G1 + 4 * DM; LAS float* SC2 = SH2 + 4 * DM;
    for (int i = F.tid; i < DM; i += 512) { NW1[i] = F.norm_w[1024 + i]; NW2[i] = F.norm_w[2048 + i]; }
    for (int i = F.tid; i < 4 * DM; i += 512) { const int b = i >> 10, k = i & 1023; G1[i] = F.MOD()[b * 6144 + 2048 + k]; SH2[i] = F.MOD()[b * 6144 + 3072 + k]; SC2[i] = F.MOD()[b * 6144 + 4096 + k]; }
    asm volatile("s_waitcnt vmcnt(0)" ::: "memory");
    __syncthreads();
    const int lane = F.lane, gw = F.c * 8 + F.wave, NGW = F.G * 8;
#define POST_LOAD(RR, XX, rw) do { if ((rw) < MLAT) { _Pragma("unroll") for (int j = 0; j < 4; ++j) { RR[j] = *(const f16x4*)(F.R() + (size_t)(rw) * DM + 4 * lane + 256 * j); XX[j] = *(const f32x4*)(F.x + (size_t)(rw) * DM + 4 * lane + 256 * j); } } } while (0)
#define POST_ROW(RR, XX, row) do { \
        const int b = (row) / SEQ; \
        int lo = 4 * lane; asm volatile("" : "+v"(lo)); \
        f32x4 r[4], xl[4]; float ss = 0.f; \
        _Pragma("unroll") for (int j = 0; j < 4; ++j) { const f16x4 rh = RR[j]; r[j] = (f32x4){(float)rh.x, (float)rh.y, (float)rh.z, (float)rh.w}; xl[j] = XX[j]; ss += r[j].x * r[j].x + r[j].y * r[j].y + r[j].z * r[j].z + r[j].w * r[j].w; } \
        POST_LOAD(RR, XX, (row) + 2 * NGW); \
        const float rstd = rsqrtf(wave_sum(ss) * (1.f / DM) + EPS); \
        float s2 = 0.f; \
        _Pragma("unroll") for (int j = 0; j < 4; ++j) { const int k = lo + 256 * j; \
            const f32x4 nw = *(const LAS f32x4*)(NW1 + k), gt = *(const LAS f32x4*)(G1 + b * DM + k); \
            xl[j] = xl[j] + gt * (r[j] * rstd * nw); \
            { f16x4 o; o.x = (f16)xl[j].x; o.y = (f16)xl[j].y; o.z = (f16)xl[j].z; o.w = (f16)xl[j].w; *(f16x4*)(F.XLAT() + (size_t)(row) * DM + k) = o; } \
            s2 += xl[j].x * xl[j].x + xl[j].y * xl[j].y + xl[j].z * xl[j].z + xl[j].w * xl[j].w; } \
        const float rstd2 = rsqrtf(wave_sum(s2) * (1.f / DM) + EPS); \
        _Pragma("unroll") for (int j = 0; j < 4; ++j) { const int k = lo + 256 * j; \
            const f32x4 nw = *(const LAS f32x4*)(NW2 + k), sh = *(const LAS f32x4*)(SH2 + b * DM + k), sc = *(const LAS f32x4*)(SC2 + b * DM + k); \
            const f32x4 hv = xl[j] * rstd2 * nw * (1.f + sc) + sh; \
            f16x4 o; o.x = (f16)hv.x; o.y = (f16)hv.y; o.z = (f16)hv.z; o.w = (f16)hv.w; \
            *(f16x4*)(F.H2() + (size_t)(row) * DM + k) = o; } } while (0)
    {
        f16x4 rA[4], rB[4]; f32x4 xA[4], xB[4];
        POST_LOAD(rA, xA, gw); POST_LOAD(rB, xB, gw + NGW);
        for (int row = gw; row < MLAT; row += 2 * NGW) { POST_ROW(rA, xA, row); if (row + NGW < MLAT) POST_ROW(rB, xB, row + NGW); }
    }
#undef POST_LOAD
#undef POST_ROW
    asm volatile("s_waitcnt vmcnt(0)" ::: "memory");
    {
        const int fr = lane & 15, fq = lane >> 4;
        const f16* arow = F.H2() + (size_t)(gw + fr * NGW) * DM + 8 * fq;
        f32x4 acc = (f32x4){0, 0, 0, 0};
#pragma unroll 8
        for (int kk = 0; kk < 32; ++kk)
            acc = __builtin_amdgcn_mfma_f32_16x16x32_f16(*(const f16x8*)(arow + 32 * kk), *(const LAS f16x8*)(wr16 + fr * DM + 32 * kk + 8 * fq), acc, 0, 0, 0);
#pragma unroll
        for (int r = 0; r < 4; ++r) {
            float mx = acc[r];
#pragma unroll
            for (int o = 1; o < 16; o <<= 1) mx = fmaxf(mx, __shfl_xor(mx, o));
            const float ex = __expf(acc[r] - mx);
            float den = ex;
#pragma unroll
            for (int o = 1; o < 16; o <<= 1) den += __shfl_xor(den, o);
            const int row = gw + (4 * fq + r) * NGW, b = row / SEQ, t = row % SEQ;
            F.AFF()[((size_t)b * 16 + fr) * SEQ + t] = ex * __builtin_amdgcn_rcpf(den);
        }
    }
    __syncthreads();
}

DI void phase_topk(const Ctx& F) {
    if (F.c >= 64) return;
    LAS unsigned* vals = (LAS unsigned*)F.lds;
    LAS unsigned* hist = vals + SEQ;
    LAS unsigned* sm = hist + 256;
    const int be = F.c, tid = F.tid;
    const float* a = F.AFF() + (size_t)be * SEQ;
    for (int i = tid; i < SEQ; i += 512) vals[i] = __float_as_uint(a[i]);
    if (tid == 0) { sm[0] = 0u; sm[1] = CAP; }
    __syncthreads();
    unsigned mask = 0u;
    for (int pass = 0; pass < 4; ++pass) {
        const int shift = 24 - 8 * pass;
        if (tid < 256) hist[tid] = 0u;
        __syncthreads();
        const unsigned prefix = sm[0];
        for (int i = tid; i < SEQ; i += 512) { const unsigned v = vals[i]; if ((v & mask) == prefix) atomicAdd((unsigned*)&hist[(v >> shift) & 255u], 1u); }
        __syncthreads();
        {
            const unsigned kcur = sm[1];
            unsigned hv = 0u, suf = 0u;
            if (tid < 256) { hv = hist[255 - tid]; suf = hv;
                for (int o = 1; o < 64; o <<= 1) { const unsigned tt = __shfl_up(suf, o); if ((tid & 63) >= o) suf += tt; }
                if ((tid & 63) == 63) sm[18 + (tid >> 6)] = suf; }
            __syncthreads();
            if (tid < 256) { for (int i = 0; i < (tid >> 6); ++i) suf += sm[18 + i];
                if (suf >= kcur && suf - hv < kcur) { sm[1] = kcur - (suf - hv); sm[0] = prefix | ((unsigned)(255 - tid) << shift); } }
        }
        mask |= 255u << shift;
        __syncthreads();
    }
    const unsigned T = sm[0], keq = sm[1];
    unsigned cg = 0, ce = 0;
    for (int j = 0; j < 16; ++j) { const unsigned v = vals[tid * 16 + j]; cg += v > T; ce += v == T; }
    const int lane = tid & 63, w = tid >> 6;
    unsigned ig = cg, ie = ce;
    for (int o = 1; o < 64; o <<= 1) { const unsigned tg = __shfl_up(ig, o), te = __shfl_up(ie, o); if (lane >= o) { ig += tg; ie += te; } }
    if (lane == 63) { sm[2 + w] = ig; sm[10 + w] = ie; }
    __syncthreads();
    unsigned og = 0, oe = 0;
    for (int i = 0; i < w; ++i) { og += sm[2 + i]; oe += sm[10 + i]; }
    unsigned pg = og + ig - cg, pe = oe + ie - ce;
    const int rowbase = ((be & 15) * 4 + (be >> 4)) * CAP;
    for (int j = 0; j < 16; ++j) {
        const int t = tid * 16 + j; const unsigned v = vals[t];
        int slot = -1;
        if (v > T) { slot = (int)(pg + (pe < keq ? pe : keq)); pg++; }
        else if (v == T) { if (pe < keq) slot = (int)(pg + pe); pe++; }
        F.SLOT()[(size_t)be * SEQ + t] = slot;
        if (slot >= 0) { F.IDX()[rowbase + slot] = t; F.GATEV()[rowbase + slot] = __uint_as_float(v); }
    }
    __syncthreads();
}

DI void phase_combine(const Ctx& F) {
    LAS float* NW3 = (LAS float*)F.lds; LAS float* G2 = NW3 + DM;
    for (int i = F.tid; i < DM; i += 512) NW3[i] = F.norm_w[3072 + i];
    for (int i = F.tid; i < 4 * DM; i += 512) G2[i] = F.MOD()[(i >> 10) * 6144 + 5120 + (i & 1023)];
    asm volatile("s_waitcnt vmcnt(0)" ::: "memory");
    __syncthreads();
    const int lane = F.lane, gw = F.c * 8 + F.wave, NGW = F.G * 8;
    if (gw >= MLAT) return;
#define CB_LOADSX(S, X, rw) do { const int _r = (rw) < MLAT ? (rw) : gw; const int _b = _r / SEQ, _t = _r % SEQ; \
        S = F.SLOT()[((size_t)_b * 16 + (lane & 15)) * SEQ + _t]; \
        _Pragma("unroll") for (int j = 0; j < 4; ++j) X[j] = *(const f16x4*)(F.XLAT() + (size_t)_r * DM + 4 * lane + 256 * j); } while (0)
#define CB_LOADY(Y, S, M, rw) do { const int _r = (rw) < MLAT ? (rw) : gw; const int _b = _r / SEQ; unsigned _m = (M); \
        _Pragma("unroll") for (int q = 0; q < 4; ++q) { const bool _has = _m != 0u; const int _e = _has ? __builtin_ctz(_m) : 0; _m &= _m - 1u; \
            const int _s = __shfl(S, _e); const size_t _ro = _has ? (size_t)((_e * 4 + _b) * CAP + _s) : 0; \
            _Pragma("unroll") for (int j = 0; j < 4; ++j) Y[q][j] = *(const f16x4*)(F.YM() + _ro * DM + 4 * lane + 256 * j); } } while (0)
    int s0, s1, s2; f16x4 x0[4], x1[4], x2[4]; f16x4 y0[4][4], y1[4][4];
    CB_LOADSX(s0, x0, gw); CB_LOADSX(s1, x1, gw + NGW);
    unsigned m0 = (unsigned)(__ballot(s0 >= 0) & 0xffffull), m1;
    CB_LOADY(y0, s0, m0, gw);
    for (int row = gw; row < MLAT; row += NGW) {
        CB_LOADSX(s2, x2, row + 2 * NGW);
        m1 = (unsigned)(__ballot(s1 >= 0) & 0xffffull);
        CB_LOADY(y1, s1, m1, row + NGW);
        const int b = row / SEQ;
        f32x4 acc[4];
#pragma unroll
        for (int j = 0; j < 4; ++j) acc[j] = (f32x4){0, 0, 0, 0};
        { unsigned m = m0;
#pragma unroll
          for (int q = 0; q < 4; ++q) { const float on = m != 0u ? 1.f : 0.f; m &= m - 1u;
#pragma unroll
              for (int j = 0; j < 4; ++j) { acc[j].x += on * (float)y0[q][j].x; acc[j].y += on * (float)y0[q][j].y; acc[j].z += on * (float)y0[q][j].z; acc[j].w += on * (float)y0[q][j].w; } }
          while (m) {
              const int e = __builtin_ctz(m); m &= m - 1u; const int s = __shfl(s0, e);
              const f16* yr = F.YM() + (size_t)((e * 4 + b) * CAP + s) * DM + 4 * lane;
#pragma unroll
              for (int j = 0; j < 4; ++j) { const f16x4 v = *(const f16x4*)(yr + 256 * j); acc[j].x += (float)v.x; acc[j].y += (float)v.y; acc[j].z += (float)v.z; acc[j].w += (float)v.w; } } }
        float ss = 0.f;
#pragma unroll
        for (int j = 0; j < 4; ++j) ss += acc[j].x * acc[j].x + acc[j].y * acc[j].y + acc[j].z * acc[j].z + acc[j].w * acc[j].w;
        const float rstd = rsqrtf(wave_sum(ss) * (1.f / DM) + EPS);
#pragma unroll
        for (int j = 0; j < 4; ++j) {
            const int k = 4 * lane + 256 * j;
            const f32x4 nw = *(const LAS f32x4*)(NW3 + k), gt = *(const LAS f32x4*)(G2 + b * DM + k);
            const f32x4 xl = (f32x4){(float)x0[j].x, (float)x0[j].y, (float)x0[j].z, (float)x0[j].w};
            *(f32x4*)(F.out + (size_t)row * DM + k) = xl + gt * (acc[j] * rstd * nw);
        }
        s0 = s1; s1 = s2; m0 = m1;
#pragma unroll
        for (int j = 0; j < 4; ++j) { x0[j] = x1[j]; x1[j] = x2[j]; }
#pragma unroll
        for (int q = 0; q < 4; ++q)
#pragma unroll
            for (int j = 0; j < 4; ++j) y0[q][j] = y1[q][j];
    }
#undef CB_LOADSX
#undef CB_LOADY
}

#ifndef PROBE_PH
#define PROBE_PH -1
#endif

namespace mx {
DI int swz(int row, int chunk) { return row * 256 + ((chunk ^ (row & 15)) << 4); }
template <bool TR>
DI void load_tile(const f16* U, int row0, int s0, int ucol, LAS unsigned char* T, int rbase, int chunk) {
    f16x8 raw[8];
#pragma unroll
    for (int t = 0; t < 8; ++t) raw[t] = *(const f16x8*)(U + (size_t)(row0 + s0 + t) * NU + ucol);
    if (!TR) {
#pragma unroll
        for (int t = 0; t < 8; ++t) *(LAS f16x8*)(T + swz(rbase + t, chunk)) = raw[t];
    } else {
#pragma unroll
        for (int j = 0; j < 8; ++j) { f16x8 v;
#pragma unroll
            for (int t = 0; t < 8; ++t) v[t] = raw[t][j];
            *(LAS f16x8*)(T + swz(rbase + j, chunk)) = v; }
    }
}
DI void scan128(float a0, float a1, float& c0, float& c1, float& tot) {
    float p = a0 + a1;
#pragma unroll
    for (int o = 1; o < 64; o <<= 1) { const float t = __shfl_up(p, o); if ((int)(threadIdx.x & 63) >= o) p += t; }
    c1 = p; c0 = p - a1; tot = __shfl(p, 63);
}
constexpr size_t SSD_SLOT = 8192;
DI size_t ssd_sid(int b, int ck, int h, int dir) { return (size_t)(((b * 66 + ck) * 8 + h) * 2 + dir); }

struct SsaPre { f16x8 raw[8]; float d0, d1; };
DI void ssa_ids(int u, int& b, int& ck, int& h) { b = u / (66 * 8); ck = (u / 8) % 66; h = u & 7; }
DI int ssa_row0(int b, int ck) { return ck < 2 ? MLAT + b * CTXL + 128 * ck : b * SEQ + 128 * (ck - 2); }
DI void ssa_prefetch(const Ctx& F, int u, SsaPre& P) {
    int b, ck, h; ssa_ids(u, b, ck, h);
    const int tid = F.tid, row0 = ssa_row0(b, ck), g = h >> 2;
    if (tid < 384) {
        const int tr = tid & 15, g8 = tid >> 4;
        const int ucol = g8 < 8 ? UXBC + h * 64 + 8 * g8 : UXBC + 512 + g * 128 + 8 * (g8 - 8);
#pragma unroll
        for (int t = 0; t < 8; ++t) P.raw[t] = *(const f16x8*)(F.U() + (size_t)(row0 + 8 * tr + t) * NU + ucol);
    } else {
        const int s = tid - 384;
        P.d0 = F.DT()[(size_t)(row0 + s) * 16 + h]; P.d1 = F.DT()[(size_t)(row0 + s) * 16 + 8 + h];
    }
}
DI void ssd_a_phase(const Ctx& F, f16* ST, float* TOTS) {
    const int tid = F.tid, lane = F.lane;
    LAS unsigned char* XT = F.lds;
    LAS unsigned char* BT = F.lds + 64 * 256;
    LAS float* dtA = (LAS float*)(F.lds + 192 * 256);
    LAS float* laA = dtA + 256;
    LAS f16* w16 = (LAS f16*)(laA + 256);
    int u = F.c; if (u >= 2112) return;
    const int hq = u & 7;
    const float dtb0 = F.dt_bias[hq], dtb1 = F.dt_bias[8 + hq], an0 = -__expf(F.a_log[hq]), an1 = -__expf(F.a_log[8 + hq]);
    SsaPre P; ssa_prefetch(F, u, P);
    for (; u < 2112; u += F.G) {
        int b, ck, h; ssa_ids(u, b, ck, h);
        if (tid < 384) {
            const int tr = tid & 15, g8 = tid >> 4;
            LAS unsigned char* T = g8 < 8 ? XT : BT; const int rbase = g8 < 8 ? 8 * g8 : 8 * (g8 - 8);
#pragma unroll
            for (int j = 0; j < 8; ++j) { f16x8 v;
#pragma unroll
                for (int t = 0; t < 8; ++t) v[t] = P.raw[t][j];
                *(LAS f16x8*)(T + swz(rbase + j, tr)) = v; }
        } else {
            const int s = tid - 384;
            const float da = softplus_f(P.d0 + dtb0), db = softplus_f(P.d1 + dtb1);
            dtA[s] = da; laA[s] = da * an0; dtA[128 + s] = db; laA[128 + s] = db * an1;
        }
        if (u + F.G < 2112) ssa_prefetch(F, u + F.G, P);
        __syncthreads();
        if (F.wave < 2) {
            const int dir = F.wave; const float a0 = laA[dir * 128 + 2 * lane], a1 = laA[dir * 128 + 2 * lane + 1];
            float c0, c1, tot; scan128(a0, a1, c0, c1, tot);
            const float e0 = dir == 0 ? tot - c0 : c0 - a0, e1 = dir == 0 ? tot - c1 : c1 - a1;
            w16[dir * 128 + 2 * lane] = (f16)(dtA[dir * 128 + 2 * lane] * __expf(e0));
            w16[dir * 128 + 2 * lane + 1] = (f16)(dtA[dir * 128 + 2 * lane + 1] * __expf(e1));
            if (lane == 0) TOTS[ssd_sid(b, ck, h, dir)] = __expf(tot);
        }
        __syncthreads();
        {
            int t2 = tid; asm volatile("" : "+v"(t2));
            const int lane2 = t2 & 63, fr = lane2 & 15, fq = lane2 >> 4, wv = __builtin_amdgcn_readfirstlane(t2 >> 6);
            const int dir = wv & 1, ntp = wv >> 1;
            f32x4 acc[2][4];
#pragma unroll
            for (int i = 0; i < 2; ++i)
#pragma unroll
                for (int j = 0; j < 4; ++j) acc[i][j] = (f32x4){0, 0, 0, 0};
#pragma unroll
            for (int kk = 0; kk < 4; ++kk) {
                const f16x8 wv8 = *(const LAS f16x8*)(w16 + dir * 128 + 32 * kk + 8 * fq);
                f16x8 a[2], bf[4];
#pragma unroll
                for (int nt = 0; nt < 2; ++nt) a[nt] = *(const LAS f16x8*)(BT + swz(16 * (2 * ntp + nt) + fr, 4 * kk + fq)) * wv8;
#pragma unroll
                for (int pt = 0; pt < 4; ++pt) bf[pt] = *(const LAS f16x8*)(XT + swz(16 * pt + fr, 4 * kk + fq));
#pragma unroll
                for (int nt = 0; nt < 2; ++nt)
#pragma unroll
                    for (int pt = 0; pt < 4; ++pt) acc[nt][pt] = __builtin_amdgcn_mfma_f32_16x16x32_f16(a[nt], bf[pt], acc[nt][pt], 0, 0, 0);
            }
            f16* S = ST + ssd_sid(b, ck, h, dir) * SSD_SLOT;
#pragma unroll
            for (int nt = 0; nt < 2; ++nt)
#pragma unroll
                for (int pt = 0; pt < 4; ++pt) { f16x4 o; o.x = (f16)acc[nt][pt].x; o.y = (f16)acc[nt][pt].y; o.z = (f16)acc[nt][pt].z; o.w = (f16)acc[nt][pt].w;
                    *(f16x4*)(S + (size_t)(16 * pt + fr) * 128 + 16 * (2 * ntp + nt) + 4 * fq) = o; }
        }
        __syncthreads();
    }
}

DI void ssd_b(const Ctx& F, f16* ST, const float* TOTS) {
    const int idx = F.c * 512 + F.tid; if (idx >= 64 * 2048) return;
    const int e = idx & 2047, chain = idx >> 11, dir = chain & 1, h = (chain >> 1) & 7, b = chain >> 4;
    float run[4] = {0.f, 0.f, 0.f, 0.f};
    for (int s0 = 0; s0 < 66; s0 += 6) {
        f16x4 loc[6]; float d[6]; f16* p[6];
#pragma unroll
        for (int i = 0; i < 6; ++i) { const int st = s0 + i; const int ck = dir == 0 ? st : (st < 2 ? 1 - st : 67 - st);
            const size_t sid = ssd_sid(b, ck, h, dir); p[i] = ST + sid * SSD_SLOT + (size_t)e * 4; loc[i] = *(const f16x4*)p[i]; d[i] = TOTS[sid]; }
#pragma unroll
        for (int i = 0; i < 6; ++i) { f16x4 o; o.x = (f16)run[0]; o.y = (f16)run[1]; o.z = (f16)run[2]; o.w = (f16)run[3]; *(f16x4*)p[i] = o;
            run[0] = d[i] * run[0] + (float)loc[i].x; run[1] = d[i] * run[1] + (float)loc[i].y; run[2] = d[i] * run[2] + (float)loc[i].z; run[3] = d[i] * run[3] + (float)loc[i].w; }
    }
}

DI void ssd_c_unit(const Ctx& F, const f16* ST, int b, int c, int g) {
    const int tid = F.tid, lane = F.lane;
    const int row0 = b * SEQ + 128 * c;
    LAS unsigned char* CT = F.lds;
    LAS unsigned char* BM = F.lds + 128 * 256;
    LAS unsigned char* XT = F.lds + 256 * 256;
    LAS float* dtA = (LAS float*)(F.lds + 131072);
    LAS float* csA = dtA + 1024;
    {
        const int trx = tid & 15, g8x = tid >> 4;
        const int g8b = tid & 31, trb = tid >> 5;
        f16x8 rx[8], rb[8]; float dv[2];
        const f16* px = F.U() + (size_t)(row0 + 8 * trx) * NU + UXBC + g * 256 + 8 * g8x;
        const f16* pb = F.U() + (size_t)(row0 + 8 * trb) * NU + UXBC + 512 + (g8b >> 4) * 256 + g * 128 + 8 * (g8b & 15);
#pragma unroll
        for (int t = 0; t < 8; ++t) { rx[t] = *(const f16x8*)(px + (size_t)t * NU); rb[t] = *(const f16x8*)(pb + (size_t)t * NU); }
#pragma unroll
        for (int q = 0; q < 2; ++q) { const int idx = tid + 512 * q, s = idx & 127, hd = idx >> 7; dv[q] = F.DT()[(size_t)(row0 + s) * 16 + (hd & 1) * 8 + g * 4 + (hd >> 1)]; }
#pragma unroll
        for (int j = 0; j < 8; ++j) { f16x8 v;
#pragma unroll
            for (int t = 0; t < 8; ++t) v[t] = rx[t][j];
            *(LAS f16x8*)(XT + swz(8 * g8x + j, trx)) = v; }
        LAS unsigned char* T = g8b < 16 ? BM : CT;
#pragma unroll
        for (int t = 0; t < 8; ++t) *(LAS f16x8*)(T + swz(8 * trb + t, g8b & 15)) = rb[t];
#pragma unroll
        for (int q = 0; q < 2; ++q) { const int idx = tid + 512 * q, s = idx & 127, hd = idx >> 7, hh = hd >> 1, dir = hd & 1, h = g * 4 + hh;
            const float d = softplus_f(dv[q] + F.dt_bias[dir * 8 + h]);
            dtA[hd * 128 + s] = d; csA[hd * 128 + s] = -d * __expf(F.a_log[dir * 8 + h]); }
    }
    __syncthreads();
    {
        const int wv = F.wave;
        const float a0 = csA[wv * 128 + 2 * lane], a1 = csA[wv * 128 + 2 * lane + 1];
        float c0, c1, tot; scan128(a0, a1, c0, c1, tot);
        if (wv & 1) { c0 = tot - c0 + a0; c1 = tot - c1 + a1; }
        csA[wv * 128 + 2 * lane] = c0; csA[wv * 128 + 2 * lane + 1] = c1;
    }
    __syncthreads();
    int t2 = tid; asm volatile("" : "+v"(t2));
    const int lane2 = t2 & 63, fr = lane2 & 15, fq = lane2 >> 4, w = __builtin_amdgcn_readfirstlane(t2 >> 6);
    const int l0 = 16 * w + fr;
    f16x8 cfr[4];
#pragma unroll
    for (int kk = 0; kk < 4; ++kk) cfr[kk] = *(const LAS f16x8*)(CT + swz(l0, 4 * kk + fq));
    f32x4 gacc[8];
#pragma unroll
    for (int st = 0; st < 8; ++st) { gacc[st] = (f32x4){0, 0, 0, 0};
#pragma unroll
        for (int kk = 0; kk < 4; ++kk) gacc[st] = __builtin_amdgcn_mfma_f32_16x16x32_f16(*(const LAS f16x8*)(BM + swz(16 * st + fr, 4 * kk + fq)), cfr[kk], gacc[st], 0, 0, 0); }
    float dsk4 = F.ssd_d[g * 4 + (lane2 & 3)]; asm volatile("s_waitcnt vmcnt(0)" : "+v"(dsk4) :: "memory");
    __syncthreads();
#define SSD_RING_ISSUE(q) do { const f16* _S = ST + ssd_sid(b, c + 2, g * 4 + ((q) >> 1), (q) & 1) * SSD_SLOT; \
        _Pragma("unroll") for (int _p = 0; _p < 2; ++_p) { const int _o = (w * 2 + _p) * 1024 + lane2 * 16, _row = _o >> 8, _pch = (_o >> 4) & 15, _lch = _pch ^ (_row & 15); \
            __builtin_amdgcn_global_load_lds((const unsigned*)((const char*)_S + _row * 256 + _lch * 16), (LAS unsigned*)(CT + ((q) & 3) * 16384 + (w * 2 + _p) * 1024), 16, 0, 0); } } while (0)
    SSD_RING_ISSUE(0); SSD_RING_ISSUE(1); SSD_RING_ISSUE(2); SSD_RING_ISSUE(3);
#pragma unroll 1
    for (int hh = 0; hh < 4; ++hh) {
        int l = l0; asm volatile("" : "+v"(l));
        const LAS float* dtf = dtA + (2 * hh) * 128, *dtb = dtA + (2 * hh + 1) * 128, *csf = csA + (2 * hh) * 128, *rcb = csA + (2 * hh + 1) * 128;
        const float csf_l = csf[l], rcb_l = rcb[l], dsum_l = dtf[l] + dtb[l], dskip = __shfl(dsk4, hh);
        f32x4 yacc[4];
#pragma unroll
        for (int pt = 0; pt < 4; ++pt) yacc[pt] = (f32x4){0, 0, 0, 0};
#pragma unroll
        for (int kk = 0; kk < 4; ++kk) {
            f16x8 m;
#pragma unroll
            for (int hf = 0; hf < 2; ++hf) { const int st = 2 * kk + hf, sb = 16 * st + 4 * fq;
                const f32x4 cf = *(const LAS f32x4*)(csf + sb), rb = *(const LAS f32x4*)(rcb + sb), df = *(const LAS f32x4*)(dtf + sb), db = *(const LAS f32x4*)(dtb + sb);
#pragma unroll
                for (int r = 0; r < 4; ++r) { const int s = sb + r;
                    const float arg = s < l ? csf_l - cf[r] : (s > l ? rcb_l - rb[r] : 0.f);
                    const float dsel = s < l ? df[r] : (s > l ? db[r] : dsum_l);
                    float val = gacc[st][r] * __expf(arg) * dsel; if (s == l) val += dskip;
                    m[hf * 4 + r] = (f16)val; } }
            __builtin_amdgcn_sched_barrier(0);
#pragma unroll
            for (int pt = 0; pt < 4; ++pt) { const int p = 64 * hh + 16 * pt + fr;
                const f16x4 x0 = *(const LAS f16x4*)(XT + swz(p, 4 * kk + (fq >> 1)) + 8 * (fq & 1));
                const f16x4 x1 = *(const LAS f16x4*)(XT + swz(p, 4 * kk + 2 + (fq >> 1)) + 8 * (fq & 1));
                f16x8 xf; xf[0] = x0[0]; xf[1] = x0[1]; xf[2] = x0[2]; xf[3] = x0[3]; xf[4] = x1[0]; xf[5] = x1[1]; xf[6] = x1[2]; xf[7] = x1[3];
                yacc[pt] = __builtin_amdgcn_mfma_f32_16x16x32_f16(xf, m, yacc[pt], 0, 0, 0); }
            __builtin_amdgcn_sched_barrier(0);
        }
        if (hh == 0) asm volatile("s_waitcnt vmcnt(4)" ::: "memory"); else if (hh == 3) asm volatile("s_waitcnt vmcnt(0)" ::: "memory"); else asm volatile("s_waitcnt vmcnt(4)" ::: "memory");
        bar_lds();
#pragma unroll
        for (int dir = 0; dir < 2; ++dir) {
            const LAS unsigned char* SL = CT + ((2 * hh + dir) & 3) * 16384;
            f32x4 off[4];
#pragma unroll
            for (int pt = 0; pt < 4; ++pt) off[pt] = (f32x4){0, 0, 0, 0};
#pragma unroll
            for (int kk = 0; kk < 4; ++kk)
#pragma unroll
                for (int pt = 0; pt < 4; ++pt) off[pt] = __builtin_amdgcn_mfma_f32_16x16x32_f16(*(const LAS f16x8*)(SL + swz(16 * pt + fr, 4 * kk + fq)), cfr[kk], off[pt], 0, 0, 0);
            const float e = __expf(dir == 0 ? csf_l : rcb_l);
#pragma unroll
            for (int pt = 0; pt < 4; ++pt) yacc[pt] += off[pt] * e;
        }
        bar_lds();
        if (hh < 2) { SSD_RING_ISSUE(2 * hh + 4); SSD_RING_ISSUE(2 * hh + 5); }
        { LAS unsigned char* stg = XT + hh * 16384 + w * 2048;
#pragma unroll
          for (int pt = 0; pt < 4; ++pt) { f16x4 o; o.x = (f16)yacc[pt].x; o.y = (f16)yacc[pt].y; o.z = (f16)yacc[pt].z; o.w = (f16)yacc[pt].w;
              *(LAS f16x4*)(stg + fr * 128 + (16 * pt + 4 * fq) * 2) = o; } }
    }
#undef SSD_RING_ISSUE
    {
        asm volatile("s_waitcnt lgkmcnt(0)" ::: "memory");
        const int tp = lane2 >> 5, ch = lane2 & 31, hd = ch >> 3, cw = ch & 7;
        const LAS unsigned char* stg = XT + hd * 16384 + w * 2048 + cw * 16;
        f16x8 zv[8];
#pragma unroll
        for (int i = 0; i < 8; ++i) zv[i] = *(const f16x8*)(F.U() + (size_t)(row0 + 16 * w + 2 * i + tp) * NU + UZ + g * 256 + 8 * ch);
        const f32x4 nw0 = *(const f32x4*)(F.ssd_nw + g * 256 + 8 * ch), nw1 = *(const f32x4*)(F.ssd_nw + g * 256 + 8 * ch + 4);
#pragma unroll
        for (int i = 0; i < 8; ++i) {
            const f16x8 yv = *(const LAS f16x8*)(stg + (2 * i + tp) * 128);
            float gv[8]; float ss = 0.f;
#pragma unroll
            for (int j = 0; j < 8; ++j) { gv[j] = (float)yv[j] * silu_f((float)zv[i][j]); ss += gv[j] * gv[j]; }
#pragma unroll
            for (int o = 1; o < 32; o <<= 1) ss += __shfl_xor(ss, o);
            const float rstd = rsqrtf(ss * (1.f / 256.f) + EPS);
            f16x8 ov;
#pragma unroll
            for (int j = 0; j < 4; ++j) { ov[j] = (f16)(gv[j] * rstd * nw0[j]); ov[4 + j] = (f16)(gv[4 + j] * rstd * nw1[j]); }
            *(f16x8*)(F.Y() + (size_t)(row0 + 16 * w + 2 * i + tp) * DM + g * 256 + 8 * ch) = ov;
        }
    }
    __syncthreads();
}
}

namespace mx {
typedef short s16x8 __attribute__((ext_vector_type(8)));
typedef float f32x2 __attribute__((ext_vector_type(2)));
DI int swz64(int row, int chunk) { return row * 128 + ((chunk ^ ((row >> 1) & 7)) << 4); }
DI unsigned short f2bf(float f) { unsigned u = __builtin_bit_cast(unsigned, f); return (unsigned short)((u + 0x7fffu + ((u >> 16) & 1u)) >> 16); }
constexpr size_t HG_SLOT = 16384;
DI size_t hg_sid(int b, int ck, int h, int dir) { return (size_t)(((b * 132 + ck) * 4 + h) * 2 + dir); }
DI f16* hg_slot(f16* HCT, f16* HLAT, int b, int ck, int h, int dir) {
    return ck < 4 ? HCT + (size_t)(((b * 4 + ck) * 4 + h) * 2 + dir) * HG_SLOT : HLAT + (size_t)(((b * 128 + (ck - 4)) * 4 + h) * 2 + dir) * HG_SLOT;
}
template <int NCH>
DI void load_raw(const Ctx& F, int row0, int ucol, LAS unsigned char* RAW) {
    constexpr int CPR = NCH / 8;
    for (int i = F.tid; i < 64 * CPR; i += 512) { const int t = i / CPR, cch = i % CPR;
        *(LAS f16x8*)(RAW + (t * NCH + cch * 8) * 2) = *(const f16x8*)(F.U() + (size_t)(row0 + t) * NU + ucol + cch * 8); }
}
DI void load_vt(const Ctx& F, int row0, int h, LAS unsigned char* VT) {
    const int i = F.tid & 31, g8 = F.tid >> 5;
    const f16x8 a = *(const f16x8*)(F.U() + (size_t)(row0 + 2 * i) * NU + UI + h * 128 + 8 * g8);
    const f16x8 b = *(const f16x8*)(F.U() + (size_t)(row0 + 2 * i + 1) * NU + UI + h * 128 + 8 * g8);
#pragma unroll
    for (int j = 0; j < 8; ++j) { typedef _Float16 h2 __attribute__((ext_vector_type(2))); h2 p; p.x = a[j]; p.y = b[j];
        *(LAS h2*)(VT + swz64(8 * g8 + j, i >> 2) + (i & 3) * 4) = p; }
}

template <int T0, int SGN>
DI float hg_gates(const LAS f16* rf, float lb, float (&f)[32]) {
    float prod = 1.f;
#pragma unroll
    for (int i = 0; i < 32; ++i) { const int t = T0 + SGN * i; f[i] = lb + (1.f - lb) * sigmoid_f((float)rf[t * 128]); prod *= f[i]; }
    return prod;
}
template <int T0, int SGN>
DI void hg_a_write(const float (&f)[32], float R, LAS unsigned char* T, int k) {
    f16 v[32];
#pragma unroll
    for (int i = 0; i < 32; ++i) { v[i] = (f16)((1.f - f[i]) * R); R *= f[i]; }
#pragma unroll
    for (int j = 0; j < 4; ++j) { f16x8 o;
#pragma unroll
        for (int q = 0; q < 8; ++q) { const int t = (T0 < 32 ? 0 : 32) + 8 * j + q; const int i = SGN > 0 ? t - T0 : T0 - t; o[q] = v[i]; }
        const int ch = ((T0 < 32 ? 0 : 32) >> 3) + j;
        *(LAS f16x8*)(T + k * 128 + ((ch ^ ((k >> 1) & 7)) << 4)) = o; }
}
template <int T0, int SGN>
DI void hg_c_write(const float (&f)[32], float P, const LAS f16* rq, LAS unsigned char* TQ, LAS unsigned char* TK, int k) {
    const int cb = (k & 7) * 2, cx = (k >> 3) << 4;
#pragma unroll
    for (int i = 0; i < 32; ++i) { const int t = T0 + SGN * i; P *= f[i];
        const float qv = silu_f((float)rq[t * 128]);
        const int off = t * 256 + (cx ^ ((t & 15) << 4)) + cb;
        *(LAS unsigned short*)(TQ + off) = f2bf(qv * P);
        *(LAS unsigned short*)(TK + off) = f2bf((1.f - f[i]) * __builtin_amdgcn_rcpf(P)); }
}

typedef _Float16 f16x2 __attribute__((ext_vector_type(2)));
struct HgaPre { unsigned rf[16]; f16x8 va, vb; };
DI void hga_ids(int v, int& b, int& ck, int& h) { b = v / (132 * 4); ck = (v / 4) % 132; h = v & 3; }
DI int hga_row0(int b, int ck) { return ck < 4 ? MLAT + b * CTXL + 64 * ck : b * SEQ + 64 * (ck - 4); }
DI void hga_prefetch(const Ctx& F, int v, HgaPre& P) {
    int b, ck, h; hga_ids(v, b, ck, h);
    const int tid = F.tid, row0 = hga_row0(b, ck);
    const int kp = tid & 63, dir = (tid >> 6) & 1, qq = tid >> 7;
    const int T0 = dir == 0 ? 16 * qq : 63 - 16 * qq, SG = dir == 0 ? 1 : -1;
    const f16* pf = F.U() + (size_t)(row0 + T0) * NU + (dir ? UFB : UFF) + h * 128 + 2 * kp;
    const long st = (long)SG * NU;
#pragma unroll
    for (int i = 0; i < 16; ++i) P.rf[i] = *(const unsigned*)(pf + i * st);
    const int pi = tid & 31, g8 = tid >> 5;
    P.va = *(const f16x8*)(F.U() + (size_t)(row0 + 2 * pi) * NU + UI + h * 128 + 8 * g8);
    P.vb = *(const f16x8*)(F.U() + (size_t)(row0 + 2 * pi + 1) * NU + UI + h * 128 + 8 * g8);
}
DI void hg_a_phase(const Ctx& F, f16* HCT, f16* HLAT, float* DEC) {
    LAS unsigned char* KD = F.lds;
    LAS unsigned char* VT = F.lds + 32768;
    LAS float* PX = (LAS float*)(F.lds + 49152);
    const int tid = F.tid;
    int v = (F.c + 64) % F.G; if (v >= 2112) return;
    float lbw[2];
    { const int kp = tid & 63, dir = (tid >> 6) & 1, ch = (v & 3) * 128 + 2 * kp;
#pragma unroll
      for (int e = 0; e < 2; ++e) { const float l0 = F.hgrn_lb[dir * 512 + ch + e], l1 = F.hgrn_lb[1024 + dir * 512 + ch + e]; lbw[e] = __builtin_amdgcn_rcpf(1.f + __expf(l1 - l0)); } }
    HgaPre P; hga_prefetch(F, v, P);
    for (; v < 2112; v += F.G) {
        int b, ck, h; hga_ids(v, b, ck, h);
        unsigned rf[16];
#pragma unroll
        for (int i = 0; i < 16; ++i) rf[i] = P.rf[i];
        const f16x8 va = P.va, vb = P.vb;
        if (v + F.G < 2112) hga_prefetch(F, v + F.G, P);
        { const int pi = tid & 31, g8 = tid >> 5;
#pragma unroll
          for (int j = 0; j < 8; ++j) { typedef _Float16 h2 __attribute__((ext_vector_type(2))); h2 pr; pr.x = va[j]; pr.y = vb[j];
              *(LAS h2*)(VT + swz64(8 * g8 + j, pi >> 2) + (pi & 3) * 4) = pr; } }
        {
            const int kp = tid & 63, dir = (tid >> 6) & 1, qq = tid >> 7;
            const float lb[2] = {lbw[0], lbw[1]};
            float f0[16], f1[16]; float p0 = 1.f, p1 = 1.f;
#pragma unroll
            for (int i = 0; i < 16; ++i) { const f16x2 r = __builtin_bit_cast(f16x2, rf[i]);
                f0[i] = lb[0] + (1.f - lb[0]) * sigmoid_f((float)r.x); f1[i] = lb[1] + (1.f - lb[1]) * sigmoid_f((float)r.y); p0 *= f0[i]; p1 *= f1[i]; }
            *(LAS f32x2*)(PX + (dir * 4 + qq) * 128 + 2 * kp) = (f32x2){p0, p1};
            __syncthreads();
            float c0 = 1.f, c1 = 1.f, a0 = p0, a1 = p1;
            for (int q2 = 0; q2 < 4; ++q2) if (q2 != qq) { const f32x2 pp = *(const LAS f32x2*)(PX + (dir * 4 + q2) * 128 + 2 * kp); a0 *= pp.x; a1 *= pp.y; if (q2 > qq) { c0 *= pp.x; c1 *= pp.y; } }
            if (qq == 0) *(f32x2*)(DEC + hg_sid(b, ck, h, dir) * 128 + 2 * kp) = (f32x2){a0, a1};
            f16 w0[16], w1[16];
#pragma unroll
            for (int i = 15; i >= 0; --i) { w0[i] = (f16)((1.f - f0[i]) * c0); w1[i] = (f16)((1.f - f1[i]) * c1); c0 *= f0[i]; c1 *= f1[i]; }
            const int tb = dir == 0 ? 16 * qq : 48 - 16 * qq;
            LAS unsigned char* T = KD + dir * 16384;
#pragma unroll
            for (int e = 0; e < 2; ++e)
#pragma unroll
                for (int hf = 0; hf < 2; ++hf) { f16x8 o;
#pragma unroll
                    for (int q = 0; q < 8; ++q) { const int j = 8 * hf + q; const int i = dir == 0 ? j : 15 - j; o[q] = e == 0 ? w0[i] : w1[i]; }
                    *(LAS f16x8*)(T + swz64(2 * kp + e, (tb >> 3) + hf)) = o; }
        }
        __syncthreads();
        {
            int t2 = tid; asm volatile("" : "+v"(t2));
            const int lane2 = t2 & 63, fr = lane2 & 15, fq = lane2 >> 4, w = __builtin_amdgcn_readfirstlane(t2 >> 6);
            const int dir = w & 1, q = w >> 1;
            const LAS unsigned char* T = KD + dir * 16384;
            f32x4 acc[2][8];
#pragma unroll
            for (int i = 0; i < 2; ++i)
#pragma unroll
                for (int j = 0; j < 8; ++j) acc[i][j] = (f32x4){0, 0, 0, 0};
#pragma unroll
            for (int kk = 0; kk < 2; ++kk) {
                f16x8 a[2];
#pragma unroll
                for (int i = 0; i < 2; ++i) a[i] = *(const LAS f16x8*)(T + swz64(16 * (2 * q + i) + fr, 4 * kk + fq));
#pragma unroll
                for (int vt = 0; vt < 8; ++vt) { const f16x8 bv = *(const LAS f16x8*)(VT + swz64(16 * vt + fr, 4 * kk + fq));
#pragma unroll
                    for (int i = 0; i < 2; ++i) acc[i][vt] = __builtin_amdgcn_mfma_f32_16x16x32_f16(a[i], bv, acc[i][vt], 0, 0, 0); }
            }
            f16* S = hg_slot(HCT, HLAT, b, ck, h, dir);
#pragma unroll
            for (int i = 0; i < 2; ++i)
#pragma unroll
                for (int vt = 0; vt < 8; ++vt) { f16x4 o; o.x = (f16)acc[i][vt].x; o.y = (f16)acc[i][vt].y; o.z = (f16)acc[i][vt].z; o.w = (f16)acc[i][vt].w;
                    *(f16x4*)(S + (size_t)(16 * vt + fr) * 128 + 16 * (2 * q + i) + 4 * fq) = o; }
        }
        __syncthreads();
    }
}

DI void hg_b(const Ctx& F, f16* HCT, f16* HLAT, const float* DEC) {
    const int idx = F.c * 512 + F.tid; if (idx >= 32 * 4096) return;
    const int e = idx & 4095, chain = idx >> 12, dir = chain & 1, h = (chain >> 1) & 3, b = chain >> 3;
    const int k0 = (e & 31) * 4;
    float run[4] = {0.f, 0.f, 0.f, 0.f};
    for (int s0 = 0; s0 < 132; s0 += 6) {
        f16x4 loc[6]; f32x4 d[6]; f16* p[6];
#pragma unroll
        for (int i = 0; i < 6; ++i) { const int st = s0 + i; const int ck = dir == 0 ? st : (st < 4 ? 3 - st : 135 - st);
            p[i] = hg_slot(HCT, HLAT, b, ck, h, dir) + (size_t)e * 4; loc[i] = *(const f16x4*)p[i]; d[i] = *(const f32x4*)(DEC + hg_sid(b, ck, h, dir) * 128 + k0); }
#pragma unroll
        for (int i = 0; i < 6; ++i) { f16x4 o; o.x = (f16)run[0]; o.y = (f16)run[1]; o.z = (f16)run[2]; o.w = (f16)run[3]; *(f16x4*)p[i] = o;
            run[0] = d[i].x * run[0] + (float)loc[i].x; run[1] = d[i].y * run[1] + (float)loc[i].y; run[2] = d[i].z * run[2] + (float)loc[i].z; run[3] = d[i].w * run[3] + (float)loc[i].w; }
    }
}

DI unsigned cvt_pk_bf16(float lo, float hi) { unsigned r; asm volatile("v_cvt_pk_bf16_f32 %0, %1, %2" : "=v"(r) : "v"(lo), "v"(hi)); return r; }
struct HgcPre { unsigned rf[16], rq[16]; f16x8 va, vb; f16x4 g[4]; };
DI void hgc_unit_ids(int u, int& b, int& c, int& h) { b = u >> 9; c = (u >> 2) & 127; h = u & 3; }
DI void hgc_prefetch(const Ctx& F, int u, HgcPre& P) {
    int b, c, h; hgc_unit_ids(u, b, c, h);
    const int tid = F.tid, row0 = b * SEQ + 64 * c;
    const int kp = tid & 63, dir = (tid >> 6) & 1, qq = tid >> 7;
    const int T0 = dir == 0 ? 16 * qq : 63 - 16 * qq, SG = dir == 0 ? 1 : -1;
    const f16* pf = F.U() + (size_t)(row0 + T0) * NU + (dir ? UFB : UFF) + h * 128 + 2 * kp;
    const f16* pq = F.U() + (size_t)(row0 + T0) * NU + UQ + h * 128 + 2 * kp;
    const long st = (long)SG * NU;
#pragma unroll
    for (int i = 0; i < 16; ++i) { P.rf[i] = *(const unsigned*)(pf + i * st); P.rq[i] = *(const unsigned*)(pq + i * st); }
    const int pi = tid & 31, g8 = tid >> 5;
    P.va = *(const f16x8*)(F.U() + (size_t)(row0 + 2 * pi) * NU + UI + h * 128 + 8 * g8);
    P.vb = *(const f16x8*)(F.U() + (size_t)(row0 + 2 * pi + 1) * NU + UI + h * 128 + 8 * g8);
    const int lane = tid & 63, fr = lane & 15, fq = lane >> 4, w = tid >> 6, lt = w & 3, vh = w >> 2;
    const f16* pg = F.U() + (size_t)(row0 + 16 * lt + fr) * NU + UG + h * 128 + 64 * vh + 4 * fq;
#pragma unroll
    for (int vt = 0; vt < 4; ++vt) P.g[vt] = *(const f16x4*)(pg + 16 * vt);
}
DI void hg_c_phase(const Ctx& F, f16* HCT, f16* HLAT) {
    LAS unsigned char* QD = F.lds;
    LAS unsigned char* KI = F.lds + 32768;
    LAS unsigned char* VT = F.lds + 65536;
    LAS unsigned char* SS = F.lds + 81920;
    LAS float* red = (LAS float*)(F.lds + 147456);
    LAS float* PX = red + 128;
    const int tid = F.tid;
    int u = F.c; if (u >= 2048) return;
    float lbw[2];
    { const int kp = tid & 63, dir = (tid >> 6) & 1, ch = (u & 3) * 128 + 2 * kp;
#pragma unroll
      for (int e = 0; e < 2; ++e) { const float l0 = F.hgrn_lb[dir * 512 + ch + e], l1 = F.hgrn_lb[1024 + dir * 512 + ch + e]; lbw[e] = __builtin_amdgcn_rcpf(1.f + __expf(l1 - l0)); } }
    LAS float* NW = PX + 1024;
    if (tid < 128) NW[tid] = F.hgrn_nw[(u & 3) * 128 + tid];
    asm volatile("s_waitcnt vmcnt(0)" ::: "memory");
    __syncthreads();
    HgcPre P; hgc_prefetch(F, u, P);
    for (; u < 2048; u += F.G) {
        int b, c, h; hgc_unit_ids(u, b, c, h);
        const int row0 = b * SEQ + 64 * c;
        unsigned rf[16], rq[16];
#pragma unroll
        for (int i = 0; i < 16; ++i) { rf[i] = P.rf[i]; rq[i] = P.rq[i]; }
        const f16x8 va = P.va, vb = P.vb; f16x4 gz[4];
#pragma unroll
        for (int vt = 0; vt < 4; ++vt) gz[vt] = P.g[vt];
        if (u + F.G < 2048) hgc_prefetch(F, u + F.G, P);
        {
            const int wv = __builtin_amdgcn_readfirstlane(tid >> 6), lane = tid & 63;
#pragma unroll
            for (int dir = 0; dir < 2; ++dir) { const f16* S = hg_slot(HCT, HLAT, b, c + 4, h, dir);
#pragma unroll
                for (int p = 0; p < 4; ++p) { const int o = (wv * 4 + p) * 1024 + lane * 16, row = o >> 8, pch = (o >> 4) & 15, lch = pch ^ (row & 15);
                    __builtin_amdgcn_global_load_lds((const unsigned*)((const char*)S + row * 256 + lch * 16), (LAS unsigned*)(SS + dir * 32768 + (wv * 4 + p) * 1024), 16, 0, 0); } }
        }
        { const int pi = tid & 31, g8 = tid >> 5;
#pragma unroll
          for (int j = 0; j < 8; ++j) { typedef _Float16 h2 __attribute__((ext_vector_type(2))); h2 pr; pr.x = va[j]; pr.y = vb[j];
              *(LAS h2*)(VT + swz64(8 * g8 + j, pi >> 2) + (pi & 3) * 4) = pr; } }
        {
            const int kp = tid & 63, dir = (tid >> 6) & 1, qq = tid >> 7;
            const int T0 = dir == 0 ? 16 * qq : 63 - 16 * qq, SG = dir == 0 ? 1 : -1;
            const float lb[2] = {lbw[0], lbw[1]};
            float f0[16], f1[16]; float p0 = 1.f, p1 = 1.f;
#pragma unroll
            for (int i = 0; i < 16; ++i) { const f16x2 r = __builtin_bit_cast(f16x2, rf[i]);
                f0[i] = lb[0] + (1.f - lb[0]) * sigmoid_f((float)r.x); f1[i] = lb[1] + (1.f - lb[1]) * sigmoid_f((float)r.y); p0 *= f0[i]; p1 *= f1[i]; }
            *(LAS f32x2*)(PX + (dir * 4 + qq) * 128 + 2 * kp) = (f32x2){p0, p1};
            bar_lds();
            float c0 = 1.f, c1 = 1.f;
            for (int q2 = 0; q2 < qq; ++q2) { const f32x2 pp = *(const LAS f32x2*)(PX + (dir * 4 + q2) * 128 + 2 * kp); c0 *= pp.x; c1 *= pp.y; }
            LAS unsigned char* TQ = QD + dir * 16384; LAS unsigned char* TK = KI + dir * 16384;
            const int cb = (kp & 3) * 4, cx = (kp >> 2) << 4;
#pragma unroll
            for (int i = 0; i < 16; ++i) { const int t = T0 + SG * i; c0 *= f0[i]; c1 *= f1[i];
                const f16x2 r = __builtin_bit_cast(f16x2, rq[i]);
                const int off = t * 256 + (cx ^ ((t & 15) << 4)) + cb;
                *(LAS unsigned*)(TQ + off) = cvt_pk_bf16(silu_f((float)r.x) * c0, silu_f((float)r.y) * c1);
                *(LAS unsigned*)(TK + off) = cvt_pk_bf16((1.f - f0[i]) * __builtin_amdgcn_rcpf(c0), (1.f - f1[i]) * __builtin_amdgcn_rcpf(c1)); }
        }
        bar_lds();
        int t2 = tid; asm volatile("" : "+v"(t2));
        const int lane2 = t2 & 63, fr = lane2 & 15, fq = lane2 >> 4, w = __builtin_amdgcn_readfirstlane(t2 >> 6);
        const int lt = w & 3, vh = w >> 2, l = 16 * lt + fr;
        f32x4 oacc[4];
#pragma unroll
        for (int vt = 0; vt < 4; ++vt) oacc[vt] = (f32x4){0, 0, 0, 0};
        s16x8 qfr[2][4];
#pragma unroll
        for (int dir = 0; dir < 2; ++dir) {
            const LAS unsigned char* TQ = QD + dir * 16384; const LAS unsigned char* TK = KI + dir * 16384;
#pragma unroll
            for (int kk = 0; kk < 4; ++kk) qfr[dir][kk] = *(const LAS s16x8*)(TQ + swz(l, 4 * kk + fq));
            f32x4 att[4];
#pragma unroll
            for (int st = 0; st < 4; ++st) { att[st] = (f32x4){0, 0, 0, 0};
#pragma unroll
                for (int kk = 0; kk < 4; ++kk) att[st] = __builtin_amdgcn_mfma_f32_16x16x32_bf16(*(const LAS s16x8*)(TK + swz(16 * st + fr, 4 * kk + fq)), qfr[dir][kk], att[st], 0, 0, 0); }
#pragma unroll
            for (int k2 = 0; k2 < 2; ++k2) {
                f16x8 m;
#pragma unroll
                for (int hf = 0; hf < 2; ++hf)
#pragma unroll
                    for (int r = 0; r < 4; ++r) { const int s = 16 * (2 * k2 + hf) + 4 * fq + r; const bool keep = dir == 0 ? s <= l : s >= l; m[hf * 4 + r] = keep ? (f16)att[2 * k2 + hf][r] : (f16)0.f; }
#pragma unroll
                for (int vt = 0; vt < 4; ++vt) { const int v = 64 * vh + 16 * vt + fr;
                    const f16x4 x0 = *(const LAS f16x4*)(VT + swz64(v, 4 * k2 + (fq >> 1)) + 8 * (fq & 1));
                    const f16x4 x1 = *(const LAS f16x4*)(VT + swz64(v, 4 * k2 + 2 + (fq >> 1)) + 8 * (fq & 1));
                    f16x8 xf; xf[0] = x0[0]; xf[1] = x0[1]; xf[2] = x0[2]; xf[3] = x0[3]; xf[4] = x1[0]; xf[5] = x1[1]; xf[6] = x1[2]; xf[7] = x1[3];
                    oacc[vt] = __builtin_amdgcn_mfma_f32_16x16x32_f16(xf, m, oacc[vt], 0, 0, 0); }
            }
        }
        asm volatile("s_waitcnt vmcnt(0)" ::: "memory");
        __syncthreads();
#pragma unroll
        for (int dir = 0; dir < 2; ++dir)
#pragma unroll
            for (int kk = 0; kk < 4; ++kk) { f16x8 q16;
#pragma unroll
                for (int j = 0; j < 8; ++j) q16[j] = (f16)__builtin_bit_cast(float, ((unsigned)(unsigned short)qfr[dir][kk][j]) << 16);
#pragma unroll
                for (int vt = 0; vt < 4; ++vt) oacc[vt] = __builtin_amdgcn_mfma_f32_16x16x32_f16(*(const LAS f16x8*)(SS + dir * 32768 + swz(64 * vh + 16 * vt + fr, 4 * kk + fq)), q16, oacc[vt], 0, 0, 0); }
        float ss = 0.f;
#pragma unroll
        for (int vt = 0; vt < 4; ++vt) ss += oacc[vt].x * oacc[vt].x + oacc[vt].y * oacc[vt].y + oacc[vt].z * oacc[vt].z + oacc[vt].w * oacc[vt].w;
        ss += __shfl_xor(ss, 16); ss += __shfl_xor(ss, 32);
        if (fq == 0) red[vh * 64 + l] = ss;
        __syncthreads();
        const float rstd = rsqrtf((red[l] + red[64 + l]) * (1.f / 128.f) + EPS);
        f16* yrow = F.Y() + (size_t)(row0 + l) * DM + 512 + h * 128;
#pragma unroll
        for (int vt = 0; vt < 4; ++vt) { const int v = 64 * vh + 16 * vt + 4 * fq;
            const f32x4 nw = *(const LAS f32x4*)(NW + v);
            f16x4 o; o.x = (f16)(oacc[vt].x * rstd * nw.x * silu_f((float)gz[vt].x)); o.y = (f16)(oacc[vt].y * rstd * nw.y * silu_f((float)gz[vt].y));
            o.z = (f16)(oacc[vt].z * rstd * nw.z * silu_f((float)gz[vt].z)); o.w = (f16)(oacc[vt].w * rstd * nw.w * silu_f((float)gz[vt].w));
            *(f16x4*)(yrow + v) = o; }
        __syncthreads();
    }
}
}

__global__ void __launch_bounds__(512, 2) mk_fwd(Args args) {
    extern __shared__ __attribute__((aligned(16))) unsigned char lds_raw[];
    Ctx F;
    F.lds = (LAS unsigned char*)lds_raw;
    F.tid = threadIdx.x; F.lane = F.tid & 63; F.wave = __builtin_amdgcn_readfirstlane(F.tid >> 6); F.G = gridDim.x; F.c = blockIdx.x;
    unsigned char* ws = args.ws;
    F.x = args.in[0]; F.cvec = args.in[1]; F.ctx = args.in[2]; F.c_ctx = args.in[3]; F.ada_w = args.in[4]; F.ada_b = args.in[5]; F.norm_w = args.in[6]; F.w_in = args.in[7];
    F.conv_w = args.in[8]; F.conv_b = args.in[9]; F.dt_bias = args.in[10]; F.a_log = args.in[11]; F.ssd_d = args.in[12]; F.ssd_nw = args.in[13]; F.hgrn_lb = args.in[14]; F.hgrn_nw = args.in[15];
    F.w_out = args.in[16]; F.w_router = args.in[17]; F.w_gate = args.in[18]; F.w_up = args.in[19]; F.w_down = args.in[20];
    F.out = args.out;
    F.ws = ws;
    volatile LAS unsigned* misc = (volatile LAS unsigned*)(F.lds + LDS_MISC_OFF);
    if (F.tid < 16) misc[F.tid] = 0u;
    __syncthreads();
    XcdBarrier bar = xcd_barrier_post((unsigned*)(ws + WS_BAR), misc + 8);
    f16* SST = (f16*)(ws + WS_H); float* TOTS = (float*)(ws + WS_Y); float* DEC = (float*)(ws + WS_Y + 65536);
    f16* HCT = (f16*)(ws + WS_AFF); f16* HLAT = (f16*)F.out;
    const int hi = args.hi;
#define REFRESH() do { int _t = threadIdx.x; asm volatile("" : "+v"(_t)); F.tid = _t; F.lane = _t & 63; F.wave = __builtin_amdgcn_readfirstlane(_t >> 6); } while (0)
#define PHASE(k, last, ...) do { if ((k) < hi) { REFRESH(); __VA_ARGS__; if (!(last) && (k) + 1 < hi) xcd_barrier(bar); } } while (0)
    PHASE(PH_PREP, false, phase_prep(F));
    PHASE(PH_HROWS, false, phase_hrows(F));
    PHASE(PH_GEMM_IN, false, { gm::ProbIn p{F.H(), F.WIN(), F.U()}; gm::gemm_phase(F.lds, p, F.G, F.c, F.tid); moe_convert(F, 0, MOE_SPLIT); });
    PHASE(PH_CONV, false, phase_conv(F));
    PHASE(PH_MA, false, {
        mx::ssd_a_phase(F, SST, TOTS);
        mx::hg_a_phase(F, HCT, HLAT, DEC); });
    PHASE(PH_MB, false, { mx::ssd_b(F, SST, TOTS); mx::hg_b(F, HCT, HLAT, DEC); });
    PHASE(PH_MC, false, {
        for (int u = F.c; u < 512; u += F.G) mx::ssd_c_unit(F, SST, u >> 7, (u >> 1) & 63, u & 1);
        mx::hg_c_phase(F, HCT, HLAT); });
    PHASE(PH_GEMM_OUT, false, { gm::ProbOut p{F.Y(), F.WOUT(), F.R()}; gm::gemm_phase(F.lds, p, F.G, F.c, F.tid); });
    PHASE(PH_POST, false, phase_post(F));
    PHASE(PH_TOPK, false, { phase_topk(F); moe_convert(F, MOE_SPLIT, MOE_ITEMS); });
    PHASE(PH_GEMM_GU, false, {
        LAS int* tab = (LAS int*)(F.lds + LDS_TAB_OFF);
        for (int i = 0; i < 8; ++i) { gm::Unit u; if (!gm::unit_at(i, F.G, F.c, gm::ProbGU::nM, gm::ProbGU::nN, u)) break;
            if (F.tid < 256) { const int b = (u.pm >> 2) & 3; tab[i * 256 + F.tid] = b * SEQ + F.IDX()[u.pm * 256 + F.tid]; } }
        __syncthreads();
        gm::ProbGU p{F.H2(), F.WGU(), F.ACT(), F.IDX(), tab}; gm::gemm_phase(F.lds, p, F.G, F.c, F.tid); });
    PHASE(PH_GEMM_DOWN, false, {
        LAS float* gtab = (LAS float*)(F.lds + LDS_TAB_OFF);
        for (int i = 0; i < 8; ++i) { gm::Unit u; if (!gm::unit_at(i, F.G, F.c, gm::ProbDown::nM, gm::ProbDown::nN, u)) break;
            if (F.tid < 256) gtab[i * 256 + F.tid] = F.GATEV()[u.pm * 256 + F.tid]; }
        asm volatile("s_waitcnt vmcnt(0)" ::: "memory");
        __syncthreads();
        gm::ProbDown p{F.ACT(), F.WD(), F.YM(), gtab, 0}; gm::gemm_phase(F.lds, p, F.G, F.c, F.tid); });
    PHASE(PH_COMBINE, true, phase_combine(F));
#undef PHASE
}

extern "C" void kernel_launch(void* const* d_in, const int* in_sizes, int n_in, void* d_out, int out_size, void* d_ws, size_t ws_size, hipStream_t stream) {
    if (ws_size < WS_END || n_in < 21) { fprintf(stderr, "kernel_launch: bad workspace/inputs: ws %zu n_in %d\n", ws_size, n_in); return; }
    static bool attr_set = false;
    if (!attr_set) { (void)hipFuncSetAttribute((const void*)mk_fwd, hipFuncAttributeMaxDynamicSharedMemorySize, LDS_BYTES); attr_set = true; }
    Args a{}; for (int i = 0; i < 21; ++i) a.in[i] = (const float*)d_in[i]; a.out = (float*)d_out; a.ws = (unsigned char*)d_ws;
#if PROBE_PH >= 0
    (void)hipMemsetAsync((char*)d_ws + WS_BAR, 0, WS_CTL_BYTES, stream);
    a.hi = PROBE_PH; hipLaunchKernelGGL(mk_fwd, dim3(256), dim3(512), LDS_BYTES, stream, a);
#endif
    (void)hipMemsetAsync((char*)d_ws + WS_BAR, 0, WS_CTL_BYTES, stream);
    a.hi = PH_COUNT; hipLaunchKernelGGL(mk_fwd, dim3(256), dim3(512), LDS_BYTES, stream, a);
}
```

```cpp
#include <hip/hip_runtime.h>
#include <cstdio>
#include <cstdint>

#define DI __device__ __forceinline__
typedef _Float16 f16;
typedef _Float16 f16x8 __attribute__((ext_vector_type(8)));
typedef _Float16 f16x4 __attribute__((ext_vector_type(4)));
typedef float f32x4 __attribute__((ext_vector_type(4)));

constexpr int DM = 1024, NB = 4, SEQ = 8192, CTXL = 256;
constexpr int MLAT = NB * SEQ;
constexpr int MCTX = NB * CTXL;
constexpr int MTOT = MLAT + MCTX;
constexpr int INCOLS = 4112, NU = 4096;
constexpr int UZ = 0, UXBC = 512, UQ = 1536, UFF = 2048, UFB = 2560, UI = 3072, UG = 3584;
constexpr int NE = 16, FF = 1024, CAP = 1024;
constexpr float EPS = 1e-6f;

constexpr size_t MiB = 1u << 20;
constexpr size_t WS_MOD = 1 * MiB;
constexpr size_t WS_DT = 2 * MiB;
constexpr size_t WS_WDT = 5 * MiB;
constexpr size_t WS_AFF = 6 * MiB;
constexpr size_t WS_IDX = 8 * MiB;
constexpr size_t WS_GATEV = 8 * MiB + 256 * 1024;
constexpr size_t WS_SLOT = 9 * MiB;
constexpr size_t WS_WIN = 12 * MiB;
constexpr size_t WS_WOUT = 20 * MiB;
constexpr size_t WS_WGU = 22 * MiB;
constexpr size_t WS_WD = 86 * MiB;
constexpr size_t WS_H = 118 * MiB;
constexpr size_t WS_U = 184 * MiB;
constexpr size_t WS_Y = 448 * MiB;
constexpr size_t WS_END = 512 * MiB;
constexpr size_t WS_ACT = WS_U;
constexpr size_t WS_YM = WS_U + 128 * MiB;
constexpr size_t WS_R = WS_U;

DI float silu_f(float x) { return x * __builtin_amdgcn_rcpf(1.f + __expf(-x)); }
DI float sigmoid_f(float x) { return __builtin_amdgcn_rcpf(1.f + __expf(-x)); }
DI float softplus_f(float x) { return x > 20.f ? x : log1pf(__expf(x)); }
DI float wave_sum(float v) {
#pragma unroll
    for (int o = 1; o < 64; o <<= 1) v += __shfl_xor(v, o);
    return v;
}


DI float reduce16(const float (&v)[16]) {
    const int lane = threadIdx.x & 63;
    float w8[8], w4[4], w2[2];
    const bool b0 = lane & 1, b1 = lane & 2, b2 = lane & 4, b3 = lane & 8;
#pragma unroll
    for (int i = 0; i < 8; ++i) { const float keep = b0 ? v[2 * i + 1] : v[2 * i], send = b0 ? v[2 * i] : v[2 * i + 1]; w8[i] = keep + __shfl_xor(send, 1); }
#pragma unroll
    for (int i = 0; i < 4; ++i) { const float keep = b1 ? w8[2 * i + 1] : w8[2 * i], send = b1 ? w8[2 * i] : w8[2 * i + 1]; w4[i] = keep + __shfl_xor(send, 2); }
#pragma unroll
    for (int i = 0; i < 2; ++i) { const float keep = b2 ? w4[2 * i + 1] : w4[2 * i], send = b2 ? w4[2 * i] : w4[2 * i + 1]; w2[i] = keep + __shfl_xor(send, 4); }
    float r = (b3 ? w2[1] : w2[0]) + __shfl_xor(b3 ? w2[0] : w2[1], 8);
    r += __shfl_xor(r, 16); r += __shfl_xor(r, 32);
    return r;
}

DI void bar_lds() { asm volatile("s_waitcnt lgkmcnt(0)" ::: "memory"); __builtin_amdgcn_s_barrier(); asm volatile("" ::: "memory"); }
#define LAS __attribute__((address_space(3)))
typedef unsigned u32x4 __attribute__((ext_vector_type(4)));
namespace gm {
constexpr int BM = 256, BK = 64, HALF = 128, HTB = HALF * BK * 2, STAGE_BYTES = 8 * HTB, NXCD = 8, WGM = 8, KD = 1024, NT = KD / BK;
DI int lds_byte(int r, int c) { const int st = (r >> 4) * 2 + (c >> 5), rr = r & 15, cc = c & 31, ob = rr * 64 + cc * 2; return st * 1024 + (ob ^ (((ob >> 9) & 1) << 5)); }
DI void stage_rc(int b, int& R, int& C) { const int st = b / 1024, sb = b % 1024, swz = sb ^ (((sb >> 9) & 1) << 5); R = (st >> 1) * 16 + swz / 64; C = (st & 1) * 32 + (swz % 64) / 2; }
DI int perm32(int rho) { const int n = rho >> 4, i = rho & 15; return 8 * (i >> 2) + 4 * n + (i & 3); }
struct Unit { int pm, pn; };
DI bool unit_at(int i, int G, int c, int nM, int nN, Unit& u) {
    const int nwg = nM * nN; const long L = (long)i * G + c; if (L >= nwg) return false;
    int wgid = (int)L; { const int q = nwg / NXCD, r = nwg % NXCD, xcd = wgid % NXCD, off = wgid / NXCD; wgid = (xcd < r ? xcd * (q + 1) : r * (q + 1) + (xcd - r) * q) + off; }
    const int nig = WGM * nN, gid = wgid / nig, fm = gid * WGM, gsz = (nM - fm) < WGM ? (nM - fm) : WGM;
    u.pm = fm + ((wgid % nig) % gsz); u.pn = (wgid % nig) / gsz; return true;
}
typedef f32x4 Acc[2][2][4][2];
typedef int i32x8 __attribute__((ext_vector_type(8)));
typedef int i32x4g __attribute__((ext_vector_type(4)));
DI i32x8 cat8(f16x8 a, f16x8 b) { return __builtin_shufflevector(__builtin_bit_cast(i32x4g, a), __builtin_bit_cast(i32x4g, b), 0, 1, 2, 3, 4, 5, 6, 7); }
DI unsigned pack4f8(float a, float b, float c, float d) {
    a = __builtin_amdgcn_fmed3f(a, -448.f, 448.f); b = __builtin_amdgcn_fmed3f(b, -448.f, 448.f); c = __builtin_amdgcn_fmed3f(c, -448.f, 448.f); d = __builtin_amdgcn_fmed3f(d, -448.f, 448.f);
    int p = __builtin_amdgcn_cvt_pk_fp8_f32(a, b, 0, false); p = __builtin_amdgcn_cvt_pk_fp8_f32(c, d, p, true); return (unsigned)p; }
typedef unsigned u32x2g __attribute__((ext_vector_type(2)));
DI unsigned pack2(float a, float b) { typedef _Float16 h2 __attribute__((ext_vector_type(2))); h2 v; v.x = (f16)a; v.y = (f16)b; return __builtin_bit_cast(unsigned, v); }

#ifndef GEMM_SP2
#define GEMM_SP2 0
#define GEMM_ALIGN 1
#endif
template <class P, bool SP2 = GEMM_SP2, bool ALIGN = GEMM_ALIGN>
DI void gemm_phase(LAS unsigned char* lds, const P& p, int G, int c, int tid) {
    const int wid = __builtin_amdgcn_readfirstlane(tid >> 6), lane = tid & 63, wr = wid >> 2, wc = wid & 3, fr = lane & 15, fq = lane >> 4;
    constexpr int ROWB = P::ROWB, nt = ROWB / 128;
    int Rr[2], Cc[2]; unsigned voffB[2];
#pragma unroll
    for (int i = 0; i < 2; ++i) { stage_rc(tid * 16 + i * 8192, Rr[i], Cc[i]); const int Rb = P::PERM ? ((Rr[i] & ~31) + perm32(Rr[i] & 31)) : Rr[i]; voffB[i] = (unsigned)(Rb * ROWB + Cc[i] * 2); }
    const size_t kstep = (size_t)(BK * 2);
    const size_t hstep = (size_t)HALF * ROWB;
    const unsigned ldsw = (unsigned)wid * 1024u;
    const int aoff = lds_byte(wr * 64 + fr, fq * 8), boff = lds_byte(wc * 32 + fr, fq * 8);
#define G_SA(b, h) (((b) * 2 + (h)) * HTB)
#define G_SB(b, h) ((4 + (b) * 2 + (h)) * HTB)
#define G_STAGEB(bufoff, gbase) do { const char* _gb = (const char*)(gbase); asm volatile("" : "+s"(_gb)); _Pragma("unroll") for (int _i = 0; _i < 2; ++_i) \
        __builtin_amdgcn_global_load_lds((const unsigned*)(_gb + voffB[_i]), (LAS unsigned*)(lds + (bufoff) + ldsw + _i * 8192), 16, 0, 0); } while (0)
#define G_STAGEA(bufoff, offs, h, koff) do { const char* _ga = gA + (koff); asm volatile("" : "+s"(_ga)); _Pragma("unroll") for (int _i = 0; _i < 2; ++_i) \
        __builtin_amdgcn_global_load_lds((const unsigned*)(_ga + (offs)[h][_i]), (LAS unsigned*)(lds + (bufoff) + ldsw + _i * 8192), 16, 0, 0); } while (0)
#define G_LDA(dst, b, h) do { if constexpr (P::F8) { _Pragma("unroll") for (int m = 0; m < 4; ++m) dst##8[m] = cat8(*(const LAS f16x8*)(lds + G_SA(b, h) + aoff + m * 2048), *(const LAS f16x8*)(lds + G_SA(b, h) + aoff + m * 2048 + 1024)); } \
        else { _Pragma("unroll") for (int m = 0; m < 4; ++m) _Pragma("unroll") for (int k = 0; k < 2; ++k) dst[m][k] = *(const LAS f16x8*)(lds + G_SA(b, h) + aoff + m * 2048 + k * 1024); } } while (0)
#define G_LDB(dst, b, h) do { if constexpr (P::F8) { _Pragma("unroll") for (int n = 0; n < 2; ++n) dst##8[n] = cat8(*(const LAS f16x8*)(lds + G_SB(b, h) + boff + n * 2048), *(const LAS f16x8*)(lds + G_SB(b, h) + boff + n * 2048 + 1024)); } \
        else { _Pragma("unroll") for (int n = 0; n < 2; ++n) _Pragma("unroll") for (int k = 0; k < 2; ++k) dst[n][k] = *(const LAS f16x8*)(lds + G_SB(b, h) + boff + n * 2048 + k * 1024); } } while (0)
#define G_MMA(ai, bj, At, Bt) do { __builtin_amdgcn_s_setprio(1); \
        if constexpr (P::F8) { _Pragma("unroll") for (int m = 0; m < 4; ++m) _Pragma("unroll") for (int n = 0; n < 2; ++n) \
            asm volatile("v_mfma_f32_16x16x128_f8f6f4 %0, %1, %2, %0" : "+v"(acc[ai][bj][m][n]) : "v"(Bt##8[n]), "v"(At##8[m])); } \
        else { _Pragma("unroll") for (int m = 0; m < 4; ++m) _Pragma("unroll") for (int n = 0; n < 2; ++n) _Pragma("unroll") for (int k = 0; k < 2; ++k) \
            acc[ai][bj][m][n] = __builtin_amdgcn_mfma_f32_16x16x32_f16(Bt[n][k], At[m][k], acc[ai][bj][m][n], 0, 0, 0); } \
        __builtin_amdgcn_s_setprio(0); } while (0)
#define G_WAIT_V(n) asm volatile("s_waitcnt vmcnt(" #n ")" ::: "memory")
#define G_WAIT_L(n) asm volatile("s_waitcnt lgkmcnt(" #n ")" ::: "memory")
#define G_BAR __builtin_amdgcn_s_barrier()
#define G_SCHED __builtin_amdgcn_sched_barrier(0)
    Unit cur, nxt; int ui = 0;
    if (!unit_at(0, G, c, P::nM, P::nN, cur)) return;
    Acc acc;
#pragma unroll
    for (int a = 0; a < 2; ++a)
#pragma unroll
        for (int b = 0; b < 2; ++b)
#pragma unroll
            for (int m = 0; m < 4; ++m)
#pragma unroll
                for (int n = 0; n < 2; ++n) acc[a][b][m][n] = (f32x4){0.f, 0.f, 0.f, 0.f};
    f16x8 At[4][2], B0[2][2], B1[2][2];
    i32x8 At8[4], B08[2], B18[2];
    const char* gA = (const char*)p.A;
    unsigned offC[2][2], offN[2][2];
#pragma unroll
    for (int h = 0; h < 2; ++h)
#pragma unroll
        for (int i = 0; i < 2; ++i) offC[h][i] = p.arow(0, cur, 128 * h + Rr[i]) * (unsigned)ROWB + (unsigned)Cc[i] * 2u;
    const char* cB = p.bptr(cur);
    if constexpr (SP2) {
        G_STAGEB(G_SB(0, 0), cB); G_STAGEB(G_SB(0, 1), cB + hstep); G_STAGEA(G_SA(0, 0), offC, 0, 0); G_STAGEA(G_SA(0, 1), offC, 1, 0);
        if (wr == 1) G_BAR;
        G_WAIT_V(2); G_BAR;
        G_STAGEB(G_SB(1, 0), cB + kstep); G_STAGEA(G_SA(1, 0), offC, 0, kstep); G_STAGEB(G_SB(1, 1), cB + hstep + kstep);
        G_WAIT_V(6); G_BAR;
    } else {
    G_STAGEB(G_SB(0, 0), cB); G_STAGEA(G_SA(0, 0), offC, 0, 0); G_STAGEB(G_SB(0, 1), cB + hstep); G_STAGEA(G_SA(0, 1), offC, 1, 0);
    if (wr == 1) G_BAR;
    G_WAIT_V(4); G_BAR;
    G_STAGEB(G_SB(1, 0), cB + kstep); G_STAGEA(G_SA(1, 0), offC, 0, kstep); G_STAGEB(G_SB(1, 1), cB + hstep + kstep);
    G_WAIT_V(6); G_BAR;
    }
    for (;;) {
        const bool has_next = unit_at(ui + 1, G, c, P::nM, P::nN, nxt);
        const char* nB = has_next ? p.bptr(nxt) : cB;
#pragma unroll
        for (int h = 0; h < 2; ++h)
#pragma unroll
            for (int i = 0; i < 2; ++i) offN[h][i] = has_next ? p.arow(ui + 1, nxt, 128 * h + Rr[i]) * (unsigned)ROWB + (unsigned)Cc[i] * 2u : offC[h][i];
#pragma unroll 1
        for (int t = 0; t < nt; t += 2) {
            const bool last = (t == nt - 2);
            const size_t k1 = (size_t)(t + 1) * kstep;
            const size_t k2 = last ? 0 : (size_t)(t + 2) * kstep, k3 = k2 + kstep;
            const char* b2 = last ? nB : cB + (size_t)(t + 2) * kstep; const char* b3 = b2 + kstep;
            unsigned o2[2][2];
#pragma unroll
            for (int h = 0; h < 2; ++h)
#pragma unroll
                for (int i = 0; i < 2; ++i) o2[h][i] = last ? offN[h][i] : offC[h][i];
            if constexpr (SP2) {
            G_LDB(B0, 0, 0); G_LDB(B1, 0, 1); G_SCHED; G_LDA(At, 0, 0); G_STAGEA(G_SA(1, 1), offC, 1, k1);
            G_WAIT_V(8); G_WAIT_L(0); G_BAR; G_MMA(0, 0, At, B0); G_MMA(0, 1, At, B1); G_BAR; G_SCHED;
            G_LDA(At, 0, 1); G_STAGEB(G_SB(0, 0), b2); G_STAGEB(G_SB(0, 1), b2 + hstep); G_STAGEA(G_SA(0, 0), o2, 0, k2);
            G_WAIT_V(8); G_WAIT_L(0); G_BAR; G_MMA(1, 0, At, B0); G_MMA(1, 1, At, B1); G_BAR; G_SCHED;
            G_LDB(B0, 1, 0); G_LDB(B1, 1, 1); G_SCHED; G_LDA(At, 1, 0); G_STAGEA(G_SA(0, 1), o2, 1, k2);
            G_WAIT_V(8); G_WAIT_L(0); G_BAR; G_MMA(0, 0, At, B0); G_MMA(0, 1, At, B1); G_BAR; G_SCHED;
            G_LDA(At, 1, 1); G_STAGEB(G_SB(1, 0), b3); G_STAGEB(G_SB(1, 1), b3 + hstep); G_STAGEA(G_SA(1, 0), o2, 0, k3);
            G_WAIT_V(8); G_WAIT_L(0); G_BAR; G_MMA(1, 0, At, B0); G_MMA(1, 1, At, B1); G_BAR; G_SCHED;
            } else {
            G_LDB(B0, 0, 0); G_SCHED; G_LDA(At, 0, 0); G_STAGEA(G_SA(1, 1), offC, 1, k1);
            G_WAIT_L(8); G_BAR; G_WAIT_L(0); G_MMA(0, 0, At, B0); G_BAR; G_SCHED;
            G_LDB(B1, 0, 1); G_STAGEB(G_SB(0, 0), b2);
            G_BAR; G_WAIT_L(0); G_MMA(0, 1, At, B1); G_BAR;
            G_LDA(At, 0, 1); G_STAGEA(G_SA(0, 0), o2, 0, k2);
            G_BAR; G_WAIT_L(0); G_MMA(1, 0, At, B0); G_BAR; G_SCHED;
            G_STAGEB(G_SB(0, 1), b2 + hstep);
            G_WAIT_V(6); G_BAR; G_MMA(1, 1, At, B1); G_BAR;
            G_LDB(B0, 1, 0); G_SCHED; G_LDA(At, 1, 0); G_STAGEA(G_SA(0, 1), o2, 1, k2);
            G_WAIT_L(8); G_BAR; G_WAIT_L(0); G_MMA(0, 0, At, B0); G_BAR; G_SCHED;
            G_LDB(B1, 1, 1); G_STAGEB(G_SB(1, 0), b3);
            G_BAR; G_WAIT_L(0); G_MMA(0, 1, At, B1); G_BAR;
            G_LDA(At, 1, 1); G_STAGEA(G_SA(1, 0), o2, 0, k3);
            G_BAR; G_WAIT_L(0); G_MMA(1, 0, At, B0); G_BAR; G_SCHED;
            G_STAGEB(G_SB(1, 1), b3 + hstep);
            G_WAIT_V(6); G_BAR; G_MMA(1, 1, At, B1); G_BAR;
            }
        }
        if constexpr (ALIGN) { if (wr == 0) G_BAR; }
        if constexpr (P::F8) asm volatile("s_nop 15\n\ts_nop 7" ::: "memory");
        p.epi(acc, cur, wr, wc, fr, fq);
        if (!has_next) break;
#pragma unroll
        for (int a = 0; a < 2; ++a)
#pragma unroll
            for (int b = 0; b < 2; ++b)
#pragma unroll
                for (int m = 0; m < 4; ++m)
#pragma unroll
                    for (int n = 0; n < 2; ++n) acc[a][b][m][n] = (f32x4){0.f, 0.f, 0.f, 0.f};
        cur = nxt; cB = nB; ++ui;
#pragma unroll
        for (int h = 0; h < 2; ++h)
#pragma unroll
            for (int i = 0; i < 2; ++i) offC[h][i] = offN[h][i];
        if constexpr (ALIGN) { if (wr == 1) G_BAR; }
    }
    G_WAIT_V(0);
    if constexpr (!ALIGN) { if (wr == 0) G_BAR; }
    G_BAR;
#undef G_SA
#undef G_SB
#undef G_STAGEA
#undef G_STAGEB
#undef G_LDA
#undef G_LDB
#undef G_MMA
#undef G_WAIT_V
#undef G_WAIT_L
#undef G_BAR
#undef G_SCHED
}

struct ProbIn {
    static constexpr int nM = MTOT / 256, nN = NU / 256; static constexpr bool PERM = true; static constexpr int ROWB = 2048; static constexpr bool F8 = false;
    const f16* A; const f16* BT; f16* U;
    DI unsigned arow(int, const Unit& u, int r) const { return (unsigned)(u.pm * 256 + r); }
    DI const char* bptr(const Unit& u) const { return (const char*)(BT + (size_t)u.pn * 256 * KD); }
    DI void epi(const Acc& acc, const Unit& u, int wr, int wc, int fr, int fq) const {
        const int row0 = u.pm * BM + wr * 64 + fr, col0 = u.pn * BM + wc * 32 + 8 * fq;
#pragma unroll
        for (int ai = 0; ai < 2; ++ai)
#pragma unroll
            for (int m = 0; m < 4; ++m) { f16* rowp = U + (size_t)(row0 + ai * HALF + m * 16) * NU + col0;
#pragma unroll
                for (int bj = 0; bj < 2; ++bj) { const f32x4 v0 = acc[ai][bj][m][0], v1 = acc[ai][bj][m][1];
                    u32x4 w; w.x = pack2(v0[0], v0[1]); w.y = pack2(v0[2], v0[3]); w.z = pack2(v1[0], v1[1]); w.w = pack2(v1[2], v1[3]);
                    *(u32x4*)(rowp + bj * HALF) = w; } }
    }
};
struct ProbOut {
    static constexpr int nM = MLAT / 256, nN = DM / 256; static constexpr bool PERM = true; static constexpr int ROWB = 2048; static constexpr bool F8 = false;
    const f16* A; const f16* BT; f16* R;
    DI unsigned arow(int, const Unit& u, int r) const { return (unsigned)(u.pm * 256 + r); }
    DI const char* bptr(const Unit& u) const { return (const char*)(BT + (size_t)u.pn * 256 * KD); }
    DI void epi(const Acc& acc, const Unit& u, int wr, int wc, int fr, int fq) const {
        const int row0 = u.pm * BM + wr * 64 + fr, col0 = u.pn * BM + wc * 32 + 8 * fq;
#pragma unroll
        for (int ai = 0; ai < 2; ++ai)
#pragma unroll
            for (int m = 0; m < 4; ++m) { f16* rowp = R + (size_t)(row0 + ai * HALF + m * 16) * DM + col0;
#pragma unroll
                for (int bj = 0; bj < 2; ++bj) { const f32x4 v0 = acc[ai][bj][m][0], v1 = acc[ai][bj][m][1];
                    u32x4 w; w.x = pack2(v0[0], v0[1]); w.y = pack2(v0[2], v0[3]); w.z = pack2(v1[0], v1[1]); w.w = pack2(v1[2], v1[3]);
                    *(u32x4*)(rowp + bj * HALF) = w; } }
    }
};
struct ProbGU {
    static constexpr int nM = (NE * NB * CAP) / 256, nN = 2048 / 256; static constexpr bool PERM = true; static constexpr int ROWB = 2048; static constexpr bool F8 = false;
    const f16* A; const f16* BT; f16* ACT; const int* IDX; const LAS int* tab;
    DI unsigned arow(int ui, const Unit& u, int r) const { return (unsigned)tab[ui * 256 + r]; }
    DI const char* bptr(const Unit& u) const { return (const char*)(BT + ((size_t)(u.pm >> 4) * 2048 + (size_t)u.pn * 256) * KD); }
    DI void epi(const Acc& acc, const Unit& u, int wr, int wc, int fr, int fq) const {
        const int row0 = u.pm * BM + wr * 64 + fr, col0 = u.pn * 128 + wc * 32 + 8 * fq;
#pragma unroll
        for (int ai = 0; ai < 2; ++ai)
#pragma unroll
            for (int m = 0; m < 4; ++m) { f16* rowp = ACT + (size_t)(row0 + ai * HALF + m * 16) * FF + col0;
                const f32x4 g0 = acc[ai][0][m][0], g1 = acc[ai][0][m][1], u0 = acc[ai][1][m][0], u1 = acc[ai][1][m][1];
                u32x4 w; w.x = pack2(silu_f(g0[0]) * u0[0], silu_f(g0[1]) * u0[1]); w.y = pack2(silu_f(g0[2]) * u0[2], silu_f(g0[3]) * u0[3]);
                w.z = pack2(silu_f(g1[0]) * u1[0], silu_f(g1[1]) * u1[1]); w.w = pack2(silu_f(g1[2]) * u1[2], silu_f(g1[3]) * u1[3]);
                *(u32x4*)rowp = w; }
    }
};
struct ProbDown {
    static constexpr int nM = (NE * NB * CAP) / 256, nN = DM / 256; static constexpr bool PERM = true; static constexpr int ROWB = 2048; static constexpr bool F8 = false;
    const f16* A; const f16* BT; f16* YM; const LAS float* gtab; mutable int ord;
    DI unsigned arow(int, const Unit& u, int r) const { return (unsigned)(u.pm * 256 + r); }
    DI const char* bptr(const Unit& u) const { return (const char*)(BT + ((size_t)(u.pm >> 4) * 1024 + (size_t)u.pn * 256) * KD); }
    DI void epi(const Acc& acc, const Unit& u, int wr, int wc, int fr, int fq) const {
        const int row0 = u.pm * BM + wr * 64 + fr, col0 = u.pn * BM + wc * 32 + 8 * fq;
#pragma unroll
        for (int ai = 0; ai < 2; ++ai)
#pragma unroll
            for (int m = 0; m < 4; ++m) { const int row = row0 + ai * HALF + m * 16; const float g = gtab[ord * 256 + (row & 255)]; f16* rowp = YM + (size_t)row * DM + col0;
#pragma unroll
                for (int bj = 0; bj < 2; ++bj) { const f32x4 v0 = acc[ai][bj][m][0] * g, v1 = acc[ai][bj][m][1] * g;
                    u32x4 w; w.x = pack2(v0[0], v0[1]); w.y = pack2(v0[2], v0[3]); w.z = pack2(v1[0], v1[1]); w.w = pack2(v1[2], v1[3]);
                    *(u32x4*)(rowp + bj * HALF) = w; } }
        ++ord;
    }
};

constexpr float F8_SW = 64.f, F8_SACT = 8.f, F8_SY = 32.f, F8_SYO = 4.f;
typedef float f32x2g __attribute__((ext_vector_type(2)));
DI f32x4 unpack4f8(unsigned w) { const f32x2g lo = __builtin_amdgcn_cvt_pk_f32_fp8((int)w, false), hi = __builtin_amdgcn_cvt_pk_f32_fp8((int)w, true); return (f32x4){lo.x, lo.y, hi.x, hi.y}; }
struct ProbGU8 {
    static constexpr int nM = (NE * NB * CAP) / 256, nN = 2048 / 256; static constexpr bool PERM = true; static constexpr int ROWB = 1024; static constexpr bool F8 = true;
    const unsigned char* A; const unsigned char* BT; unsigned char* ACT; const LAS int* tab;
    DI unsigned arow(int ui, const Unit& u, int r) const { return (unsigned)tab[ui * 256 + r]; }
    DI const char* bptr(const Unit& u) const { return (const char*)(BT + ((size_t)(u.pm >> 4) * 2048 + (size_t)u.pn * 256) * 1024); }
    DI void epi(const Acc& acc, const Unit& u, int wr, int wc, int fr, int fq) const {
        const int row0 = u.pm * BM + wr * 64 + fr, col0 = u.pn * 128 + wc * 32 + 8 * fq;
        constexpr float sg = 1.f / F8_SW, su = F8_SACT / F8_SW;
#pragma unroll
        for (int ai = 0; ai < 2; ++ai)
#pragma unroll
            for (int m = 0; m < 4; ++m) { unsigned char* rowp = ACT + (size_t)(row0 + ai * HALF + m * 16) * FF + col0;
                const f32x4 g0 = acc[ai][0][m][0], g1 = acc[ai][0][m][1], u0 = acc[ai][1][m][0], u1 = acc[ai][1][m][1];
                u32x2g w; w.x = pack4f8(silu_f(g0[0] * sg) * (u0[0] * su), silu_f(g0[1] * sg) * (u0[1] * su), silu_f(g0[2] * sg) * (u0[2] * su), silu_f(g0[3] * sg) * (u0[3] * su));
                w.y = pack4f8(silu_f(g1[0] * sg) * (u1[0] * su), silu_f(g1[1] * sg) * (u1[1] * su), silu_f(g1[2] * sg) * (u1[2] * su), silu_f(g1[3] * sg) * (u1[3] * su));
                *(u32x2g*)rowp = w; }
    }
};
struct ProbDown8 {
    static constexpr int nM = (NE * NB * CAP) / 256, nN = DM / 256; static constexpr bool PERM = true; static constexpr int ROWB = 1024; static constexpr bool F8 = true;
    const unsigned char* A; const unsigned char* BT; unsigned char* YM; const LAS float* gtab; mutable int ord;
    DI unsigned arow(int, const Unit& u, int r) const { return (unsigned)(u.pm * 256 + r); }
    DI const char* bptr(const Unit& u) const { return (const char*)(BT + ((size_t)(u.pm >> 4) * 1024 + (size_t)u.pn * 256) * 1024); }
    DI void epi(const Acc& acc, const Unit& u, int wr, int wc, int fr, int fq) const {
        const int row0 = u.pm * BM + wr * 64 + fr, col0 = u.pn * BM + wc * 32 + 8 * fq;
#pragma unroll
        for (int ai = 0; ai < 2; ++ai)
#pragma unroll
            for (int m = 0; m < 4; ++m) { const int row = row0 + ai * HALF + m * 16; const float g = gtab[ord * 256 + (row & 255)] * (F8_SY / (F8_SW * F8_SACT)); unsigned char* rowp = YM + (size_t)row * DM + col0;
#pragma unroll
                for (int bj = 0; bj < 2; ++bj) { const f32x4 v0 = acc[ai][bj][m][0] * g, v1 = acc[ai][bj][m][1] * g;
                    u32x2g w; w.x = pack4f8(v0[0], v0[1], v0[2], v0[3]); w.y = pack4f8(v1[0], v1[1], v1[2], v1[3]);
                    *(u32x2g*)(rowp + bj * HALF) = w; } }
        ++ord;
    }
};
struct ProbOut8 {
    static constexpr int nM = MLAT / 256, nN = DM / 256; static constexpr bool PERM = true; static constexpr int ROWB = 1024; static constexpr bool F8 = true;
    const unsigned char* A; const unsigned char* BT; f16* R;
    DI unsigned arow(int, const Unit& u, int r) const { return (unsigned)(u.pm * 256 + r); }
    DI const char* bptr(const Unit& u) const { return (const char*)(BT + (size_t)u.pn * 256 * 1024); }
    DI void epi(const Acc& acc, const Unit& u, int wr, int wc, int fr, int fq) const {
        const int row0 = u.pm * BM + wr * 64 + fr, col0 = u.pn * BM + wc * 32 + 8 * fq;
        constexpr float sc = 1.f / (F8_SYO * F8_SW);
#pragma unroll
        for (int ai = 0; ai < 2; ++ai)
#pragma unroll
            for (int m = 0; m < 4; ++m) { f16* rowp = R + (size_t)(row0 + ai * HALF + m * 16) * DM + col0;
#pragma unroll
                for (int bj = 0; bj < 2; ++bj) { const f32x4 v0 = acc[ai][bj][m][0] * sc, v1 = acc[ai][bj][m][1] * sc;
                    u32x4 w; w.x = pack2(v0[0], v0[1]); w.y = pack2(v0[2], v0[3]); w.z = pack2(v1[0], v1[1]); w.w = pack2(v1[2], v1[3]);
                    *(u32x4*)(rowp + bj * HALF) = w; } }
    }
};
}

#define XB_TMO      128
#define XB_XCNT(j)  (256  + 64 * (j))
#define XB_XSUB(j)  (1280 + 64 * (j))
#define XB_XGEN(j)  (2304 + 64 * (j))
#define XB_TOP      3328
#define XB_TOPGEN   3392
#define XCD_BAR_WORDS 3456
#define XB_SPIN_CAP (1u << 22)
DI unsigned xb_ld(unsigned* p)              { return __hip_atomic_load(p, __ATOMIC_RELAXED, __HIP_MEMORY_SCOPE_AGENT); }
DI unsigned xb_add(unsigned* p, unsigned v) { return __hip_atomic_fetch_add(p, v, __ATOMIC_RELAXED, __HIP_MEMORY_SCOPE_AGENT); }
DI unsigned xb_xcc_id() { return (unsigned)__builtin_amdgcn_s_getreg((3 << 11) | 20) & 0xFu; }
#define XB_SPIN(cond, bar) do { unsigned _sp = 0; while (cond) { __builtin_amdgcn_s_sleep(1); \
    if ((++_sp & 255u) == 0u) { if (xb_ld(&(bar)[XB_TMO])) break; if (_sp > XB_SPIN_CAP) { atomicAdd(&(bar)[XB_TMO], 1u); break; } } } } while (0)
struct XcdBarrier { unsigned* bar; unsigned x; volatile LAS unsigned* st; };
DI XcdBarrier xcd_barrier_post(unsigned* bar, volatile LAS unsigned* st) {
    XcdBarrier b; b.bar = bar; b.x = xb_xcc_id(); b.st = st;
    if (threadIdx.x == 0) (void)xb_add(&bar[XB_XCNT(b.x)], 1u);
    return b;
}
DI void xcd_barrier_complete(unsigned* bar, unsigned x, unsigned& nloc, unsigned& nx) {
    const unsigned G = gridDim.x * gridDim.y * gridDim.z;
    unsigned sum, cnt, mine, sp = 0u;
    for (;;) {
        sum = 0u; cnt = 0u; mine = 0u;
#pragma unroll
        for (unsigned j = 0; j < 16; ++j) { const unsigned c = xb_ld(&bar[XB_XCNT(j)]); sum += c; cnt += (c > 0u) ? 1u : 0u; mine = (j == x) ? c : mine; }
        if (sum == G) break;
        __builtin_amdgcn_s_sleep(1);
        if ((++sp & 255u) == 0u) { if (xb_ld(&bar[XB_TMO])) break; if (sp > XB_SPIN_CAP) { atomicAdd(&bar[XB_TMO], 1u); break; } }
    }
    nloc = mine > 0u ? mine : 1u; nx = cnt > 0u ? cnt : 1u;
}
DI void xcd_barrier(const XcdBarrier& b) {
    asm volatile("s_waitcnt vmcnt(0)" ::: "memory");
    __syncthreads();
    if (threadIdx.x == 0) {
        unsigned* bar = b.bar;
        __builtin_amdgcn_s_waitcnt(0);
        unsigned nloc = b.st[0], nx = b.st[1];
        if (nloc == 0u) { xcd_barrier_complete(bar, b.x, nloc, nx); b.st[0] = nloc; b.st[1] = nx; }
        const unsigned old = xb_add(&bar[XB_XSUB(b.x)], 1u);
        const unsigned gen = old / nloc;
        if (old + 1u == (gen + 1u) * nloc) {
            __builtin_amdgcn_fence(__ATOMIC_RELEASE, "agent");
            asm volatile("s_waitcnt vmcnt(0)" ::: "memory");
            const unsigned og = xb_add(&bar[XB_TOP], 1u);
            const unsigned tg = og / nx;
            if (og + 1u == (tg + 1u) * nx) xb_add(&bar[XB_TOPGEN], 1u);
            else XB_SPIN(xb_ld(&bar[XB_TOPGEN]) == tg, bar);
            __builtin_amdgcn_fence(__ATOMIC_ACQUIRE, "agent");
            xb_add(&bar[XB_XGEN(b.x)], 1u);
            asm volatile("s_waitcnt vmcnt(0)" ::: "memory");
        } else {
            XB_SPIN(xb_ld(&bar[XB_XGEN(b.x)]) == gen, bar);
            __builtin_amdgcn_fence(__ATOMIC_ACQUIRE, "agent");
            asm volatile("s_waitcnt vmcnt(0)" ::: "memory");
        }
    }
    __syncthreads();
}

constexpr int LDS_TAB_OFF = 131072;
constexpr int LDS_MISC_OFF = 163840 - 256;
constexpr int LDS_BYTES = 163840;
constexpr size_t WS_BAR = 0;
constexpr size_t WS_CTL_BYTES = 65536;
struct Args { const float* in[21]; float* out; unsigned char* ws; int hi; int pad; };
enum { PH_PREP = 0, PH_HROWS, PH_GEMM_IN, PH_CONV, PH_MA, PH_MB, PH_MC, PH_GEMM_OUT, PH_POST, PH_TOPK, PH_GEMM_GU, PH_GEMM_DOWN, PH_COMBINE, PH_COUNT };

struct Ctx {
    LAS unsigned char* lds; int tid, lane, wave, G, c;
    const float *x, *cvec, *ctx, *c_ctx, *ada_w, *ada_b, *norm_w, *w_in, *conv_w, *conv_b, *dt_bias, *a_log, *ssd_d, *ssd_nw, *hgrn_lb, *hgrn_nw, *w_out, *w_router, *w_gate, *w_up, *w_down;
    float* out; unsigned char* ws;
    DI float* MOD() const { return (float*)(ws + WS_MOD); }   DI float* DT() const { return (float*)(ws + WS_DT); }   DI float* WDT() const { return (float*)(ws + WS_WDT); }
    DI float* AFF() const { return (float*)(ws + WS_AFF); }   DI float* GATEV() const { return (float*)(ws + WS_GATEV); }   DI f16* R() const { return (f16*)(ws + WS_R); }
    DI f16* XLAT() const { return (f16*)(ws + WS_Y); }   DI int* IDX() const { return (int*)(ws + WS_IDX); }   DI int* SLOT() const { return (int*)(ws + WS_SLOT); }
    DI f16* WIN() const { return (f16*)(ws + WS_WIN); }   DI f16* WOUT() const { return (f16*)(ws + WS_WOUT); }   DI f16* WGU() const { return (f16*)(ws + WS_WGU); }   DI f16* WD() const { return (f16*)(ws + WS_WD); }
    DI f16* H() const { return (f16*)(ws + WS_H); }   DI f16* H2() const { return (f16*)(ws + WS_H); }   DI f16* U() const { return (f16*)(ws + WS_U); }   DI f16* Y() const { return (f16*)(ws + WS_Y); }
    DI f16* ACT() const { return (f16*)(ws + WS_ACT); }   DI f16* YM() const { return (f16*)(ws + WS_YM); }
    DI unsigned char* WGU8() const { return ws + WS_WGU; }   DI unsigned char* WD8() const { return ws + WS_WD; }   DI unsigned char* ACT8() const { return ws + WS_ACT; }   DI unsigned char* H2Q() const { return ws + WS_YM; }   DI unsigned char* YM8() const { return ws + WS_YM; }
};

struct TrItem { const float* src; int ld, col0, k0; f16* dst; int ldd; };
DI void tr_load(const TrItem& t, int lane, f32x4 (&v)[8]) {
#pragma unroll
    for (int i = 0; i < 8; ++i) v[i] = __builtin_nontemporal_load((const f32x4*)(t.src + (size_t)(t.k0 + 8 * i + (lane >> 3)) * t.ld + t.col0 + 4 * (lane & 7)));
}
template <bool Q = false>
DI void tr_store(const TrItem& t, int lane, const f32x4 (&v)[8], LAS float* scr) {
#pragma unroll
    for (int i = 0; i < 8; ++i) { LAS float* p = scr + (8 * i + (lane >> 3)) * 33 + 4 * (lane & 7); p[0] = v[i].x; p[1] = v[i].y; p[2] = v[i].z; p[3] = v[i].w; }
    asm volatile("s_waitcnt lgkmcnt(0)" ::: "memory");
    const int cc = lane & 7;
#pragma unroll
    for (int j = 0; j < 4; ++j) { const int n = (lane >> 3) + 8 * j; const LAS float* s = scr + (8 * cc) * 33 + n;
        if constexpr (Q) { gm::u32x2g o; o.x = gm::pack4f8(s[0 * 33] * gm::F8_SW, s[1 * 33] * gm::F8_SW, s[2 * 33] * gm::F8_SW, s[3 * 33] * gm::F8_SW); o.y = gm::pack4f8(s[4 * 33] * gm::F8_SW, s[5 * 33] * gm::F8_SW, s[6 * 33] * gm::F8_SW, s[7 * 33] * gm::F8_SW);
            *(gm::u32x2g*)((unsigned char*)t.dst + (size_t)n * t.ldd + t.k0 + 8 * cc) = o; }
        else { u32x4 o; o.x = gm::pack2(s[0 * 33], s[1 * 33]); o.y = gm::pack2(s[2 * 33], s[3 * 33]); o.z = gm::pack2(s[4 * 33], s[5 * 33]); o.w = gm::pack2(s[6 * 33], s[7 * 33]);
            *(u32x4*)(t.dst + (size_t)n * t.ldd + t.k0 + 8 * cc) = o; } }
    asm volatile("s_waitcnt lgkmcnt(0)" ::: "memory");
}
DI void tr_item(const float* src, int ld, int col0, int k0, f16* dst_row0, int ldd, LAS float* scr, int lane) {
    const TrItem t{src, ld, col0, k0, dst_row0, ldd}; f32x4 v[8]; tr_load(t, lane, v); tr_store(t, lane, v, scr);
}
constexpr int PREP_ITEMS = 16 * 128 + 16 * 32;
DI TrItem prep_item(const Ctx& F, int r) {
    constexpr int I_IN = 16 * 128;
    if (r < I_IN) { const int kb = r / 128, nb = r % 128, n0 = nb * 32; return TrItem{F.w_in, INCOLS, n0 < 1536 ? n0 : n0 + 16, kb * 64, F.WIN() + (size_t)n0 * DM, DM}; }
    r -= I_IN; const int kb = r / 32, nb = r % 32; return TrItem{F.w_out, DM, nb * 32, kb * 64, (f16*)((unsigned char*)F.WOUT() + (size_t)nb * 32 * 1024), 1024};
}
DI void phase_prep(const Ctx& F) {
    const int gw0 = F.c * 8 + F.wave, NGW0 = F.G * 8;
    f32x4 v0[8]; tr_load(prep_item(F, gw0), F.lane, v0);
    {
        LAS float* sv = (LAS float*)F.lds;
        LAS float* red = sv + 5 * DM;
        for (int i = F.tid; i < 5 * DM; i += 512) { const int r = i >> 10, k = i & 1023; sv[i] = silu_f(r < 4 ? F.cvec[r * DM + k] : F.c_ctx[k]); }
        __syncthreads();
        const int col = F.tid % 24, kg = F.tid / 24, j = F.c * 24 + col;
        if (kg < 21) {
            float a[5] = {0, 0, 0, 0, 0};
            int k = kg;
            for (; k + 6 * 21 < DM; k += 7 * 21) { float w[7];
#pragma unroll
                for (int q = 0; q < 7; ++q) w[q] = F.ada_w[(size_t)(k + 21 * q) * 6144 + j];
#pragma unroll
                for (int q = 0; q < 7; ++q)
#pragma unroll
                    for (int r = 0; r < 5; ++r) a[r] += sv[r * DM + k + 21 * q] * w[q]; }
            for (; k < DM; k += 21) { const float w = F.ada_w[(size_t)k * 6144 + j];
#pragma unroll
                for (int r = 0; r < 5; ++r) a[r] += sv[r * DM + k] * w; }
#pragma unroll
            for (int r = 0; r < 5; ++r) red[(kg * 24 + col) * 5 + r] = a[r];
        }
        __syncthreads();
        if (F.tid < 120) { const int cl = F.tid % 24, r = F.tid / 24; float s = 0.f; for (int g = 0; g < 21; ++g) s += red[(g * 24 + cl) * 5 + r]; const int jj = F.c * 24 + cl; F.MOD()[r * 6144 + jj] = s + F.ada_b[jj]; }
        __syncthreads();
    }
    for (int i = F.c * 512 + F.tid; i < 16 * DM; i += F.G * 512) { const int j = i >> 10, k = i & 1023; F.WDT()[i] = F.w_in[(size_t)k * INCOLS + 1536 + j]; }
    LAS float* scr = (LAS float*)(F.lds + F.wave * 8704);
    if (gw0 < 16 * 128) tr_store(prep_item(F, gw0), F.lane, v0, scr); else tr_store<true>(prep_item(F, gw0), F.lane, v0, scr);
    for (int it = gw0 + NGW0; it < PREP_ITEMS; it += NGW0) { const TrItem t = prep_item(F, it); f32x4 v[8]; tr_load(t, F.lane, v); if (it < 16 * 128) tr_store(t, F.lane, v, scr); else tr_store<true>(t, F.lane, v, scr); }
}
constexpr int MOE_ITEMS = 16 * 16 * 64 + 16 * 16 * 32, MOE_IDLE_WG0 = 64, MOE_SPLIT = 13312;
DI TrItem moe_item(const Ctx& F, int r) {
    constexpr int I_GU = 16 * 16 * 64;
    if (r < I_GU) { const int e = r / 1024, q = r % 1024, kb = q / 64, nb = q % 64, r0 = nb * 32, blk = r0 >> 7, within = r0 & 127, isu = blk & 1, f0 = (blk >> 1) * 128 + within;
        return TrItem{(isu ? F.w_up : F.w_gate) + (size_t)e * DM * FF, FF, f0, kb * 64, (f16*)(F.WGU8() + ((size_t)e * 2048 + r0) * 1024), 1024}; }
    r -= I_GU;
    const int e = r / 512, q = r % 512, kb = q / 32, nb = q % 32;
    return TrItem{F.w_down + (size_t)e * FF * DM, DM, nb * 32, kb * 64, (f16*)(F.WD8() + ((size_t)e * DM + nb * 32) * 1024), 1024};
}
DI void moe_convert(const Ctx& F, int it0, int it1) {
    if (F.c < MOE_IDLE_WG0) return;
    LAS float* scr = (LAS float*)(F.lds + F.wave * 8704);
    const int gw = (F.c - MOE_IDLE_WG0) * 8 + F.wave, NGW = (F.G - MOE_IDLE_WG0) * 8;
    for (int it = it0 + gw; it < it1; it += 2 * NGW) {
        const TrItem t0 = moe_item(F, it); f32x4 v0[8], v1[8]; tr_load(t0, F.lane, v0);
        const bool two = it + NGW < it1;
        const TrItem t1 = moe_item(F, two ? it + NGW : it);
        if (two) tr_load(t1, F.lane, v1);
        tr_store<true>(t0, F.lane, v0, scr);
        if (two) tr_store<true>(t1, F.lane, v1, scr);
    }
}

DI void phase_hrows(const Ctx& F) {
    constexpr int WROW = 2048 + 16;
    LAS unsigned char* wh = F.lds; LAS unsigned char* wl = F.lds + 16 * WROW;
    { f32x4 t[8];
#pragma unroll
      for (int q = 0; q < 8; ++q) t[q] = *(const f32x4*)(F.WDT() + 4 * (F.tid + 512 * q));
#pragma unroll
      for (int q = 0; q < 8; ++q) { const int i = 4 * (F.tid + 512 * q), d = i >> 10, k = i & 1023; f16x4 hi, lo;
#pragma unroll
          for (int e = 0; e < 4; ++e) { hi[e] = (f16)t[q][e]; lo[e] = (f16)(t[q][e] - (float)hi[e]); }
          *(LAS f16x4*)(wh + d * WROW + k * 2) = hi; *(LAS f16x4*)(wl + d * WROW + k * 2) = lo; } }
    LAS float* NW0 = (LAS float*)(F.lds + 2 * 16 * WROW); LAS float* SH1 = NW0 + DM; LAS float* SC1 = SH1 + 5 * DM;
    { float a[2], s[10], c[10];
#pragma unroll
      for (int q = 0; q < 2; ++q) a[q] = F.norm_w[F.tid + 512 * q];
#pragma unroll
      for (int q = 0; q < 10; ++q) { const int i = F.tid + 512 * q, r = i >> 10, k = i & 1023; s[q] = F.MOD()[r * 6144 + k]; c[q] = F.MOD()[r * 6144 + 1024 + k]; }
#pragma unroll
      for (int q = 0; q < 2; ++q) NW0[F.tid + 512 * q] = a[q];
#pragma unroll
      for (int q = 0; q < 10; ++q) { SH1[F.tid + 512 * q] = s[q]; SC1[F.tid + 512 * q] = c[q]; } }
    asm volatile("s_waitcnt vmcnt(0)" ::: "memory");
    __syncthreads();
    const int gw = F.c * 8 + F.wave, NGW = F.G * 8, lane = F.lane;
    LAS unsigned char* hbuf = (LAS unsigned char*)(SC1 + 5 * DM) + F.wave * (2 * WROW);
#define HR_LOAD(XX, rw) do { if ((rw) < MTOT) { const float* xr = (rw) < MLAT ? F.x + (size_t)(rw) * DM : F.ctx + (size_t)((rw) - MLAT) * DM; \
        _Pragma("unroll") for (int j = 0; j < 4; ++j) XX[j] = __builtin_nontemporal_load((const f32x4*)(xr + 4 * lane + 256 * j)); } } while (0)
#define HR_NORM(XX, row, SL) do { \
        const int r = (row) < MLAT ? (row) / SEQ : 4; float ss = 0.f; f32x4 V[4]; \
        _Pragma("unroll") for (int j = 0; j < 4; ++j) { V[j] = XX[j]; ss += V[j].x * V[j].x + V[j].y * V[j].y + V[j].z * V[j].z + V[j].w * V[j].w; } \
        const float rstd = rsqrtf(wave_sum(ss) * (1.f / DM) + EPS); \
        _Pragma("unroll") for (int j = 0; j < 4; ++j) { const int k = 4 * lane + 256 * j; \
            const f32x4 nw = *(const LAS f32x4*)(NW0 + k), sc = *(const LAS f32x4*)(SC1 + r * DM + k), sh = *(const LAS f32x4*)(SH1 + r * DM + k); \
            V[j] = V[j] * rstd * nw * (1.f + sc) + sh; \
            f16x4 o; o.x = (f16)V[j].x; o.y = (f16)V[j].y; o.z = (f16)V[j].z; o.w = (f16)V[j].w; \
            *(f16x4*)(F.H() + (size_t)(row) * DM + k) = o; *(LAS f16x4*)(hbuf + (SL) * WROW + k * 2) = o; } } while (0)
    {
        f32x4 xA[4], xB[4];
        HR_LOAD(xA, gw); HR_LOAD(xB, gw + NGW);
        const int fr = lane & 15, fq = lane >> 4;
        for (int row = gw; row < MTOT; row += 2 * NGW) {
            const int rowb = row + NGW < MTOT ? row + NGW : row;
            HR_NORM(xA, row, 0);
            if (row + NGW < MTOT) { HR_NORM(xB, rowb, 1); }
            HR_LOAD(xA, row + 2 * NGW); HR_LOAD(xB, row + 3 * NGW);
            asm volatile("s_waitcnt lgkmcnt(0)" ::: "memory");
            f32x4 ah = (f32x4){0, 0, 0, 0}, al = ah;
            const LAS unsigned char* ar = hbuf + (fr & 1) * WROW + 16 * fq;
#pragma unroll
            for (int kk = 0; kk < 32; ++kk) { const f16x8 av = *(const LAS f16x8*)(ar + 64 * kk);
                ah = __builtin_amdgcn_mfma_f32_16x16x32_f16(av, *(const LAS f16x8*)(wh + fr * WROW + 64 * kk + 16 * fq), ah, 0, 0, 0);
                al = __builtin_amdgcn_mfma_f32_16x16x32_f16(av, *(const LAS f16x8*)(wl + fr * WROW + 64 * kk + 16 * fq), al, 0, 0, 0); }
            if (lane < 16) { F.DT()[(size_t)row * 16 + lane] = ah[0] + al[0]; if (row + NGW < MTOT) F.DT()[(size_t)rowb * 16 + lane] = ah[1] + al[1]; }
            asm volatile("s_waitcnt lgkmcnt(0)" ::: "memory");
        }
    }
#undef HR_NORM
#undef HR_LOAD
    __syncthreads();
}

DI void phase_conv(const Ctx& F) {
    const int tid = F.tid;
    int cg = tid & 15, tg = tid >> 4, s0 = 8 * tg;
    constexpr int NUNIT = (MTOT / 256) * 8, NMAIN = (NUNIT / 256) * 256;
#define CV_LOAD(RAW, u) do { const int _rb = (u) >> 3, _cc = ((u) & 7) * 128 + cg * 8; const int _lo = _rb < MLAT / 256 ? (s0 & ~63) : 0, _hi = _rb < MLAT / 256 ? _lo + 64 : 256; \
        const f16* _base = F.U() + (size_t)_rb * 256 * NU + UXBC + _cc; \
        _Pragma("unroll") for (int i = 0; i < 12; ++i) { const int s = s0 - 2 + i; const bool ok = s >= _lo && s < _hi; \
            if (ok) RAW[i] = *(const f16x8*)(_base + (size_t)s * NU); else RAW[i] = (f16x8){0, 0, 0, 0, 0, 0, 0, 0}; } } while (0)
#define CV_WLOAD(cc) float w[5][8], bb[8]; \
        { const f32x4 b0 = *(const f32x4*)(F.conv_b + (cc)), b1 = *(const f32x4*)(F.conv_b + (cc) + 4); \
          _Pragma("unroll") for (int j = 0; j < 4; ++j) { bb[j] = b0[j]; bb[4 + j] = b1[j]; } } \
        _Pragma("unroll") for (int tp = 0; tp < 5; ++tp) { const f32x4 w0 = *(const f32x4*)(F.conv_w + tp * 1024 + (cc)), w1 = *(const f32x4*)(F.conv_w + tp * 1024 + (cc) + 4); \
            _Pragma("unroll") for (int j = 0; j < 4; ++j) { w[tp][j] = w0[j]; w[tp][4 + j] = w1[j]; } }
#define CV_COMPUTE(O, RAW) do { \
        _Pragma("unroll") for (int t = 0; t < 8; ++t) _Pragma("unroll") for (int j = 0; j < 8; ++j) { float a = bb[j]; \
            _Pragma("unroll") for (int tp = 0; tp < 5; ++tp) a += w[tp][j] * (float)RAW[t + tp][j]; \
            O[t][j] = (f16)silu_f(a); } } while (0)
    {
    int u = F.c;
    f16x8 nraw[12]; CV_LOAD(nraw, u);
    for (; u < NMAIN; u += F.G) {
        const int rb = u >> 3, cb8 = u & 7, row0 = rb * 256, cc = cb8 * 128 + cg * 8;
        f16* base = F.U() + (size_t)row0 * NU + UXBC + cc;
        f16x8 raw[12];
#pragma unroll
        for (int i = 0; i < 12; ++i) raw[i] = nraw[i];
        CV_WLOAD(cc);
        if (u + F.G < NMAIN) CV_LOAD(nraw, u + F.G);
        f16x8 o[8]; CV_COMPUTE(o, raw);
        __syncthreads();
#pragma unroll
        for (int t = 0; t < 8; ++t) *(f16x8*)(base + (size_t)(s0 + t) * NU) = o[t];
    }
    }
    {
        const int ut = NMAIN + (F.c >> 3), part = F.c & 7;
        if (F.wave == 0 && ut < NUNIT) {
            cg = 2 * part + (F.lane & 1); tg = F.lane >> 1; s0 = 8 * tg;
            f16x8 raw[12]; CV_LOAD(raw, ut);
            const int cc = (ut & 7) * 128 + cg * 8;
            CV_WLOAD(cc);
            f16x8 o[8]; CV_COMPUTE(o, raw);
            f16* base = F.U() + (size_t)(ut >> 3) * 256 * NU + UXBC + cc;
#pragma unroll
            for (int t = 0; t < 8; ++t) *(f16x8*)(base + (size_t)(s0 + t) * NU) = o[t];
        }
        cg = tid & 15; tg = tid >> 4; s0 = 8 * tg;
    }
#undef CV_LOAD
#undef CV_WLOAD
#undef CV_COMPUTE
}

DI void phase_post(const Ctx& F) {
    LAS f16* wr16 = (LAS f16*)F.lds;
    {
        float t[32];
#pragma unroll
        for (int q = 0; q < 32; ++q) t[q] = F.w_router[F.tid + 512 * q];
#pragma unroll
        for (int q = 0; q < 32; ++q) { const int i = F.tid + 512 * q; wr16[(i & 15) * DM + (i >> 4)] = (f16)t[q]; }
    }
    LAS float* NW1 = (LAS float*)(F.lds + 32768); LAS float* NW2 = NW1 + DM; LAS float* G1 = NW2 + DM; LAS float* SH2 = G1 + 4 * DM; LAS float* SC2 = SH2 + 4 * DM;
    {
        float a[2], b2[2], g[8], s[8], c[8];
#pragma unroll
        for (int q = 0; q < 2; ++q) { a[q] = F.norm_w[1024 + F.tid + 512 * q]; b2[q] = F.norm_w[2048 + F.tid + 512 * q]; }
#pragma unroll
        for (int q = 0; q < 8; ++q) { const int i = F.tid + 512 * q, b = i >> 10, k = i & 1023; g[q] = F.MOD()[b * 6144 + 2048 + k]; s[q] = F.MOD()[b * 6144 + 3072 + k]; c[q] = F.MOD()[b * 6144 + 4096 + k]; }
#pragma unroll
        for (int q = 0; q < 2; ++q) { NW1[F.tid + 512 * q] = a[q]; NW2[F.tid + 512 * q] = b2[q]; }
#pragma unroll
        for (int q = 0; q < 8; ++q) { const int i = F.tid + 512 * q; G1[i] = g[q]; SH2[i] = s[q]; SC2[i] = c[q]; }
    }
    asm volatile("s_waitcnt vmcnt(0)" ::: "memory");
    __syncthreads();
    const int lane = F.lane, gw = F.c * 8 + F.wave, NGW = F.G * 8;
    constexpr int HB_ROW = 2048 + 16;
    LAS unsigned char* hbuf = F.lds + 90112 + F.wave * (4 * HB_ROW);
#define POST_LOAD(RR, XX, rw) do { if ((rw) < MLAT) { _Pragma("unroll") for (int j = 0; j < 4; ++j) { RR[j] = *(const f16x4*)(F.R() + (size_t)(rw) * DM + 4 * lane + 256 * j); XX[j] = __builtin_nontemporal_load((const f32x4*)(F.x + (size_t)(rw) * DM + 4 * lane + 256 * j)); } } } while (0)
#define POST_ROW(RR, XX, row, SL) do { \
        const int b = (row) / SEQ; \
        int lo = 4 * lane; asm volatile("" : "+v"(lo)); \
        f32x4 r[4], xl[4]; float ss = 0.f; \
        _Pragma("unroll") for (int j = 0; j < 4; ++j) { const f16x4 rh = RR[j]; r[j] = (f32x4){(float)rh.x, (float)rh.y, (float)rh.z, (float)rh.w}; xl[j] = XX[j]; ss += r[j].x * r[j].x + r[j].y * r[j].y + r[j].z * r[j].z + r[j].w * r[j].w; } \
        POST_LOAD(RR, XX, (row) + 2 * NGW); \
        const float rstd = rsqrtf(wave_sum(ss) * (1.f / DM) + EPS); \
        float s2 = 0.f; \
        _Pragma("unroll") for (int j = 0; j < 4; ++j) { const int k = lo + 256 * j; \
            const f32x4 nw = *(const LAS f32x4*)(NW1 + k), gt = *(const LAS f32x4*)(G1 + b * DM + k); \
            xl[j] = xl[j] + gt * (r[j] * rstd * nw); \
            { f16x4 o; o.x = (f16)xl[j].x; o.y = (f16)xl[j].y; o.z = (f16)xl[j].z; o.w = (f16)xl[j].w; *(f16x4*)(F.XLAT() + (size_t)(row) * DM + k) = o; } \
            s2 += xl[j].x * xl[j].x + xl[j].y * xl[j].y + xl[j].z * xl[j].z + xl[j].w * xl[j].w; } \
        const float rstd2 = rsqrtf(wave_sum(s2) * (1.f / DM) + EPS); \
        _Pragma("unroll") for (int j = 0; j < 4; ++j) { const int k = lo + 256 * j; \
            const f32x4 nw = *(const LAS f32x4*)(NW2 + k), sh = *(const LAS f32x4*)(SH2 + b * DM + k), sc = *(const LAS f32x4*)(SC2 + b * DM + k); \
            const f32x4 hv = xl[j] * rstd2 * nw * (1.f + sc) + sh; \
            f16x4 o; o.x = (f16)hv.x; o.y = (f16)hv.y; o.z = (f16)hv.z; o.w = (f16)hv.w; \
            *(LAS f16x4*)(hbuf + (SL) * HB_ROW + k * 2) = o; \
            *(unsigned*)(F.H2Q() + (size_t)(row) * DM + k) = gm::pack4f8(hv.x, hv.y, hv.z, hv.w); } } while (0)
    {
        f16x4 rA[4], rB[4]; f32x4 xA[4], xB[4];
        POST_LOAD(rA, xA, gw); POST_LOAD(rB, xB, gw + NGW);
        const int fr = lane & 15, fq = lane >> 4;
        for (int bt = 0; bt < 4; ++bt) {
            const int row = gw + 4 * bt * NGW;
            POST_ROW(rA, xA, row, 0); POST_ROW(rB, xB, row + NGW, 1); POST_ROW(rA, xA, row + 2 * NGW, 2); POST_ROW(rB, xB, row + 3 * NGW, 3);
            asm volatile("s_waitcnt lgkmcnt(0)" ::: "memory");
            f32x4 acc = (f32x4){0, 0, 0, 0};
            const LAS unsigned char* ar = hbuf + (fr & 3) * HB_ROW + 16 * fq;
#pragma unroll
            for (int kk = 0; kk < 32; ++kk)
                acc = __builtin_amdgcn_mfma_f32_16x16x32_f16(*(const LAS f16x8*)(ar + 64 * kk), *(const LAS f16x8*)(wr16 + fr * DM + 32 * kk + 8 * fq), acc, 0, 0, 0);
#pragma unroll
            for (int r = 0; r < 4; ++r) {
                float mx = acc[r];
#pragma unroll
                for (int o = 1; o < 16; o <<= 1) mx = fmaxf(mx, __shfl_xor(mx, o));
                const float ex = __expf(acc[r] - mx);
                float den = ex;
#pragma unroll
                for (int o = 1; o < 16; o <<= 1) den += __shfl_xor(den, o);
                const int rw = row + r * NGW, b = rw / SEQ, t = rw % SEQ;
                if (fq == 0) F.AFF()[((size_t)b * 16 + fr) * SEQ + t] = ex * __builtin_amdgcn_rcpf(den);
            }
            asm volatile("s_waitcnt lgkmcnt(0)" ::: "memory");
        }
    }
#undef POST_LOAD
#undef POST_ROW
    __syncthreads();
}

DI void phase_topk(const Ctx& F) {
    if (F.c >= 64) return;
    LAS unsigned* vals = (LAS unsigned*)F.lds;
    LAS unsigned* hist = vals + SEQ;
    LAS unsigned* sm = hist + 256;
    const int be = F.c, tid = F.tid;
    const float* a = F.AFF() + (size_t)be * SEQ;
    { float t[16];
#pragma unroll
      for (int q = 0; q < 16; ++q) t[q] = a[tid + 512 * q];
#pragma unroll
      for (int q = 0; q < 16; ++q) vals[tid + 512 * q] = __float_as_uint(t[q]); }
    if (tid == 0) { sm[0] = 0u; sm[1] = CAP; }
    __syncthreads();
    unsigned mask = 0u;
    for (int pass = 0; pass < 4; ++pass) {
        const int shift = 24 - 8 * pass;
        if (tid < 256) hist[tid] = 0u;
        __syncthreads();
        const unsigned prefix = sm[0];
        for (int i = tid; i < SEQ; i += 512) { const unsigned v = vals[i]; if ((v & mask) == prefix) atomicAdd((unsigned*)&hist[(v >> shift) & 255u], 1u); }
        __syncthreads();
        {
            const unsigned kcur = sm[1];
            unsigned hv = 0u, suf = 0u;
            if (tid < 256) { hv = hist[255 - tid]; suf = hv;
                for (int o = 1; o < 64; o <<= 1) { const unsigned tt = __shfl_up(suf, o); if ((tid & 63) >= o) suf += tt; }
                if ((tid & 63) == 63) sm[18 + (tid >> 6)] = suf; }
            __syncthreads();
            if (tid < 256) { for (int i = 0; i < (tid >> 6); ++i) suf += sm[18 + i];
                if (suf >= kcur && suf - hv < kcur) { sm[1] = kcur - (suf - hv); sm[0] = prefix | ((unsigned)(255 - tid) << shift); } }
        }
        mask |= 255u << shift;
        __syncthreads();
    }
    const unsigned T = sm[0], keq = sm[1];
    unsigned cg = 0, ce = 0;
    for (int j = 0; j < 16; ++j) { const unsigned v = vals[tid * 16 + j]; cg += v > T; ce += v == T; }
    const int lane = tid & 63, w = tid >> 6;
    unsigned ig = cg, ie = ce;
    for (int o = 1; o < 64; o <<= 1) { const unsigned tg = __shfl_up(ig, o), te = __shfl_up(ie, o); if (lane >= o) { ig += tg; ie += te; } }
    if (lane == 63) { sm[2 + w] = ig; sm[10 + w] = ie; }
    __syncthreads();
    unsigned og = 0, oe = 0;
    for (int i = 0; i < w; ++i) { og += sm[2 + i]; oe += sm[10 + i]; }
    unsigned pg = og + ig - cg, pe = oe + ie - ce;
    const int rowbase = ((be & 15) * 4 + (be >> 4)) * CAP;
    for (int j = 0; j < 16; ++j) {
        const int t = tid * 16 + j; const unsigned v = vals[t];
        int slot = -1;
        if (v > T) { slot = (int)(pg + (pe < keq ? pe : keq)); pg++; }
        else if (v == T) { if (pe < keq) slot = (int)(pg + pe); pe++; }
        F.SLOT()[(size_t)be * SEQ + t] = slot;
        if (slot >= 0) { F.IDX()[rowbase + slot] = t; F.GATEV()[rowbase + slot] = __uint_as_float(v); }
    }
    __syncthreads();
}

DI void phase_combine(const Ctx& F) {
    LAS float* NW3 = (LAS float*)F.lds; LAS float* G2 = NW3 + DM;
    { float a[2], g[8];
#pragma unroll
      for (int q = 0; q < 2; ++q) a[q] = F.norm_w[3072 + F.tid + 512 * q];
#pragma unroll
      for (int q = 0; q < 8; ++q) { const int i = F.tid + 512 * q; g[q] = F.MOD()[(i >> 10) * 6144 + 5120 + (i & 1023)]; }
#pragma unroll
      for (int q = 0; q < 2; ++q) NW3[F.tid + 512 * q] = a[q];
#pragma unroll
      for (int q = 0; q < 8; ++q) G2[F.tid + 512 * q] = g[q]; }
    asm volatile("s_waitcnt vmcnt(0)" ::: "memory");
    __syncthreads();
    const int lane = F.lane, gw = F.c * 8 + F.wave, NGW = F.G * 8;
    if (gw >= MLAT) return;
#define CB_LOADSX(S, X, rw) do { const int _r = (rw) < MLAT ? (rw) : gw; const int _b = _r / SEQ, _t = _r % SEQ; \
        S = F.SLOT()[((size_t)_b * 16 + (lane & 15)) * SEQ + _t]; \
        _Pragma("unroll") for (int j = 0; j < 4; ++j) X[j] = __builtin_nontemporal_load((const f16x4*)(F.XLAT() + (size_t)_r * DM + 4 * lane + 256 * j)); } while (0)
#define CB_LOADY(Y, S, M, rw) do { const int _r = (rw) < MLAT ? (rw) : gw; const int _b = _r / SEQ; unsigned _m = (M); \
        _Pragma("unroll") for (int q = 0; q < 4; ++q) { const bool _has = _m != 0u; const int _e = _has ? __builtin_ctz(_m) : 0; _m &= _m - 1u; \
            const int _s = __shfl(S, _e); const size_t _ro = _has ? (size_t)((_e * 4 + _b) * CAP + _s) : 0; \
            _Pragma("unroll") for (int j = 0; j < 4; ++j) Y[q][j] = *(const unsigned*)(F.YM8() + _ro * DM + 4 * lane + 256 * j); } } while (0)
    int s0, s1, s2; f16x4 x0[4], x1[4], x2[4]; unsigned y0[4][4], y1[4][4];
    CB_LOADSX(s0, x0, gw); CB_LOADSX(s1, x1, gw + NGW);
    unsigned m0 = (unsigned)(__ballot(s0 >= 0) & 0xffffull), m1;
    CB_LOADY(y0, s0, m0, gw);
    for (int row = gw; row < MLAT; row += NGW) {
        CB_LOADSX(s2, x2, row + 2 * NGW);
        m1 = (unsigned)(__ballot(s1 >= 0) & 0xffffull);
        CB_LOADY(y1, s1, m1, row + NGW);
        const int b = row / SEQ;
        f32x4 acc[4];
#pragma unroll
        for (int j = 0; j < 4; ++j) acc[j] = (f32x4){0, 0, 0, 0};
        { unsigned m = m0;
#pragma unroll
          for (int q = 0; q < 4; ++q) { const float on = m != 0u ? 1.f : 0.f; m &= m - 1u;
#pragma unroll
              for (int j = 0; j < 4; ++j) acc[j] += gm::unpack4f8(y0[q][j]) * on; }
          while (m) {
              const int e = __builtin_ctz(m); m &= m - 1u; const int s = __shfl(s0, e);
              const unsigned char* yr = F.YM8() + (size_t)((e * 4 + b) * CAP + s) * DM + 4 * lane;
#pragma unroll
              for (int j = 0; j < 4; ++j) acc[j] += gm::unpack4f8(*(const unsigned*)(yr + 256 * j)); } }
        float ss = 0.f;
#pragma unroll
        for (int j = 0; j < 4; ++j) ss += acc[j].x * acc[j].x + acc[j].y * acc[j].y + acc[j].z * acc[j].z + acc[j].w * acc[j].w;
        const float rstd = rsqrtf(wave_sum(ss) * (1.f / (DM * gm::F8_SY * gm::F8_SY)) + EPS) * (1.f / gm::F8_SY);
#pragma unroll
        for (int j = 0; j < 4; ++j) {
            const int k = 4 * lane + 256 * j;
            const f32x4 nw = *(const LAS f32x4*)(NW3 + k), gt = *(const LAS f32x4*)(G2 + b * DM + k);
            const f32x4 xl = (f32x4){(float)x0[j].x, (float)x0[j].y, (float)x0[j].z, (float)x0[j].w};
            *(f32x4*)(F.out + (size_t)row * DM + k) = xl + gt * (acc[j] * rstd * nw);
        }
        s0 = s1; s1 = s2; m0 = m1;
#pragma unroll
        for (int j = 0; j < 4; ++j) { x0[j] = x1[j]; x1[j] = x2[j]; }
#pragma unroll
        for (int q = 0; q < 4; ++q)
#pragma unroll
            for (int j = 0; j < 4; ++j) y0[q][j] = y1[q][j];
    }
#undef CB_LOADSX
#undef CB_LOADY
}

#ifndef PROBE_PH
#define PROBE_PH -1
#endif

namespace mx {
DI int swz(int row, int chunk) { return row * 256 + ((chunk ^ (row & 15)) << 4); }
template <bool TR>
DI void load_tile(const f16* U, int row0, int s0, int ucol, LAS unsigned char* T, int rbase, int chunk) {
    f16x8 raw[8];
#pragma unroll
    for (int t = 0; t < 8; ++t) raw[t] = *(const f16x8*)(U + (size_t)(row0 + s0 + t) * NU + ucol);
    if (!TR) {
#pragma unroll
        for (int t = 0; t < 8; ++t) *(LAS f16x8*)(T + swz(rbase + t, chunk)) = raw[t];
    } else {
#pragma unroll
        for (int j = 0; j < 8; ++j) { f16x8 v;
#pragma unroll
            for (int t = 0; t < 8; ++t) v[t] = raw[t][j];
            *(LAS f16x8*)(T + swz(rbase + j, chunk)) = v; }
    }
}
DI void scan128(float a0, float a1, float& c0, float& c1, float& tot) {
    float p = a0 + a1;
#pragma unroll
    for (int o = 1; o < 64; o <<= 1) { const float t = __shfl_up(p, o); if ((int)(threadIdx.x & 63) >= o) p += t; }
    c1 = p; c0 = p - a1; tot = __shfl(p, 63);
}
constexpr size_t SSD_SLOT = 8192;
DI size_t ssd_sid(int b, int ck, int h, int dir) { return (size_t)(((b * 66 + ck) * 8 + h) * 2 + dir); }

DI float ssd_state_scale(float dt_bias) { return __builtin_exp2f(__builtin_rintf(-__builtin_log2f(softplus_f(dt_bias)))); }
DI unsigned char* ssd_slot8(unsigned char* ws, int b, int ck, int h, int dir) {
    return ck < 2 ? ws + 102 * MiB + (size_t)(((b * 2 + ck) * 8 + h) * 2 + dir) * 8192 : ws + 54 * MiB + (size_t)(((b * 64 + (ck - 2)) * 8 + h) * 2 + dir) * 8192;
}
struct SsaPre { f16x8 raw[8]; float d0, d1; };
DI void ssa_ids(int u, int& b, int& ck, int& h) { b = u / (66 * 8); ck = (u / 8) % 66; h = u & 7; }
DI int ssa_row0(int b, int ck) { return ck < 2 ? MLAT + b * CTXL + 128 * ck : b * SEQ + 128 * (ck - 2); }
DI void ssa_prefetch(const Ctx& F, int u, SsaPre& P) {
    int b, ck, h; ssa_ids(u, b, ck, h);
    const int tid = F.tid, row0 = ssa_row0(b, ck), g = h >> 2;
    if (tid < 384) {
        const int tr = tid & 15, g8 = tid >> 4;
        const int ucol = g8 < 8 ? UXBC + h * 64 + 8 * g8 : UXBC + 512 + g * 128 + 8 * (g8 - 8);
#pragma unroll
        for (int t = 0; t < 8; ++t) P.raw[t] = *(const f16x8*)(F.U() + (size_t)(row0 + 8 * tr + t) * NU + ucol);
    } else {
        const int s = tid - 384;
        P.d0 = F.DT()[(size_t)(row0 + s) * 16 + h]; P.d1 = F.DT()[(size_t)(row0 + s) * 16 + 8 + h];
    }
}
DI void ssd_a_phase(const Ctx& F, f16* ST, float* TOTS) {
    const int tid = F.tid, lane = F.lane;
    LAS unsigned char* XT = F.lds;
    LAS unsigned char* BT = F.lds + 64 * 256;
    LAS float* dtA = (LAS float*)(F.lds + 192 * 256);
    LAS float* laA = dtA + 256;
    LAS f16* w16 = (LAS f16*)(laA + 256);
    const int hq = (F.c >> 3) & 7, xq = F.c & 7, jq = F.c >> 6;
    const int nun = jq == 0 ? 8 : (jq == 3 ? 7 : 9);
#define SSA_UNIT(i) ((((i) < 7 ? xq + 8 * jq + 32 * (i) : ((i) == 7 ? (jq == 0 ? 224 : (jq == 1 ? 232 : 240)) : (jq == 1 ? 248 : 256)) + xq) << 3) + hq)
    int u = SSA_UNIT(0);
    const float dtb0 = F.dt_bias[hq], dtb1 = F.dt_bias[8 + hq], an0 = -__expf(F.a_log[hq]), an1 = -__expf(F.a_log[8 + hq]);
    const float sc0 = ssd_state_scale(dtb0), sc1 = ssd_state_scale(dtb1);
    SsaPre P; ssa_prefetch(F, u, P);
    for (int it = 0; it < nun; ++it) {
        u = SSA_UNIT(it);
        int b, ck, h; ssa_ids(u, b, ck, h);
        if (tid < 384) {
            const int tr = tid & 15, g8 = tid >> 4;
            LAS unsigned char* T = g8 < 8 ? XT : BT; const int rbase = g8 < 8 ? 8 * g8 : 8 * (g8 - 8);
#pragma unroll
            for (int j = 0; j < 8; ++j) { f16x8 v;
#pragma unroll
                for (int t = 0; t < 8; ++t) v[t] = P.raw[t][j];
                *(LAS f16x8*)(T + swz(rbase + j, tr)) = v; }
        } else {
            const int s = tid - 384;
            const float da = softplus_f(P.d0 + dtb0), db = softplus_f(P.d1 + dtb1);
            dtA[s] = da; laA[s] = da * an0; dtA[128 + s] = db; laA[128 + s] = db * an1;
        }
        if (it + 1 < nun) ssa_prefetch(F, SSA_UNIT(it + 1), P);
        __syncthreads();
        if (F.wave < 2) {
            const int dir = F.wave; const float a0 = laA[dir * 128 + 2 * lane], a1 = laA[dir * 128 + 2 * lane + 1];
            float c0, c1, tot; scan128(a0, a1, c0, c1, tot);
            const float e0 = dir == 0 ? tot - c0 : c0 - a0, e1 = dir == 0 ? tot - c1 : c1 - a1;
            w16[dir * 128 + 2 * lane] = (f16)(dtA[dir * 128 + 2 * lane] * __expf(e0));
            w16[dir * 128 + 2 * lane + 1] = (f16)(dtA[dir * 128 + 2 * lane + 1] * __expf(e1));
            if (lane == 0) TOTS[ssd_sid(b, ck, h, dir)] = __expf(tot);
        }
        __syncthreads();
        {
            int t2 = tid; asm volatile("" : "+v"(t2));
            const int lane2 = t2 & 63, fr = lane2 & 15, fq = lane2 >> 4, wv = __builtin_amdgcn_readfirstlane(t2 >> 6);
            const int dir = wv & 1, ntp = wv >> 1;
            f32x4 acc[2][4];
#pragma unroll
            for (int i = 0; i < 2; ++i)
#pragma unroll
                for (int j = 0; j < 4; ++j) acc[i][j] = (f32x4){0, 0, 0, 0};
#pragma unroll
            for (int kk = 0; kk < 4; ++kk) {
                const f16x8 wv8 = *(const LAS f16x8*)(w16 + dir * 128 + 32 * kk + 8 * fq);
                f16x8 a[2], bf[4];
#pragma unroll
                for (int nt = 0; nt < 2; ++nt) a[nt] = *(const LAS f16x8*)(BT + swz(16 * (2 * ntp + nt) + fr, 4 * kk + fq)) * wv8;
#pragma unroll
                for (int pt = 0; pt < 4; ++pt) bf[pt] = *(const LAS f16x8*)(XT + swz(16 * pt + fr, 4 * kk + fq));
#pragma unroll
                for (int nt = 0; nt < 2; ++nt)
#pragma unroll
                    for (int pt = 0; pt < 4; ++pt) acc[nt][pt] = __builtin_amdgcn_mfma_f32_16x16x32_f16(a[nt], bf[pt], acc[nt][pt], 0, 0, 0);
            }
            unsigned char* S = ssd_slot8(F.ws, b, ck, h, dir); const float sc = dir == 0 ? sc0 : sc1;
#pragma unroll
            for (int nt = 0; nt < 2; ++nt)
#pragma unroll
                for (int pt = 0; pt < 4; ++pt)
                    *(unsigned*)(S + (size_t)(16 * pt + fr) * 128 + 16 * (2 * ntp + nt) + 4 * fq) = gm::pack4f8(acc[nt][pt].x * sc, acc[nt][pt].y * sc, acc[nt][pt].z * sc, acc[nt][pt].w * sc);
        }
        __syncthreads();
    }
}
#undef SSA_UNIT

DI void ssd_b(const Ctx& F, f16* ST, const float* TOTS) {
    const int idx = F.c * 512 + F.tid; if (idx >= 64 * 2048) return;
    const int e = idx & 2047, chain = idx >> 11, dir = chain & 1, h = (chain >> 1) & 7, b = chain >> 4;
    float run[4] = {0.f, 0.f, 0.f, 0.f};
    for (int s0 = 0; s0 < 66; s0 += 6) {
        f16x4 loc[6]; float d[6]; f16* p[6];
#pragma unroll
        for (int i = 0; i < 6; ++i) { const int st = s0 + i; const int ck = dir == 0 ? st : (st < 2 ? 1 - st : 67 - st);
            const size_t sid = ssd_sid(b, ck, h, dir); p[i] = ST + sid * SSD_SLOT + (size_t)e * 4; loc[i] = *(const f16x4*)p[i]; d[i] = TOTS[sid]; }
#pragma unroll
        for (int i = 0; i < 6; ++i) { f16x4 o; o.x = (f16)run[0]; o.y = (f16)run[1]; o.z = (f16)run[2]; o.w = (f16)run[3]; *(f16x4*)p[i] = o;
            run[0] = d[i] * run[0] + (float)loc[i].x; run[1] = d[i] * run[1] + (float)loc[i].y; run[2] = d[i] * run[2] + (float)loc[i].z; run[3] = d[i] * run[3] + (float)loc[i].w; }
    }
}

DI void ssd_c_unit(const Ctx& F, const f16* ST, int b, int c, int g) {
    const int tid = F.tid, lane = F.lane;
    const int row0 = b * SEQ + 128 * c;
    LAS unsigned char* CT = F.lds;
    LAS unsigned char* BM = F.lds + 128 * 256;
    LAS unsigned char* XT = F.lds + 256 * 256;
    LAS float* dtA = (LAS float*)(F.lds + 131072);
    LAS float* csA = dtA + 1024;
    {
        const int trx = tid & 15, g8x = tid >> 4;
        const int g8b = tid & 31, trb = tid >> 5;
        f16x8 rx[8], rb[8]; float dv[2];
        const f16* px = F.U() + (size_t)(row0 + 8 * trx) * NU + UXBC + g * 256 + 8 * g8x;
        const f16* pb = F.U() + (size_t)(row0 + 8 * trb) * NU + UXBC + 512 + (g8b >> 4) * 256 + g * 128 + 8 * (g8b & 15);
#pragma unroll
        for (int t = 0; t < 8; ++t) { rx[t] = *(const f16x8*)(px + (size_t)t * NU); rb[t] = *(const f16x8*)(pb + (size_t)t * NU); }
#pragma unroll
        for (int q = 0; q < 2; ++q) { const int idx = tid + 512 * q, s = idx & 127, hd = idx >> 7; dv[q] = F.DT()[(size_t)(row0 + s) * 16 + (hd & 1) * 8 + g * 4 + (hd >> 1)]; }
#pragma unroll
        for (int j = 0; j < 8; ++j) { f16x8 v;
#pragma unroll
            for (int t = 0; t < 8; ++t) v[t] = rx[t][j];
            *(LAS f16x8*)(XT + swz(8 * g8x + j, trx)) = v; }
        LAS unsigned char* T = g8b < 16 ? BM : CT;
#pragma unroll
        for (int t = 0; t < 8; ++t) *(LAS f16x8*)(T + swz(8 * trb + t, g8b & 15)) = rb[t];
#pragma unroll
        for (int q = 0; q < 2; ++q) { const int idx = tid + 512 * q, s = idx & 127, hd = idx >> 7, hh = hd >> 1, dir = hd & 1, h = g * 4 + hh;
            const float d = softplus_f(dv[q] + F.dt_bias[dir * 8 + h]);
            dtA[hd * 128 + s] = d; csA[hd * 128 + s] = -d * __expf(F.a_log[dir * 8 + h]); }
    }
    __syncthreads();
    {
        const int wv = F.wave;
        const float a0 = csA[wv * 128 + 2 * lane], a1 = csA[wv * 128 + 2 * lane + 1];
        float c0, c1, tot; scan128(a0, a1, c0, c1, tot);
        if (wv & 1) { c0 = tot - c0 + a0; c1 = tot - c1 + a1; }
        csA[wv * 128 + 2 * lane] = c0; csA[wv * 128 + 2 * lane + 1] = c1;
    }
    __syncthreads();
    int t2 = tid; asm volatile("" : "+v"(t2));
    const int lane2 = t2 & 63, fr = lane2 & 15, fq = lane2 >> 4, w = __builtin_amdgcn_readfirstlane(t2 >> 6);
    const int l0 = 16 * w + fr;
    f16x8 cfr[4];
#pragma unroll
    for (int kk = 0; kk < 4; ++kk) cfr[kk] = *(const LAS f16x8*)(CT + swz(l0, 4 * kk + fq));
    f32x4 gacc[8];
#pragma unroll
    for (int st = 0; st < 8; ++st) { gacc[st] = (f32x4){0, 0, 0, 0};
#pragma unroll
        for (int kk = 0; kk < 4; ++kk) gacc[st] = __builtin_amdgcn_mfma_f32_16x16x32_f16(*(const LAS f16x8*)(BM + swz(16 * st + fr, 4 * kk + fq)), cfr[kk], gacc[st], 0, 0, 0); }
    float dsk4 = F.ssd_d[g * 4 + (lane2 & 3)]; asm volatile("s_waitcnt vmcnt(0)" : "+v"(dsk4) :: "memory");
    __syncthreads();
#define SSD_RING_ISSUE(q) do { const f16* _S = ST + ssd_sid(b, c + 2, g * 4 + ((q) >> 1), (q) & 1) * SSD_SLOT; \
        _Pragma("unroll") for (int _p = 0; _p < 2; ++_p) { const int _o = (w * 2 + _p) * 1024 + lane2 * 16, _row = _o >> 8, _pch = (_o >> 4) & 15, _lch = _pch ^ (_row & 15); \
            __builtin_amdgcn_global_load_lds((const unsigned*)((const char*)_S + _row * 256 + _lch * 16), (LAS unsigned*)(CT + ((q) & 3) * 16384 + (w * 2 + _p) * 1024), 16, 0, 0); } } while (0)
    SSD_RING_ISSUE(0); SSD_RING_ISSUE(1); SSD_RING_ISSUE(2); SSD_RING_ISSUE(3);
#pragma unroll 1
    for (int hh = 0; hh < 4; ++hh) {
        int l = l0; asm volatile("" : "+v"(l));
        const LAS float* dtf = dtA + (2 * hh) * 128, *dtb = dtA + (2 * hh + 1) * 128, *csf = csA + (2 * hh) * 128, *rcb = csA + (2 * hh + 1) * 128;
        const float csf_l = csf[l], rcb_l = rcb[l], dsum_l = dtf[l] + dtb[l], dskip = __shfl(dsk4, hh);
        f32x4 yacc[4];
#pragma unroll
        for (int pt = 0; pt < 4; ++pt) yacc[pt] = (f32x4){0, 0, 0, 0};
#pragma unroll
        for (int kk = 0; kk < 4; ++kk) {
            f16x8 m;
#pragma unroll
            for (int hf = 0; hf < 2; ++hf) { const int st = 2 * kk + hf, sb = 16 * st + 4 * fq;
                const f32x4 cf = *(const LAS f32x4*)(csf + sb), rb = *(const LAS f32x4*)(rcb + sb), df = *(const LAS f32x4*)(dtf + sb), db = *(const LAS f32x4*)(dtb + sb);
#pragma unroll
                for (int r = 0; r < 4; ++r) { const int s = sb + r;
                    const float arg = s < l ? csf_l - cf[r] : (s > l ? rcb_l - rb[r] : 0.f);
                    const float dsel = s < l ? df[r] : (s > l ? db[r] : dsum_l);
                    float val = gacc[st][r] * __expf(arg) * dsel; if (s == l) val += dskip;
                    m[hf * 4 + r] = (f16)val; } }
            __builtin_amdgcn_sched_barrier(0);
#pragma unroll
            for (int pt = 0; pt < 4; ++pt) { const int p = 64 * hh + 16 * pt + fr;
                const f16x4 x0 = *(const LAS f16x4*)(XT + swz(p, 4 * kk + (fq >> 1)) + 8 * (fq & 1));
                const f16x4 x1 = *(const LAS f16x4*)(XT + swz(p, 4 * kk + 2 + (fq >> 1)) + 8 * (fq & 1));
                f16x8 xf; xf[0] = x0[0]; xf[1] = x0[1]; xf[2] = x0[2]; xf[3] = x0[3]; xf[4] = x1[0]; xf[5] = x1[1]; xf[6] = x1[2]; xf[7] = x1[3];
                yacc[pt] = __builtin_amdgcn_mfma_f32_16x16x32_f16(xf, m, yacc[pt], 0, 0, 0); }
            __builtin_amdgcn_sched_barrier(0);
        }
        if (hh == 0) asm volatile("s_waitcnt vmcnt(4)" ::: "memory"); else if (hh == 3) asm volatile("s_waitcnt vmcnt(0)" ::: "memory"); else asm volatile("s_waitcnt vmcnt(4)" ::: "memory");
        bar_lds();
#pragma unroll
        for (int dir = 0; dir < 2; ++dir) {
            const LAS unsigned char* SL = CT + ((2 * hh + dir) & 3) * 16384;
            f32x4 off[4];
#pragma unroll
            for (int pt = 0; pt < 4; ++pt) off[pt] = (f32x4){0, 0, 0, 0};
#pragma unroll
            for (int kk = 0; kk < 4; ++kk)
#pragma unroll
                for (int pt = 0; pt < 4; ++pt) off[pt] = __builtin_amdgcn_mfma_f32_16x16x32_f16(*(const LAS f16x8*)(SL + swz(16 * pt + fr, 4 * kk + fq)), cfr[kk], off[pt], 0, 0, 0);
            const float e = __expf(dir == 0 ? csf_l : rcb_l);
#pragma unroll
            for (int pt = 0; pt < 4; ++pt) yacc[pt] += off[pt] * e;
        }
        bar_lds();
        if (hh < 2) { SSD_RING_ISSUE(2 * hh + 4); SSD_RING_ISSUE(2 * hh + 5); }
        { LAS unsigned char* stg = XT + hh * 16384 + w * 2048;
#pragma unroll
          for (int pt = 0; pt < 4; ++pt) { f16x4 o; o.x = (f16)yacc[pt].x; o.y = (f16)yacc[pt].y; o.z = (f16)yacc[pt].z; o.w = (f16)yacc[pt].w;
              *(LAS f16x4*)(stg + fr * 128 + (16 * pt + 4 * fq) * 2) = o; } }
    }
#undef SSD_RING_ISSUE
    {
        asm volatile("s_waitcnt lgkmcnt(0)" ::: "memory");
        const int tp = lane2 >> 5, ch = lane2 & 31, hd = ch >> 3, cw = ch & 7;
        const LAS unsigned char* stg = XT + hd * 16384 + w * 2048 + cw * 16;
        f16x8 zv[8];
#pragma unroll
        for (int i = 0; i < 8; ++i) zv[i] = *(const f16x8*)(F.U() + (size_t)(row0 + 16 * w + 2 * i + tp) * NU + UZ + g * 256 + 8 * ch);
        const f32x4 nw0 = *(const f32x4*)(F.ssd_nw + g * 256 + 8 * ch), nw1 = *(const f32x4*)(F.ssd_nw + g * 256 + 8 * ch + 4);
#pragma unroll
        for (int i = 0; i < 8; ++i) {
            const f16x8 yv = *(const LAS f16x8*)(stg + (2 * i + tp) * 128);
            float gv[8]; float ss = 0.f;
#pragma unroll
            for (int j = 0; j < 8; ++j) { gv[j] = (float)yv[j] * silu_f((float)zv[i][j]); ss += gv[j] * gv[j]; }
#pragma unroll
            for (int o = 1; o < 32; o <<= 1) ss += __shfl_xor(ss, o);
            const float rstd = rsqrtf(ss * (1.f / 256.f) + EPS);
            gm::u32x2g ov; const float rs = rstd * gm::F8_SYO;
            ov.x = gm::pack4f8(gv[0] * rs * nw0[0], gv[1] * rs * nw0[1], gv[2] * rs * nw0[2], gv[3] * rs * nw0[3]);
            ov.y = gm::pack4f8(gv[4] * rs * nw1[0], gv[5] * rs * nw1[1], gv[6] * rs * nw1[2], gv[7] * rs * nw1[3]);
            *(gm::u32x2g*)((unsigned char*)F.Y() + (size_t)(row0 + 16 * w + 2 * i + tp) * DM + g * 256 + 8 * ch) = ov;
        }
    }
    __syncthreads();
}
}

namespace mx {
typedef short s16x8 __attribute__((ext_vector_type(8)));
typedef float f32x2 __attribute__((ext_vector_type(2)));
DI int swz64(int row, int chunk) { return row * 128 + ((chunk ^ ((row >> 1) & 7)) << 4); }
DI unsigned short f2bf(float f) { unsigned u = __builtin_bit_cast(unsigned, f); return (unsigned short)((u + 0x7fffu + ((u >> 16) & 1u)) >> 16); }
constexpr size_t HG_SLOT = 16384;
DI size_t hg_sid(int b, int ck, int h, int dir) { return (size_t)(((b * 132 + ck) * 4 + h) * 2 + dir); }
DI f16* hg_slot(f16* HCT, f16* HLAT, int b, int ck, int h, int dir) {
    return ck < 4 ? HCT + (size_t)(((b * 4 + ck) * 4 + h) * 2 + dir) * HG_SLOT : HLAT + (size_t)(((b * 128 + (ck - 4)) * 4 + h) * 2 + dir) * HG_SLOT;
}
constexpr float HG_SS = 16.f;
DI unsigned char* hg_slot8(f16* HCT, f16* HLAT, int b, int ck, int h, int dir) {
    return ck < 4 ? (unsigned char*)HCT + (size_t)(((b * 4 + ck) * 4 + h) * 2 + dir) * 16384 : (unsigned char*)HLAT + (size_t)(((b * 128 + (ck - 4)) * 4 + h) * 2 + dir) * 16384;
}
template <int NCH>
DI void load_raw(const Ctx& F, int row0, int ucol, LAS unsigned char* RAW) {
    constexpr int CPR = NCH / 8;
    for (int i = F.tid; i < 64 * CPR; i += 512) { const int t = i / CPR, cch = i % CPR;
        *(LAS f16x8*)(RAW + (t * NCH + cch * 8) * 2) = *(const f16x8*)(F.U() + (size_t)(row0 + t) * NU + ucol + cch * 8); }
}
DI void load_vt(const Ctx& F, int row0, int h, LAS unsigned char* VT) {
    const int i = F.tid & 31, g8 = F.tid >> 5;
    const f16x8 a = *(const f16x8*)(F.U() + (size_t)(row0 + 2 * i) * NU + UI + h * 128 + 8 * g8);
    const f16x8 b = *(const f16x8*)(F.U() + (size_t)(row0 + 2 * i + 1) * NU + UI + h * 128 + 8 * g8);
#pragma unroll
    for (int j = 0; j < 8; ++j) { typedef _Float16 h2 __attribute__((ext_vector_type(2))); h2 p; p.x = a[j]; p.y = b[j];
        *(LAS h2*)(VT + swz64(8 * g8 + j, i >> 2) + (i & 3) * 4) = p; }
}

template <int T0, int SGN>
DI float hg_gates(const LAS f16* rf, float lb, float (&f)[32]) {
    float prod = 1.f;
#pragma unroll
    for (int i = 0; i < 32; ++i) { const int t = T0 + SGN * i; f[i] = lb + (1.f - lb) * sigmoid_f((float)rf[t * 128]); prod *= f[i]; }
    return prod;
}
template <int T0, int SGN>
DI void hg_a_write(const float (&f)[32], float R, LAS unsigned char* T, int k) {
    f16 v[32];
#pragma unroll
    for (int i = 0; i < 32; ++i) { v[i] = (f16)((1.f - f[i]) * R); R *= f[i]; }
#pragma unroll
    for (int j = 0; j < 4; ++j) { f16x8 o;
#pragma unroll
        for (int q = 0; q < 8; ++q) { const int t = (T0 < 32 ? 0 : 32) + 8 * j + q; const int i = SGN > 0 ? t - T0 : T0 - t; o[q] = v[i]; }
        const int ch = ((T0 < 32 ? 0 : 32) >> 3) + j;
        *(LAS f16x8*)(T + k * 128 + ((ch ^ ((k >> 1) & 7)) << 4)) = o; }
}
template <int T0, int SGN>
DI void hg_c_write(const float (&f)[32], float P, const LAS f16* rq, LAS unsigned char* TQ, LAS unsigned char* TK, int k) {
    const int cb = (k & 7) * 2, cx = (k >> 3) << 4;
#pragma unroll
    for (int i = 0; i < 32; ++i) { const int t = T0 + SGN * i; P *= f[i];
        const float qv = silu_f((float)rq[t * 128]);
        const int off = t * 256 + (cx ^ ((t & 15) << 4)) + cb;
        *(LAS unsigned short*)(TQ + off) = f2bf(qv * P);
        *(LAS unsigned short*)(TK + off) = f2bf((1.f - f[i]) * __builtin_amdgcn_rcpf(P)); }
}

typedef _Float16 f16x2 __attribute__((ext_vector_type(2)));
struct HgaPre { f16x4 rf[8]; f16x8 va, vb; };
DI void hga_ids(int v, int& b, int& ck, int& h) { b = v / (132 * 4); ck = (v / 4) % 132; h = v & 3; }
DI int hga_row0(int b, int ck) { return ck < 4 ? MLAT + b * CTXL + 64 * ck : b * SEQ + 64 * (ck - 4); }
DI void hga_prefetch(const Ctx& F, int v, HgaPre& P) {
    int b, ck, h; hga_ids(v, b, ck, h);
    const int tid = F.tid, row0 = hga_row0(b, ck);
    const int kq = tid & 31, dir = (tid >> 5) & 1, sg = tid >> 6;
    const int T0 = dir == 0 ? 8 * sg : 63 - 8 * sg, SG = dir == 0 ? 1 : -1;
    const f16* pf = F.U() + (size_t)(row0 + T0) * NU + (dir ? UFB : UFF) + h * 128 + 4 * kq;
    const long st = (long)SG * NU;
#pragma unroll
    for (int i = 0; i < 8; ++i) P.rf[i] = *(const f16x4*)(pf + i * st);
    const int pi = tid & 31, g8 = tid >> 5;
    P.va = *(const f16x8*)(F.U() + (size_t)(row0 + 2 * pi) * NU + UI + h * 128 + 8 * g8);
    P.vb = *(const f16x8*)(F.U() + (size_t)(row0 + 2 * pi + 1) * NU + UI + h * 128 + 8 * g8);
}
DI void hg_a_phase(const Ctx& F, f16* HCT, f16* HLAT, float* DEC) {
    LAS unsigned char* KD = F.lds;
    LAS unsigned char* VT = F.lds + 32768;
    LAS float* PX = (LAS float*)(F.lds + 49152);
    const int tid = F.tid;
    int v = (F.c + 64) % F.G; if (v >= 2112) return;
    f32x4 lbw;
    { const int kq = tid & 31, dir = (tid >> 5) & 1, ch = (v & 3) * 128 + 4 * kq;
#pragma unroll
      for (int e = 0; e < 4; ++e) { const float l0 = F.hgrn_lb[dir * 512 + ch + e], l1 = F.hgrn_lb[1024 + dir * 512 + ch + e]; lbw[e] = __builtin_amdgcn_rcpf(1.f + __expf(l1 - l0)); } }
    HgaPre P; hga_prefetch(F, v, P);
    for (; v < 2112; v += F.G) {
        int b, ck, h; hga_ids(v, b, ck, h);
        f16x4 rf[8];
#pragma unroll
        for (int i = 0; i < 8; ++i) rf[i] = P.rf[i];
        const f16x8 va = P.va, vb = P.vb;
        if (v + F.G < 2112) hga_prefetch(F, v + F.G, P);
        { const int pi = tid & 31, g8 = tid >> 5;
#pragma unroll
          for (int j = 0; j < 8; ++j) { typedef _Float16 h2 __attribute__((ext_vector_type(2))); h2 pr; pr.x = va[j]; pr.y = vb[j];
              *(LAS h2*)(VT + swz64(8 * g8 + j, pi >> 2) + (pi & 3) * 4) = pr; } }
        {
            const int kq = tid & 31, dir = (tid >> 5) & 1, sg = tid >> 6;
            float f[8][4]; f32x4 p = (f32x4){1.f, 1.f, 1.f, 1.f};
#pragma unroll
            for (int i = 0; i < 8; ++i)
#pragma unroll
                for (int e = 0; e < 4; ++e) { f[i][e] = lbw[e] + (1.f - lbw[e]) * sigmoid_f((float)rf[i][e]); p[e] *= f[i][e]; }
            *(LAS f32x4*)(PX + (dir * 8 + sg) * 128 + 4 * kq) = p;
            __syncthreads();
            f32x4 c = (f32x4){1.f, 1.f, 1.f, 1.f}, all = p;
            for (int s2 = 0; s2 < 8; ++s2) if (s2 != sg) { const f32x4 pp = *(const LAS f32x4*)(PX + (dir * 8 + s2) * 128 + 4 * kq); all = all * pp; if (s2 > sg) c = c * pp; }
            if (sg == 0) *(f32x4*)(DEC + hg_sid(b, ck, h, dir) * 128 + 4 * kq) = all;
            f16 w[8][4];
#pragma unroll
            for (int i = 7; i >= 0; --i)
#pragma unroll
                for (int e = 0; e < 4; ++e) { w[i][e] = (f16)((1.f - f[i][e]) * c[e]); c[e] *= f[i][e]; }
            const int tb = dir == 0 ? 8 * sg : 56 - 8 * sg;
            LAS unsigned char* T = KD + dir * 16384;
#pragma unroll
            for (int e = 0; e < 4; ++e) { f16x8 o;
#pragma unroll
                for (int j = 0; j < 8; ++j) o[j] = dir == 0 ? w[j][e] : w[7 - j][e];
                *(LAS f16x8*)(T + swz64(4 * kq + e, tb >> 3)) = o; }
        }
        __syncthreads();
        {
            int t2 = tid; asm volatile("" : "+v"(t2));
            const int lane2 = t2 & 63, fr = lane2 & 15, fq = lane2 >> 4, w = __builtin_amdgcn_readfirstlane(t2 >> 6);
            const int dir = w & 1, q = w >> 1;
            const LAS unsigned char* T = KD + dir * 16384;
            f32x4 acc[2][8];
#pragma unroll
            for (int i = 0; i < 2; ++i)
#pragma unroll
                for (int j = 0; j < 8; ++j) acc[i][j] = (f32x4){0, 0, 0, 0};
#pragma unroll
            for (int kk = 0; kk < 2; ++kk) {
                f16x8 a[2];
#pragma unroll
                for (int i = 0; i < 2; ++i) a[i] = *(const LAS f16x8*)(T + swz64(16 * (2 * q + i) + fr, 4 * kk + fq));
#pragma unroll
                for (int vt = 0; vt < 8; ++vt) { const f16x8 bv = *(const LAS f16x8*)(VT + swz64(16 * vt + fr, 4 * kk + fq));
#pragma unroll
                    for (int i = 0; i < 2; ++i) acc[i][vt] = __builtin_amdgcn_mfma_f32_16x16x32_f16(a[i], bv, acc[i][vt], 0, 0, 0); }
            }
            unsigned char* S = hg_slot8(HCT, HLAT, b, ck, h, dir);
#pragma unroll
            for (int i = 0; i < 2; ++i)
#pragma unroll
                for (int vt = 0; vt < 8; ++vt)
                    *(unsigned*)(S + (size_t)(16 * vt + fr) * 128 + 16 * (2 * q + i) + 4 * fq) = gm::pack4f8(acc[i][vt].x * HG_SS, acc[i][vt].y * HG_SS, acc[i][vt].z * HG_SS, acc[i][vt].w * HG_SS);
        }
        __syncthreads();
    }
}

DI void mb_scan(const Ctx& F, f16* ST, const float* TOTS, f16* HCT, f16* HLAT, const float* DEC) {
    const int idx = F.c * 512 + F.tid; if (idx >= 64 * 2048) return;
    const int es = idx & 2047, cs = idx >> 11, dirs = cs & 1, hs = (cs >> 1) & 7, bs = cs >> 4;
    const int eh = idx & 4095, chh = idx >> 12, dirh = chh & 1, hh = (chh >> 1) & 3, bh = chh >> 3, k0 = (eh & 31) * 4;
    f32x4 rs = (f32x4){0.f, 0.f, 0.f, 0.f};
    const float sinv = 1.f / ssd_state_scale(F.dt_bias[dirs * 8 + hs]);
    f32x4 rh = (f32x4){0.f, 0.f, 0.f, 0.f};
    for (int g = 0; g < 11; ++g) {
        unsigned ls[6]; float ds[6]; f16* ps[6];
        unsigned lh[12]; f32x4 dh[12]; unsigned char* ph[12];
#pragma unroll
        for (int i = 0; i < 6; ++i) { const int st = 6 * g + i; const int ck = dirs == 0 ? st : (st < 2 ? 1 - st : 67 - st);
            const size_t sid = ssd_sid(bs, ck, hs, dirs); ps[i] = ST + sid * SSD_SLOT + (size_t)es * 4; ls[i] = *(const unsigned*)(ssd_slot8(F.ws, bs, ck, hs, dirs) + (size_t)es * 4); ds[i] = TOTS[sid]; }
#pragma unroll
        for (int i = 0; i < 12; ++i) { const int st = 12 * g + i; const int ck = dirh == 0 ? st : (st < 4 ? 3 - st : 135 - st);
            ph[i] = hg_slot8(HCT, HLAT, bh, ck, hh, dirh) + (size_t)eh * 4; lh[i] = *(const unsigned*)ph[i]; dh[i] = *(const f32x4*)(DEC + hg_sid(bh, ck, hh, dirh) * 128 + k0); }
#pragma unroll
        for (int i = 0; i < 6; ++i) { f16x4 o; o.x = (f16)(rs.x * sinv); o.y = (f16)(rs.y * sinv); o.z = (f16)(rs.z * sinv); o.w = (f16)(rs.w * sinv); *(f16x4*)ps[i] = o;
            rs = rs * ds[i] + gm::unpack4f8(ls[i]); }
#pragma unroll
        for (int i = 0; i < 12; ++i) { *(unsigned*)ph[i] = gm::pack4f8(rh.x, rh.y, rh.z, rh.w); rh = dh[i] * rh + gm::unpack4f8(lh[i]); }
    }
}

DI unsigned cvt_pk_bf16(float lo, float hi) { unsigned r; asm volatile("v_cvt_pk_bf16_f32 %0, %1, %2" : "=v"(r) : "v"(lo), "v"(hi)); return r; }
struct HgcPre { f16x4 rf[8], rq[8]; f16x8 va, vb; f16x4 g[4]; };
DI void hgc_unit_ids(int u, int& b, int& c, int& h) { b = u >> 9; c = (u >> 2) & 127; h = u & 3; }
DI void hgc_prefetch(const Ctx& F, int u, HgcPre& P) {
    int b, c, h; hgc_unit_ids(u, b, c, h);
    const int tid = F.tid, row0 = b * SEQ + 64 * c;
    const int kq = tid & 31, dir = (tid >> 5) & 1, sg = tid >> 6;
    const int T0 = dir == 0 ? 8 * sg : 63 - 8 * sg, SG = dir == 0 ? 1 : -1;
    const f16* pf = F.U() + (size_t)(row0 + T0) * NU + (dir ? UFB : UFF) + h * 128 + 4 * kq;
    const f16* pq = F.U() + (size_t)(row0 + T0) * NU + UQ + h * 128 + 4 * kq;
    const long st = (long)SG * NU;
#pragma unroll
    for (int i = 0; i < 8; ++i) { P.rf[i] = *(const f16x4*)(pf + i * st); P.rq[i] = *(const f16x4*)(pq + i * st); }
    const int pi = tid & 31, g8 = tid >> 5;
    P.va = *(const f16x8*)(F.U() + (size_t)(row0 + 2 * pi) * NU + UI + h * 128 + 8 * g8);
    P.vb = *(const f16x8*)(F.U() + (size_t)(row0 + 2 * pi + 1) * NU + UI + h * 128 + 8 * g8);
    const int lane = tid & 63, fr = lane & 15, fq = lane >> 4, w = tid >> 6, lt = w & 3, vh = w >> 2;
    const f16* pg = F.U() + (size_t)(row0 + 16 * lt + fr) * NU + UG + h * 128 + 64 * vh + 4 * fq;
#pragma unroll
    for (int vt = 0; vt < 4; ++vt) P.g[vt] = *(const f16x4*)(pg + 16 * vt);
}
DI void hgc_dma(const Ctx& F, f16* HCT, f16* HLAT, int u, LAS unsigned char* SS) {
    int b, c, h; hgc_unit_ids(u, b, c, h);
    const int wv = __builtin_amdgcn_readfirstlane(F.tid >> 6), lane = F.tid & 63;
#pragma unroll
    for (int dir = 0; dir < 2; ++dir) { const unsigned char* S = hg_slot8(HCT, HLAT, b, c + 4, h, dir);
#pragma unroll
        for (int p = 0; p < 2; ++p)
            __builtin_amdgcn_global_load_lds((const unsigned*)(S + ((wv * 2 + p) * 64 + lane) * 16), (LAS unsigned*)(SS + dir * 32768 + 16384 + (wv * 2 + p) * 1024), 16, 0, 0); }
}
DI void hg_c_phase(const Ctx& F, f16* HCT, f16* HLAT) {
    LAS unsigned char* QD = F.lds;
    LAS unsigned char* KI = F.lds + 32768;
    LAS unsigned char* VT = F.lds + 65536;
    LAS unsigned char* SS = F.lds + 81920;
    LAS float* red = (LAS float*)(F.lds + 147456);
    LAS float* PX = red + 128;
    const int tid = F.tid;
    int u = F.c; if (u >= 2048) return;
    f32x4 lbw;
    { const int kq = tid & 31, dir = (tid >> 5) & 1, ch = (u & 3) * 128 + 4 * kq;
#pragma unroll
      for (int e = 0; e < 4; ++e) { const float l0 = F.hgrn_lb[dir * 512 + ch + e], l1 = F.hgrn_lb[1024 + dir * 512 + ch + e]; lbw[e] = __builtin_amdgcn_rcpf(1.f + __expf(l1 - l0)); } }
    LAS float* NW = PX + 2048;
    if (tid < 128) NW[tid] = F.hgrn_nw[(u & 3) * 128 + tid];
    asm volatile("s_waitcnt vmcnt(0)" ::: "memory");
    __syncthreads();
    HgcPre P; hgc_prefetch(F, u, P);
    __builtin_amdgcn_sched_barrier(0);
    hgc_dma(F, HCT, HLAT, u, SS);
    for (; u < 2048; u += F.G) {
        int b, c, h; hgc_unit_ids(u, b, c, h);
        const int row0 = b * SEQ + 64 * c;
        f16x4 rf[8], rq[8];
#pragma unroll
        for (int i = 0; i < 8; ++i) { rf[i] = P.rf[i]; rq[i] = P.rq[i]; }
        const f16x8 va = P.va, vb = P.vb; f16x4 gz[4];
#pragma unroll
        for (int vt = 0; vt < 4; ++vt) gz[vt] = P.g[vt];
        __builtin_amdgcn_sched_barrier(0);
        const bool has_next = u + F.G < 2048;
        if (has_next) hgc_prefetch(F, u + F.G, P);
        __builtin_amdgcn_sched_barrier(0);
        { const int pi = tid & 31, g8 = tid >> 5;
#pragma unroll
          for (int j = 0; j < 8; ++j) { typedef _Float16 h2 __attribute__((ext_vector_type(2))); h2 pr; pr.x = va[j]; pr.y = vb[j];
              *(LAS h2*)(VT + swz64(8 * g8 + j, pi >> 2) + (pi & 3) * 4) = pr; } }
        {
            const int kq = tid & 31, dir = (tid >> 5) & 1, sg = tid >> 6;
            const int T0 = dir == 0 ? 8 * sg : 63 - 8 * sg, SG = dir == 0 ? 1 : -1;
            float f[8][4]; f32x4 p = (f32x4){1.f, 1.f, 1.f, 1.f};
#pragma unroll
            for (int i = 0; i < 8; ++i)
#pragma unroll
                for (int e = 0; e < 4; ++e) { f[i][e] = lbw[e] + (1.f - lbw[e]) * sigmoid_f((float)rf[i][e]); p[e] *= f[i][e]; }
            *(LAS f32x4*)(PX + (dir * 8 + sg) * 128 + 4 * kq) = p;
            bar_lds();
            f32x4 c = (f32x4){1.f, 1.f, 1.f, 1.f};
            for (int s2 = 0; s2 < sg; ++s2) c = c * *(const LAS f32x4*)(PX + (dir * 8 + s2) * 128 + 4 * kq);
            LAS unsigned char* TQ = QD + dir * 16384; LAS unsigned char* TK = KI + dir * 16384;
            const int cb = (kq & 1) * 8, cx = (kq >> 1) << 4;
#pragma unroll
            for (int i = 0; i < 8; ++i) { const int t = T0 + SG * i;
#pragma unroll
                for (int e = 0; e < 4; ++e) c[e] *= f[i][e];
                const int off = t * 256 + (cx ^ ((t & 15) << 4)) + cb;
                typedef unsigned u32x2 __attribute__((ext_vector_type(2))); u32x2 qd, ki;
                qd.x = cvt_pk_bf16(silu_f((float)rq[i][0]) * c[0], silu_f((float)rq[i][1]) * c[1]); qd.y = cvt_pk_bf16(silu_f((float)rq[i][2]) * c[2], silu_f((float)rq[i][3]) * c[3]);
                ki.x = cvt_pk_bf16((1.f - f[i][0]) * __builtin_amdgcn_rcpf(c[0]), (1.f - f[i][1]) * __builtin_amdgcn_rcpf(c[1])); ki.y = cvt_pk_bf16((1.f - f[i][2]) * __builtin_amdgcn_rcpf(c[2]), (1.f - f[i][3]) * __builtin_amdgcn_rcpf(c[3]));
                *(LAS u32x2*)(TQ + off) = qd; *(LAS u32x2*)(TK + off) = ki; }
        }
        bar_lds();
        int t2 = tid; asm volatile("" : "+v"(t2));
        const int lane2 = t2 & 63, fr = lane2 & 15, fq = lane2 >> 4, w = __builtin_amdgcn_readfirstlane(t2 >> 6);
        const int lt = w & 3, vh = w >> 2, l = 16 * lt + fr;
        f32x4 oacc[4];
#pragma unroll
        for (int vt = 0; vt < 4; ++vt) oacc[vt] = (f32x4){0, 0, 0, 0};
        s16x8 qfr[2][4];
#pragma unroll
        for (int dir = 0; dir < 2; ++dir) {
            const LAS unsigned char* TQ = QD + dir * 16384; const LAS unsigned char* TK = KI + dir * 16384;
#pragma unroll
            for (int kk = 0; kk < 4; ++kk) qfr[dir][kk] = *(const LAS s16x8*)(TQ + swz(l, 4 * kk + fq));
            f32x4 att[4];
#pragma unroll
            for (int st = 0; st < 4; ++st) { att[st] = (f32x4){0, 0, 0, 0};
#pragma unroll
                for (int kk = 0; kk < 4; ++kk) att[st] = __builtin_amdgcn_mfma_f32_16x16x32_bf16(*(const LAS s16x8*)(TK + swz(16 * st + fr, 4 * kk + fq)), qfr[dir][kk], att[st], 0, 0, 0); }
#pragma unroll
            for (int k2 = 0; k2 < 2; ++k2) {
                f16x8 m;
#pragma unroll
                for (int hf = 0; hf < 2; ++hf)
#pragma unroll
                    for (int r = 0; r < 4; ++r) { const int s = 16 * (2 * k2 + hf) + 4 * fq + r; const bool keep = dir == 0 ? s <= l : s >= l; m[hf * 4 + r] = keep ? (f16)att[2 * k2 + hf][r] : (f16)0.f; }
#pragma unroll
                for (int vt = 0; vt < 4; ++vt) { const int v = 64 * vh + 16 * vt + fr;
                    const f16x4 x0 = *(const LAS f16x4*)(VT + swz64(v, 4 * k2 + (fq >> 1)) + 8 * (fq & 1));
                    const f16x4 x1 = *(const LAS f16x4*)(VT + swz64(v, 4 * k2 + 2 + (fq >> 1)) + 8 * (fq & 1));
                    f16x8 xf; xf[0] = x0[0]; xf[1] = x0[1]; xf[2] = x0[2]; xf[3] = x0[3]; xf[4] = x1[0]; xf[5] = x1[1]; xf[6] = x1[2]; xf[7] = x1[3];
                    oacc[vt] = __builtin_amdgcn_mfma_f32_16x16x32_f16(xf, m, oacc[vt], 0, 0, 0); }
            }
        }
        if (has_next) asm volatile("s_waitcnt vmcnt(20)" ::: "memory"); else asm volatile("s_waitcnt vmcnt(0)" ::: "memory");
        bar_lds();
        {
            const int wv2 = t2 >> 6;
            u32x4 raw[2][2];
#pragma unroll
            for (int dir = 0; dir < 2; ++dir)
#pragma unroll
                for (int p = 0; p < 2; ++p) raw[dir][p] = *(const LAS u32x4*)(SS + dir * 32768 + 16384 + ((wv2 * 2 + p) * 64 + lane2) * 16);
            bar_lds();
#pragma unroll
            for (int dir = 0; dir < 2; ++dir)
#pragma unroll
                for (int p = 0; p < 2; ++p) { const int g = (wv2 * 2 + p) * 64 + lane2, row = g >> 3, lc = (g & 7) * 2;
                    const f32x4 a0 = gm::unpack4f8(raw[dir][p].x) * (1.f / HG_SS), a1 = gm::unpack4f8(raw[dir][p].y) * (1.f / HG_SS), a2 = gm::unpack4f8(raw[dir][p].z) * (1.f / HG_SS), a3 = gm::unpack4f8(raw[dir][p].w) * (1.f / HG_SS);
                    u32x4 w0, w1; w0.x = gm::pack2(a0.x, a0.y); w0.y = gm::pack2(a0.z, a0.w); w0.z = gm::pack2(a1.x, a1.y); w0.w = gm::pack2(a1.z, a1.w);
                    w1.x = gm::pack2(a2.x, a2.y); w1.y = gm::pack2(a2.z, a2.w); w1.z = gm::pack2(a3.x, a3.y); w1.w = gm::pack2(a3.z, a3.w);
                    *(LAS u32x4*)(SS + dir * 32768 + swz(row, lc)) = w0; *(LAS u32x4*)(SS + dir * 32768 + swz(row, lc + 1)) = w1; }
            bar_lds();
        }
#pragma unroll
        for (int dir = 0; dir < 2; ++dir)
#pragma unroll
            for (int kk = 0; kk < 4; ++kk) { f16x8 q16;
#pragma unroll
                for (int j = 0; j < 8; ++j) q16[j] = (f16)__builtin_bit_cast(float, ((unsigned)(unsigned short)qfr[dir][kk][j]) << 16);
#pragma unroll
                for (int vt = 0; vt < 4; ++vt) oacc[vt] = __builtin_amdgcn_mfma_f32_16x16x32_f16(*(const LAS f16x8*)(SS + dir * 32768 + swz(64 * vh + 16 * vt + fr, 4 * kk + fq)), q16, oacc[vt], 0, 0, 0); }
        float ss = 0.f;
#pragma unroll
        for (int vt = 0; vt < 4; ++vt) ss += oacc[vt].x * oacc[vt].x + oacc[vt].y * oacc[vt].y + oacc[vt].z * oacc[vt].z + oacc[vt].w * oacc[vt].w;
        ss += __shfl_xor(ss, 16); ss += __shfl_xor(ss, 32);
        if (fq == 0) red[vh * 64 + l] = ss;
        __syncthreads();
        if (has_next) hgc_dma(F, HCT, HLAT, u + F.G, SS);
        const float rstd = rsqrtf((red[l] + red[64 + l]) * (1.f / 128.f) + EPS);
        unsigned char* yrow = (unsigned char*)F.Y() + (size_t)(row0 + l) * DM + 512 + h * 128;
#pragma unroll
        for (int vt = 0; vt < 4; ++vt) { const int v = 64 * vh + 16 * vt + 4 * fq;
            const f32x4 nw = *(const LAS f32x4*)(NW + v);
            const float rs = rstd * gm::F8_SYO;
            *(unsigned*)(yrow + v) = gm::pack4f8(oacc[vt].x * rs * nw.x * silu_f((float)gz[vt].x), oacc[vt].y * rs * nw.y * silu_f((float)gz[vt].y),
                                                 oacc[vt].z * rs * nw.z * silu_f((float)gz[vt].z), oacc[vt].w * rs * nw.w * silu_f((float)gz[vt].w)); }
        __syncthreads();
    }
}
}

__global__ void __launch_bounds__(512, 2) mk_fwd(Args args) {
    extern __shared__ __attribute__((aligned(16))) unsigned char lds_raw[];
    Ctx F;
    F.lds = (LAS unsigned char*)lds_raw;
    F.tid = threadIdx.x; F.lane = F.tid & 63; F.wave = __builtin_amdgcn_readfirstlane(F.tid >> 6); F.G = gridDim.x; F.c = blockIdx.x;
    unsigned char* ws = args.ws;
    F.x = args.in[0]; F.cvec = args.in[1]; F.ctx = args.in[2]; F.c_ctx = args.in[3]; F.ada_w = args.in[4]; F.ada_b = args.in[5]; F.norm_w = args.in[6]; F.w_in = args.in[7];
    F.conv_w = args.in[8]; F.conv_b = args.in[9]; F.dt_bias = args.in[10]; F.a_log = args.in[11]; F.ssd_d = args.in[12]; F.ssd_nw = args.in[13]; F.hgrn_lb = args.in[14]; F.hgrn_nw = args.in[15];
    F.w_out = args.in[16]; F.w_router = args.in[17]; F.w_gate = args.in[18]; F.w_up = args.in[19]; F.w_down = args.in[20];
    F.out = args.out;
    F.ws = ws;
    volatile LAS unsigned* misc = (volatile LAS unsigned*)(F.lds + LDS_MISC_OFF);
    if (F.tid < 16) misc[F.tid] = 0u;
    __syncthreads();
    XcdBarrier bar = xcd_barrier_post((unsigned*)(ws + WS_BAR), misc + 8);
    f16* SST = (f16*)(ws + WS_H); float* TOTS = (float*)(ws + WS_Y); float* DEC = (float*)(ws + WS_Y + 65536);
    f16* HCT = (f16*)(ws + WS_AFF); f16* HLAT = (f16*)F.out;
    const int hi = args.hi;
#define REFRESH() do { int _t = threadIdx.x; asm volatile("" : "+v"(_t)); F.tid = _t; F.lane = _t & 63; F.wave = __builtin_amdgcn_readfirstlane(_t >> 6); } while (0)
#define PHASE(k, last, ...) do { if ((k) < hi) { REFRESH(); __VA_ARGS__; if (!(last) && (k) + 1 < hi) xcd_barrier(bar); } } while (0)
    PHASE(PH_PREP, false, phase_prep(F));
    PHASE(PH_HROWS, false, phase_hrows(F));
    PHASE(PH_GEMM_IN, false, { gm::ProbIn p{F.H(), F.WIN(), F.U()}; gm::gemm_phase(F.lds, p, F.G, F.c, F.tid); moe_convert(F, 0, MOE_SPLIT); });
    PHASE(PH_CONV, false, phase_conv(F));
    PHASE(PH_MA, false, {
        mx::ssd_a_phase(F, SST, TOTS);
        mx::hg_a_phase(F, HCT, HLAT, DEC); });
    PHASE(PH_MB, false, { mx::mb_scan(F, SST, TOTS, HCT, HLAT, DEC); });
    PHASE(PH_MC, false, {
        for (int u = F.c; u < 512; u += F.G) mx::ssd_c_unit(F, SST, u >> 7, (u >> 1) & 63, u & 1);
        mx::hg_c_phase(F, HCT, HLAT); });
    PHASE(PH_GEMM_OUT, false, { gm::ProbOut8 p{(const unsigned char*)F.Y(), (const unsigned char*)F.WOUT(), F.R()}; gm::gemm_phase(F.lds, p, F.G, F.c, F.tid); });
    PHASE(PH_POST, false, phase_post(F));
    PHASE(PH_TOPK, false, { phase_topk(F); moe_convert(F, MOE_SPLIT, MOE_ITEMS); });
    PHASE(PH_GEMM_GU, false, {
        LAS int* tab = (LAS int*)(F.lds + LDS_TAB_OFF);
        { int tv[8]; int nb[8];
_Pragma("unroll")
          for (int i = 0; i < 8; ++i) { gm::Unit u; gm::unit_at(i, F.G, F.c, gm::ProbGU::nM, gm::ProbGU::nN, u); nb[i] = ((u.pm >> 2) & 3) * SEQ; tv[i] = F.tid < 256 ? F.IDX()[u.pm * 256 + F.tid] : 0; }
_Pragma("unroll")
          for (int i = 0; i < 8; ++i) if (F.tid < 256) tab[i * 256 + F.tid] = nb[i] + tv[i]; }
        __syncthreads();
        gm::ProbGU8 p{F.H2Q(), F.WGU8(), F.ACT8(), tab}; gm::gemm_phase(F.lds, p, F.G, F.c, F.tid); });
    PHASE(PH_GEMM_DOWN, false, {
        LAS float* gtab = (LAS float*)(F.lds + LDS_TAB_OFF);
        { float gv[4];
_Pragma("unroll")
          for (int i = 0; i < 4; ++i) { gm::Unit u; gm::unit_at(i, F.G, F.c, gm::ProbDown::nM, gm::ProbDown::nN, u); gv[i] = F.tid < 256 ? F.GATEV()[u.pm * 256 + F.tid] : 0.f; }
_Pragma("unroll")
          for (int i = 0; i < 4; ++i) if (F.tid < 256) gtab[i * 256 + F.tid] = gv[i]; }
        asm volatile("s_waitcnt vmcnt(0)" ::: "memory");
        __syncthreads();
        gm::ProbDown8 p{F.ACT8(), F.WD8(), F.YM8(), gtab, 0}; gm::gemm_phase(F.lds, p, F.G, F.c, F.tid); });
    PHASE(PH_COMBINE, true, phase_combine(F));
#undef PHASE
}

extern "C" void kernel_launch(void* const* d_in, const int* in_sizes, int n_in, void* d_out, int out_size, void* d_ws, size_t ws_size, hipStream_t stream) {
    if (ws_size < WS_END || n_in < 21) { fprintf(stderr, "kernel_launch: bad workspace/inputs: ws %zu n_in %d\n", ws_size, n_in); return; }
    static bool attr_set = false;
    if (!attr_set) { (void)hipFuncSetAttribute((const void*)mk_fwd, hipFuncAttributeMaxDynamicSharedMemorySize, LDS_BYTES); attr_set = true; }
    Args a{}; for (int i = 0; i < 21; ++i) a.in[i] = (const float*)d_in[i]; a.out = (float*)d_out; a.ws = (unsigned char*)d_ws;
#if PROBE_PH >= 0
    (void)hipMemsetAsync((char*)d_ws + WS_BAR, 0, WS_CTL_BYTES, stream);
    a.hi = PROBE_PH; hipLaunchKernelGGL(mk_fwd, dim3(256), dim3(512), LDS_BYTES, stream, a);
#endif
    (void)hipMemsetAsync((char*)d_ws + WS_BAR, 0, WS_CTL_BYTES, stream);
    a.hi = PH_COUNT; hipLaunchKernelGGL(mk_fwd, dim3(256), dim3(512), LDS_BYTES, stream, a);
}
```
